# Optimizing an MI355X kernel written in HIP

```python
import math
import jax
import jax.numpy as jnp
from jax import lax
import numpy as np

D_MODEL = 1024
BATCH = 16
SEQ = 2048
DEPTH = 4

EPS = 1e-6
ROPE_THETA = 500000.0
Q_BLOCK = 128
D_FF = 2816
N_ADA = 9

D_RNN = 512
RNN_HEADS = 8
RNN_HEAD_DIM = D_RNN // RNN_HEADS
CONV_WIDTH = 4
LRU_C = 8.0

MLA_HEADS = 8
MLA_NOPE = 64
MLA_ROPE = 32
MLA_V = 64
MLA_QK = MLA_ROPE + MLA_NOPE
MLA_Q_LORA = 256
MLA_KV_LORA = 128

DSA_HEADS = 8
DSA_HEAD_DIM = 64
DSA_ROT = DSA_HEAD_DIM // 4
IDX_HEADS = 8
IDX_DIM = 32
IDX_ROT = IDX_DIM // 4
TOPK_MAX = 256

S5_GROUP = 16
S5_GROUPS = 32
D_S5 = S5_GROUP * S5_GROUPS
S5_STATE = 64

N_BRANCH = 4
BRANCH_W = 512
IN_SPLITS = (D_RNN, D_RNN, MLA_Q_LORA, MLA_KV_LORA, MLA_ROPE,
             DSA_HEADS * DSA_HEAD_DIM, DSA_HEAD_DIM, DSA_HEAD_DIM,
             IDX_HEADS * IDX_DIM, IDX_DIM, IDX_HEADS, D_S5, N_BRANCH * D_MODEL)
D_IN = 6984

kernel_name = 'hybrid_gated_rglru_mla_dsa_s5_block'


def rmsnorm(x, g):
    xf = x.astype(jnp.float32)
    y = xf * lax.rsqrt(jnp.mean(xf * xf, axis=-1, keepdims=True) + EPS)
    return (y * g.astype(jnp.float32)).astype(x.dtype)


def modulate(x, shift, scale):
    return x * (1.0 + scale) + shift


def swiglu(u, w1, w3, w2):
    return (jax.nn.silu(u @ w1) * (u @ w3)) @ w2


def rope_tables(positions, rot_dim):
    inv = ROPE_THETA ** (-jnp.arange(0, rot_dim, 2, dtype=jnp.float32) / rot_dim)
    ang = positions.astype(jnp.float32)[..., None] * inv
    return jnp.cos(ang), jnp.sin(ang)


def apply_rope(x, cs, rot_dim):
    cos, sin = cs
    if x.ndim == 4:
        cos, sin = cos[:, :, None, :], sin[:, :, None, :]
    cos, sin = cos.astype(x.dtype), sin.astype(x.dtype)
    half = rot_dim // 2
    x1, x2, rest = x[..., :half], x[..., half:rot_dim], x[..., rot_dim:]
    return jnp.concatenate([x1 * cos - x2 * sin, x2 * cos + x1 * sin, rest], axis=-1)


def to_blocks(a):
    b, t = a.shape[:2]
    return a.reshape((b, t // Q_BLOCK, Q_BLOCK) + a.shape[2:]).swapaxes(0, 1)


def from_blocks(o):
    nb, b, qb = o.shape[:3]
    return o.swapaxes(0, 1).reshape((b, nb * qb, -1))


def linear_combine(e1, e2):
    a1, b1 = e1
    a2, b2 = e2
    return a1 * a2, a2 * b1 + b2


def complex_combine(e1, e2):
    a1r, a1i, b1r, b1i = e1
    a2r, a2i, b2r, b2i = e2
    return (a2r * a1r - a2i * a1i, a2r * a1i + a2i * a1r,
            a2r * b1r - a2i * b1i + b2r, a2r * b1i + a2i * b1r + b2i)


def rglru_branch(x_rnn, gate_rnn, conv_w, conv_b, wa, ba, wx, bx, lam):
    b, t, _ = x_rnn.shape
    xc = lax.conv_general_dilated(x_rnn, conv_w[:, None, :], window_strides=(1,),
                                  padding=[(CONV_WIDTH - 1, 0)],
                                  dimension_numbers=('NWC', 'WIO', 'NWC'),
                                  feature_group_count=D_RNN) + conv_b
    xh = xc.reshape(b, t, RNN_HEADS, RNN_HEAD_DIM)
    r = jax.nn.sigmoid((jnp.einsum('bthi,hij->bthj', xh, wa).reshape(b, t, D_RNN) + ba).astype(jnp.float32))
    ig = jax.nn.sigmoid((jnp.einsum('bthi,hij->bthj', xh, wx).reshape(b, t, D_RNN) + bx).astype(jnp.float32))
    log_a = -LRU_C * r * jax.nn.softplus(-lam.astype(jnp.float32))
    a = jnp.exp(log_a)
    inp = jnp.sqrt(-jnp.expm1(2.0 * log_a)) * ig * xc.astype(jnp.float32)
    _, h = lax.associative_scan(linear_combine, (a, inp), axis=1)
    return h.astype(x_rnn.dtype) * jax.nn.gelu(gate_rnn)


def causal_dense_attention(q, k, v, scale):
    t = q.shape[1]
    kpos = jnp.arange(t)

    def block(args):
        qb, i = args
        qpos = i * Q_BLOCK + jnp.arange(Q_BLOCK)
        s = jnp.einsum('bqhd,bshd->bhqs', qb, k).astype(jnp.float32) * scale
        s = jnp.where(kpos[None, :] <= qpos[:, None], s, -jnp.inf)
        p = jax.nn.softmax(s, axis=-1).astype(v.dtype)
        return jnp.einsum('bhqs,bshd->bqhd', p, v)

    return from_blocks(lax.map(block, (to_blocks(q), jnp.arange(t // Q_BLOCK))))


def mla_branch(q_lat, kv_lat, k_pe, cs, q_norm_g, w_uq, kv_norm_g, w_ukv, qk_gain):
    b, t, _ = q_lat.shape
    q = (rmsnorm(q_lat, q_norm_g) @ w_uq).reshape(b, t, MLA_HEADS, MLA_QK)
    kv = (rmsnorm(kv_lat, kv_norm_g) @ w_ukv).reshape(b, t, MLA_HEADS, MLA_NOPE + MLA_V)
    k_nope, v = kv[..., :MLA_NOPE], kv[..., MLA_NOPE:]
    k_rope = jnp.broadcast_to(k_pe[:, :, None, :], (b, t, MLA_HEADS, MLA_ROPE))
    k = jnp.concatenate([k_rope, k_nope], axis=-1)
    q = apply_rope(rmsnorm(q, qk_gain[0]), cs, MLA_ROPE)
    k = apply_rope(rmsnorm(k, qk_gain[1]), cs, MLA_ROPE)
    return causal_dense_attention(q, k, v, MLA_QK ** -0.5)


def dsa_branch(q, k, v, q_idx, k_idx, w_idx, cs_main, cs_idx, qk_gain):
    b, t, _ = q.shape
    topk = min(TOPK_MAX, t // 4)
    q = apply_rope(rmsnorm(q.reshape(b, t, DSA_HEADS, DSA_HEAD_DIM), qk_gain[0]), cs_main, DSA_ROT)
    k = apply_rope(rmsnorm(k, qk_gain[1]), cs_main, DSA_ROT)
    q_idx = apply_rope(q_idx.reshape(b, t, IDX_HEADS, IDX_DIM), cs_idx, IDX_ROT)
    k_idx = apply_rope(k_idx, cs_idx, IDX_ROT)
    kpos = jnp.arange(t)
    gather = jax.vmap(lambda table, idx: table[idx])

    def block(args):
        qb, qib, wib, i = args
        qpos = i * Q_BLOCK + jnp.arange(Q_BLOCK)
        rel = jax.nn.relu(jnp.einsum('bqhd,bsd->bqhs', qib, k_idx).astype(jnp.float32))
        score = jnp.einsum('bqh,bqhs->bqs', wib.astype(jnp.float32), rel)
        score = jnp.where(kpos[None, :] <= qpos[:, None], score, -jnp.inf)
        _, sel = lax.top_k(score, topk)
        valid = sel <= qpos[None, :, None]
        k_sel = gather(k, sel)
        v_sel = gather(v, sel)
        s = jnp.einsum('bqhd,bqkd->bhqk', qb, k_sel).astype(jnp.float32) * DSA_HEAD_DIM ** -0.5
        s = jnp.where(valid[:, None], s, -jnp.inf)
        p = jax.nn.softmax(s, axis=-1).astype(v.dtype)
        return jnp.einsum('bhqk,bqkd->bqhd', p, v_sel)

    xs = (to_blocks(q), to_blocks(q_idx), to_blocks(w_idx), jnp.arange(t // Q_BLOCK))
    return from_blocks(lax.map(block, xs))


def s5_branch(u, lam_re, lam_im, log_dt, b_re, b_im, c_re, c_im, d, w_glu, b_glu):
    bsz, t, _ = u.shape
    f32 = jnp.float32
    lr, li = lam_re.astype(f32), lam_im.astype(f32)
    dt = jnp.exp(log_dt.astype(f32))[:, None]
    mag = jnp.exp(lr * dt)
    ab_re, ab_im = mag * jnp.cos(li * dt), mag * jnp.sin(li * dt)
    den = lr * lr + li * li
    nr, ni = ab_re - 1.0, ab_im
    f_re = (nr * lr + ni * li) / den
    f_im = (ni * lr - nr * li) / den
    br, bi = b_re.astype(f32), b_im.astype(f32)
    bb_re = f_re[..., None] * br - f_im[..., None] * bi
    bb_im = f_re[..., None] * bi + f_im[..., None] * br
    ug = u.reshape(bsz, t, S5_GROUPS, S5_GROUP).astype(f32)
    bu_re = jnp.einsum('gpj,btgj->btgp', bb_re, ug)
    bu_im = jnp.einsum('gpj,btgj->btgp', bb_im, ug)
    a_re = jnp.broadcast_to(ab_re[None, None], (1, t, S5_GROUPS, S5_STATE))
    a_im = jnp.broadcast_to(ab_im[None, None], (1, t, S5_GROUPS, S5_STATE))
    _, _, x_re, x_im = lax.associative_scan(complex_combine, (a_re, a_im, bu_re, bu_im), axis=1)
    y = (jnp.einsum('gjp,btgp->btgj', c_re.astype(f32), x_re)
         - jnp.einsum('gjp,btgp->btgj', c_im.astype(f32), x_im))
    y = y.reshape(bsz, t, D_S5) + d.astype(f32) * u.astype(f32)
    y = jax.nn.gelu(y).astype(u.dtype)
    return y * jax.nn.sigmoid(y @ w_glu + b_glu)


def setup_inputs(seed: int = 0) -> dict:
    key = jax.random.key(seed)
    ks = jax.random.split(key, 40)
    L = DEPTH

    def nrm(k, shape, scale):
        return jax.random.normal(k, shape, jnp.float32) * scale

    def gain(k, shape):
        return 1.0 + nrm(k, shape, 0.02)

    a_c = jax.random.uniform(ks[20], (L, D_RNN), jnp.float32, 0.9, 0.999)
    a0 = a_c ** (1.0 / LRU_C)
    s5_n = jnp.arange(S5_STATE, dtype=jnp.float32)
    return {
        'x': nrm(ks[0], (BATCH, SEQ, D_MODEL), 1.0),
        'c': nrm(ks[1], (BATCH, D_MODEL), 1.0),
        'positions': jnp.arange(SEQ, dtype=jnp.int32)[None, :] + jax.random.randint(ks[2], (BATCH, 1), 0, 1024, jnp.int32),
        'ada_w': nrm(ks[3], (L, D_MODEL, N_ADA * D_MODEL), 0.1 * D_MODEL ** -0.5),
        'ada_b': nrm(ks[4], (L, N_ADA * D_MODEL), 0.01),
        'norm_g': gain(ks[5], (L, 3, D_MODEL)),
        'ffn_w1': nrm(ks[6], (L, 2, D_MODEL, D_FF), D_MODEL ** -0.5),
        'ffn_w3': nrm(ks[7], (L, 2, D_MODEL, D_FF), D_MODEL ** -0.5),
        'ffn_w2': nrm(ks[8], (L, 2, D_FF, D_MODEL), D_FF ** -0.5),
        'w_in': nrm(ks[9], (L, D_MODEL, D_IN), D_MODEL ** -0.5),
        'conv_w': nrm(ks[10], (L, CONV_WIDTH, D_RNN), CONV_WIDTH ** -0.5),
        'conv_b': nrm(ks[11], (L, D_RNN), 0.01),
        'rg_wa': nrm(ks[12], (L, RNN_HEADS, RNN_HEAD_DIM, RNN_HEAD_DIM), RNN_HEAD_DIM ** -0.5),
        'rg_ba': nrm(ks[13], (L, D_RNN), 0.01),
        'rg_wx': nrm(ks[14], (L, RNN_HEADS, RNN_HEAD_DIM, RNN_HEAD_DIM), RNN_HEAD_DIM ** -0.5),
        'rg_bx': nrm(ks[15], (L, D_RNN), 0.01),
        'rg_lambda': jnp.log(a0) - jnp.log1p(-a0),
        'mla_q_norm': gain(ks[16], (L, MLA_Q_LORA)),
        'mla_w_uq': nrm(ks[17], (L, MLA_Q_LORA, MLA_HEADS * MLA_QK), MLA_Q_LORA ** -0.5),
        'mla_kv_norm': gain(ks[18], (L, MLA_KV_LORA)),
        'mla_w_ukv': nrm(ks[19], (L, MLA_KV_LORA, MLA_HEADS * (MLA_NOPE + MLA_V)), MLA_KV_LORA ** -0.5),
        'mla_qk_gain': gain(ks[21], (L, 2, MLA_QK)),
        'dsa_qk_gain': gain(ks[22], (L, 2, DSA_HEAD_DIM)),
        's5_lambda_re': -0.5 + nrm(ks[23], (L, S5_GROUPS, S5_STATE), 0.005),
        's5_lambda_im': math.pi * s5_n + nrm(ks[24], (L, S5_GROUPS, S5_STATE), 0.01),
        's5_log_dt': jax.random.uniform(ks[25], (L, S5_GROUPS), jnp.float32, math.log(0.001), math.log(0.1)),
        's5_b_re': nrm(ks[26], (L, S5_GROUPS, S5_STATE, S5_GROUP), (2.0 * S5_GROUP) ** -0.5),
        's5_b_im': nrm(ks[27], (L, S5_GROUPS, S5_STATE, S5_GROUP), (2.0 * S5_GROUP) ** -0.5),
        's5_c_re': nrm(ks[28], (L, S5_GROUPS, S5_GROUP, S5_STATE), (2.0 * S5_STATE) ** -0.5),
        's5_c_im': nrm(ks[29], (L, S5_GROUPS, S5_GROUP, S5_STATE), (2.0 * S5_STATE) ** -0.5),
        's5_d': nrm(ks[30], (L, D_S5), 1.0),
        's5_w_glu': nrm(ks[31], (L, D_S5, D_S5), D_S5 ** -0.5),
        's5_b_glu': nrm(ks[32], (L, D_S5), 0.01),
        'w_branch': nrm(ks[33], (L, N_BRANCH, BRANCH_W, D_MODEL), BRANCH_W ** -0.5),
        'w_out': nrm(ks[34], (L, D_MODEL, D_MODEL), D_MODEL ** -0.5),
    }


def reference(x, c, positions, ada_w, ada_b, norm_g, ffn_w1, ffn_w3, ffn_w2, w_in,
              conv_w, conv_b, rg_wa, rg_ba, rg_wx, rg_bx, rg_lambda,
              mla_q_norm, mla_w_uq, mla_kv_norm, mla_w_ukv, mla_qk_gain, dsa_qk_gain,
              s5_lambda_re, s5_lambda_im, s5_log_dt, s5_b_re, s5_b_im, s5_c_re, s5_c_im,
              s5_d, s5_w_glu, s5_b_glu, w_branch, w_out):
    b, t, _ = x.shape
    split_points = np.cumsum(np.array(IN_SPLITS))[:-1].tolist()
    cs_mla = rope_tables(positions, MLA_ROPE)
    cs_dsa = rope_tables(positions, DSA_ROT)
    cs_idx = rope_tables(positions, IDX_ROT)
    c_act = jax.nn.silu(c)
    for l in range(DEPTH):
        mod = (c_act @ ada_w[l] + ada_b[l])[:, None, :]
        sh1, sc1, g1, sh2, sc2, g2, sh3, sc3, g3 = jnp.split(mod, N_ADA, axis=-1)
        u = modulate(rmsnorm(x, norm_g[l, 0]), sh1, sc1)
        x = x + 0.5 * (1.0 + g1) * swiglu(u, ffn_w1[l, 0], ffn_w3[l, 0], ffn_w2[l, 0])
        u = modulate(rmsnorm(x, norm_g[l, 1]), sh2, sc2)
        z = u @ w_in[l]
        (x_rnn, gate_rnn, q_lat, kv_lat, k_pe, q_dsa, k_dsa, v_dsa,
         q_idx, k_idx, w_idx, u_s5, gate_logits) = jnp.split(z, split_points, axis=-1)
        y_a = rglru_branch(x_rnn, gate_rnn, conv_w[l], conv_b[l], rg_wa[l], rg_ba[l],
                           rg_wx[l], rg_bx[l], rg_lambda[l])
        y_b = mla_branch(q_lat, kv_lat, k_pe, cs_mla, mla_q_norm[l], mla_w_uq[l],
                         mla_kv_norm[l], mla_w_ukv[l], mla_qk_gain[l])
        y_c = dsa_branch(q_dsa, k_dsa, v_dsa, q_idx, k_idx, w_idx, cs_dsa, cs_idx, dsa_qk_gain[l])
        y_d = s5_branch(u_s5, s5_lambda_re[l], s5_lambda_im[l], s5_log_dt[l], s5_b_re[l],
                        s5_b_im[l], s5_c_re[l], s5_c_im[l], s5_d[l], s5_w_glu[l], s5_b_glu[l])
        gates = jax.nn.sigmoid(gate_logits.reshape(b, t, N_BRANCH, D_MODEL))
        ys = [y_a, y_b, y_c, y_d]
        merged = gates[:, :, 0] * (y_a @ w_branch[l, 0])
        for n in range(1, N_BRANCH):
            merged = merged + gates[:, :, n] * (ys[n] @ w_branch[l, n])
        x = x + (1.0 + g2) * (merged @ w_out[l])
        u = modulate(rmsnorm(x, norm_g[l, 2]), sh3, sc3)
        x = x + 0.5 * (1.0 + g3) * swiglu(u, ffn_w1[l, 1], ffn_w3[l, 1], ffn_w2[l, 1])
    return x
```

```cpp
#include <hip/hip_runtime.h>
#include <hip/hip_cooperative_groups.h>
#include <stdint.h>
#include <stdio.h>
namespace cg = cooperative_groups;

#ifndef MEGA
#define MEGA 1
#endif
#ifndef PROBE_CFG
#define PROBE_CFG (255 | (1 << 8))
#endif

typedef unsigned short bf16_t;
using bf16x8 = __attribute__((ext_vector_type(8))) short;
using bf16x4 = __attribute__((ext_vector_type(4))) short;
using f32x16 = __attribute__((ext_vector_type(16))) float;
using u32x4 = __attribute__((ext_vector_type(4))) uint32_t;
using u32x2 = __attribute__((ext_vector_type(2))) uint32_t;

#define DI __device__ __forceinline__
#define MFMA32(a, b, c) __builtin_amdgcn_mfma_f32_32x32x16_bf16((a), (b), (c), 0, 0, 0)

constexpr int T = 32768, SEQ = 2048, NB = 16, D = 1024, DFF = 2816, ZW = 2944, DIN = 6984, NL = 4;
constexpr int NTHREADS = 256;
constexpr int NTHREADS_BLK = 512;
constexpr int Z_XRNN = 0, Z_GATE = 512, Z_QLAT = 1024, Z_KVLAT = 1280, Z_KPE = 1408, Z_QDSA = 1440, Z_KDSA = 1952,
              Z_VDSA = 2016, Z_QIDX = 2080, Z_KIDX = 2336, Z_WIDX = 2368, Z_US5 = 2376, Z_GATES = 2888;

constexpr size_t AL(size_t x) { return (x + 255) & ~(size_t)255; }
constexpr size_t OFF_WUP = 0;
constexpr size_t OFF_WDN = OFF_WUP + AL((size_t)2 * 5632 * 1024 * 2);
constexpr size_t OFF_WIN = OFF_WDN + AL((size_t)2 * 1024 * 2816 * 2);
constexpr size_t OFF_WBR = OFF_WIN + AL((size_t)7040 * 1024 * 2);
constexpr size_t OFF_WOUT = OFF_WBR + AL((size_t)4 * 1024 * 512 * 2);
constexpr size_t OFF_WUQ = OFF_WOUT + AL((size_t)1024 * 1024 * 2);
constexpr size_t OFF_WUKV = OFF_WUQ + AL((size_t)768 * 256 * 2);
constexpr size_t OFF_WRG = OFF_WUKV + AL((size_t)1024 * 128 * 2);
constexpr size_t OFF_WGLU = OFF_WRG + AL((size_t)8 * 128 * 64 * 2);
constexpr size_t OFF_S5AB = OFF_WGLU + AL((size_t)512 * 512 * 2);
constexpr size_t OFF_S5BB = OFF_S5AB + AL((size_t)32 * 64 * 4 * 4);
constexpr size_t OFF_S5CT = OFF_S5BB + AL((size_t)32 * 128 * 16 * 2);
constexpr size_t OFF_MOD = OFF_S5CT + AL((size_t)32 * 16 * 128 * 2);
constexpr size_t OFF_ROPE = OFF_MOD + AL((size_t)4 * 16 * 9216 * 4);
constexpr size_t OFF_U = OFF_ROPE + AL((size_t)T * 56 * 4);
constexpr size_t OFF_HZ = OFF_U + AL((size_t)T * 1024 * 2);
constexpr size_t OFF_XC = OFF_HZ + AL((size_t)T * ZW * 2);
constexpr size_t OFF_Q = OFF_XC + AL((size_t)T * 512 * 2);
constexpr size_t OFF_KNOPE = OFF_Q + AL((size_t)T * 768 * 2);
constexpr size_t OFF_VT = OFF_KNOPE + AL((size_t)T * 512 * 2);
constexpr size_t OFF_K = OFF_VT + AL((size_t)T * 512 * 2);
constexpr size_t OFF_KD = OFF_K + AL((size_t)T * 768 * 2);
constexpr size_t OFF_VTD = OFF_KD + AL((size_t)T * 64 * 2);
constexpr size_t OFF_KI = OFF_VTD + AL((size_t)T * 64 * 2);
constexpr size_t OFF_ENDS = OFF_KI + AL((size_t)T * 32 * 2);
constexpr size_t OFF_YS5 = OFF_ENDS + AL((size_t)16 * 32 * 32 * 128 * 4);
constexpr size_t OFF_LOGA = OFF_YS5 + AL((size_t)T * 512 * 2);
constexpr size_t OFF_INP = OFF_LOGA + AL((size_t)T * 512 * 2);
constexpr size_t OFF_YC = OFF_INP + AL((size_t)T * 512 * 2);
constexpr size_t OFF_YD = OFF_YC + AL((size_t)T * 512 * 2);
constexpr size_t OFF_TBL = OFF_YD + AL((size_t)T * 512 * 2);
constexpr size_t WS_NEED = OFF_TBL + 1024;
constexpr size_t OFF_YA = OFF_XC, OFF_YB = OFF_KNOPE, OFF_MERGED = OFF_HZ;

struct Params {
  const float* x; const float* c; const int* pos;
  const float *ada_w, *ada_b, *norm_g, *ffn_w1, *ffn_w3, *ffn_w2, *w_in, *conv_w, *conv_b, *rg_wa, *rg_ba, *rg_wx, *rg_bx,
      *rg_lambda, *mla_q_norm, *mla_w_uq, *mla_kv_norm, *mla_w_ukv, *mla_qk_gain, *dsa_qk_gain, *s5_lre, *s5_lim, *s5_logdt,
      *s5_bre, *s5_bim, *s5_cre, *s5_cim, *s5_d, *s5_wglu, *s5_bglu, *w_branch, *w_out;
  float* xo;
  char* ws;
};

DI int get_tid512() { int t = threadIdx.x; asm volatile("" : "+v"(t)); return t; }
DI int get_tid() { int t = threadIdx.x & 255; asm volatile("" : "+v"(t)); return t; }
DI int get_team() { int t = __builtin_amdgcn_readfirstlane(threadIdx.x >> 8); asm volatile("" : "+s"(t)); return t; }
DI int get_bid() { int b = blockIdx.x * 2 + __builtin_amdgcn_readfirstlane(threadIdx.x >> 8); asm volatile("" : "+s"(b)); return b; }
DI int get_nb() { int b = gridDim.x * 2; asm volatile("" : "+s"(b)); return b; }
DI int get_bid_real() { int b = blockIdx.x; asm volatile("" : "+s"(b)); return b; }
DI int get_nb_real() { int b = gridDim.x; asm volatile("" : "+s"(b)); return b; }
DI float xshfl_xor(float v, int m) { int l = (get_tid() & 63) ^ m; return __int_as_float(__builtin_amdgcn_ds_bpermute(l << 2, __float_as_int(v))); }
DI int xshfl_xor_i(int v, int m) { int l = (get_tid() & 63) ^ m; return __builtin_amdgcn_ds_bpermute(l << 2, v); }
DI float xshfl(float v, int src) { return __int_as_float(__builtin_amdgcn_ds_bpermute(src << 2, __float_as_int(v))); }
DI float bf2f(bf16_t v) { return __uint_as_float(((uint32_t)v) << 16); }
DI uint32_t pack2(float a, float b) { uint32_t r; asm("v_cvt_pk_bf16_f32 %0, %1, %2" : "=v"(r) : "v"(a), "v"(b)); return r; }
DI uint32_t pack2_mfma(float a, float b) { uint32_t r; asm volatile("v_cvt_pk_bf16_f32 %0, %1, %2\n\ts_nop 1" : "=v"(r) : "v"(a), "v"(b)); return r; }
DI bf16_t f2bf(float f) { return (bf16_t)(pack2(f, f) & 0xffffu); }
DI int crow(int i, int h) { return (i & 3) + 8 * (i >> 2) + 4 * h; }
DI float wave_sum(float v) {
#pragma unroll
  for (int o = 32; o > 0; o >>= 1) v += xshfl_xor(v, o);
  return v;
}
DI float wave_max(float v) {
#pragma unroll
  for (int o = 32; o > 0; o >>= 1) v = fmaxf(v, xshfl_xor(v, o));
  return v;
}
DI float sigmoidf_(float x) { return __builtin_amdgcn_rcpf(1.f + __expf(-x)); }
DI float gelu_tanh(float x) {
  float u = 0.7978845608028654f * (x + 0.044715f * x * x * x);
  float t = 1.f - 2.f * __builtin_amdgcn_rcpf(1.f + __expf(2.f * u));
  return 0.5f * x * (1.f + t);
}
DI void unpack8(u32x4 v, float* f) {
  f[0] = __uint_as_float(v.x << 16); f[1] = __uint_as_float(v.x & 0xffff0000u);
  f[2] = __uint_as_float(v.y << 16); f[3] = __uint_as_float(v.y & 0xffff0000u);
  f[4] = __uint_as_float(v.z << 16); f[5] = __uint_as_float(v.z & 0xffff0000u);
  f[6] = __uint_as_float(v.w << 16); f[7] = __uint_as_float(v.w & 0xffff0000u);
}
DI u32x4 pack8(const float* f) {
  u32x4 v; v.x = pack2(f[0], f[1]); v.y = pack2(f[2], f[3]); v.z = pack2(f[4], f[5]); v.w = pack2(f[6], f[7]); return v;
}
DI void sincos_rev(float ang, float* s, float* c) {
  double rev = (double)ang * 0.15915494309189535; rev -= rint(rev);
  float rv = (float)rev;
  *s = __builtin_amdgcn_sinf(rv); *c = __builtin_amdgcn_cosf(rv);
}

constexpr int LDT = 72;
constexpr int TILE_ELEMS = 128 * LDT;
constexpr int SMEM_BYTES = 4 * TILE_ELEMS * 2 + 1024;
constexpr int SMEM_BLK = 2 * SMEM_BYTES;

template <int NI>
struct Stage { u32x4 a[4]; u32x4 b[2 * NI]; };

template <bool SUMSQ, int UNR = 4, int NI = 2>
DI void gemm_main(const bf16_t* __restrict__ A, int lda, int ksa, const bf16_t* __restrict__ Bt, int ldb, int ksb, int K, bf16_t* sm,
                  f32x16 (&acc)[2][NI], float* rowstat) {
  const int tid = get_tid(), lane = tid & 63, wave = tid >> 6;
  const int wm = wave >> 1, wn = wave & 1, r = lane & 31, h = lane >> 5;
  const int lrow = tid >> 3, lkc = (tid & 7) * 8;
  const bf16_t* ga = A + (size_t)lrow * lda + lkc;
  const bf16_t* gb = Bt + (size_t)lrow * ldb + lkc;
  bf16_t* sA = sm;
  bf16_t* sB = sm + 2 * TILE_ELEMS;
  const int nk = K >> 6;
  float ss[4] = {0.f, 0.f, 0.f, 0.f};
  u32x4 r0a[4], r0b[2 * NI], r1a[4], r1b[2 * NI];
#define G_LOAD(RA, RB, KT)                                                                          \
  {                                                                                                 \
    const size_t ka_ = (size_t)(KT) * ksa, kb_ = (size_t)(KT) * ksb;                                \
    _Pragma("unroll") for (int i = 0; i < 4; ++i) RA[i] = *(const u32x4*)(ga + (size_t)(32 * i) * lda + ka_);      \
    _Pragma("unroll") for (int i = 0; i < 2 * NI; ++i) RB[i] = *(const u32x4*)(gb + (size_t)(32 * i) * ldb + kb_); \
  }
#define G_STORE(RA, RB, BUF)                                                                        \
  {                                                                                                 \
    bf16_t* nA_ = sA + (BUF) * TILE_ELEMS; bf16_t* nB_ = sB + (BUF) * TILE_ELEMS;                   \
    _Pragma("unroll") for (int i = 0; i < 4; ++i) {                                                 \
      *(u32x4*)(nA_ + (lrow + 32 * i) * LDT + lkc) = RA[i];                                         \
      if (SUMSQ) { float f_[8]; unpack8(RA[i], f_);                                                 \
        _Pragma("unroll") for (int e = 0; e < 8; ++e) ss[i] += f_[e] * f_[e]; }                     \
    }                                                                                               \
    _Pragma("unroll") for (int i = 0; i < 2 * NI; ++i) *(u32x4*)(nB_ + (lrow + 32 * i) * LDT + lkc) = RB[i]; \
  }
#define G_COMPUTE(BUF)                                                                              \
  {                                                                                                 \
    const bf16_t* cA = sA + (BUF) * TILE_ELEMS + (wm * 64 + r) * LDT + h * 8;                       \
    const bf16_t* cB = sB + (BUF) * TILE_ELEMS + (wn * 32 * NI + r) * LDT + h * 8;                  \
    _Pragma("unroll") for (int ks = 0; ks < 4; ++ks) {                                              \
      bf16x8 a0 = *(const bf16x8*)(cA + ks * 16);                                                   \
      bf16x8 a1 = *(const bf16x8*)(cA + 32 * LDT + ks * 16);                                        \
      _Pragma("unroll") for (int ni = 0; ni < NI; ++ni) {                                           \
        bf16x8 b0 = *(const bf16x8*)(cB + ni * 32 * LDT + ks * 16);                                 \
        acc[0][ni] = MFMA32(a0, b0, acc[0][ni]);                                                    \
        acc[1][ni] = MFMA32(a1, b0, acc[1][ni]);                                                    \
      }                                                                                             \
    }                                                                                               \
  }
  G_LOAD(r0a, r0b, 0);
  G_LOAD(r1a, r1b, (nk > 1 ? 1 : 0));
  __syncthreads();
  G_STORE(r0a, r0b, 0);
  __syncthreads();
  for (int kt = 0; kt < nk; kt += 2) {
    G_LOAD(r0a, r0b, (kt + 2 < nk ? kt + 2 : nk - 1));
    __builtin_amdgcn_sched_barrier(0);
    G_COMPUTE(0);
    __builtin_amdgcn_sched_barrier(0);
    if (kt + 1 < nk) G_STORE(r1a, r1b, 1);
    __syncthreads();
    if (kt + 1 < nk) {
      G_LOAD(r1a, r1b, (kt + 3 < nk ? kt + 3 : nk - 1));
      __builtin_amdgcn_sched_barrier(0);
      G_COMPUTE(1);
      __builtin_amdgcn_sched_barrier(0);
      if (kt + 2 < nk) G_STORE(r0a, r0b, 0);
      __syncthreads();
    }
  }
#undef G_LOAD
#undef G_STORE
#undef G_COMPUTE
  if (SUMSQ) {
#pragma unroll
    for (int i = 0; i < 4; ++i) {
      float v = ss[i];
      v += xshfl_xor(v, 1); v += xshfl_xor(v, 2); v += xshfl_xor(v, 4);
      if ((tid & 7) == 0) rowstat[lrow + 32 * i] = rsqrtf(v / (float)K + 1e-6f);
    }
    __syncthreads();
  }
}

DI size_t tiled_off(int row, int col, int nk) {
  return ((size_t)((row >> 7) * nk + (col >> 6)) << 13) + ((row & 127) << 6) + (col & 63);
}
DI void zero_acc(f32x16 (&acc)[2][2]) {
#pragma unroll
  for (int a = 0; a < 2; ++a)
#pragma unroll
    for (int b = 0; b < 2; ++b)
#pragma unroll
      for (int i = 0; i < 16; ++i) acc[a][b][i] = 0.f;
}
DI void gemm256_main(const bf16_t* __restrict__ A, const bf16_t* __restrict__ Bt, int K, bf16_t* sm, f32x16 (&acc)[4][2]) {
  const int tid = get_tid512(), lane = tid & 63, wave = tid >> 6;
  const int wm = wave >> 2, wn = wave & 3, r = lane & 31, h = lane >> 5;
  const int lrow = tid >> 3, lkc = (tid & 7) * 8;
  const int nk = K >> 6;
  const bf16_t* ga = A + (size_t)lrow * 64 + lkc;
  const bf16_t* gb = Bt + (size_t)lrow * 64 + lkc;
  const size_t rts = (size_t)nk << 13;
  constexpr int TE = 256 * LDT;
  bf16_t* sA = sm;
  bf16_t* sB = sm + 2 * TE;
  u32x4 r0a[4], r0b[4], r1a[4], r1b[4];
#define H_LOAD(RA, RB, KT)                                                                                   \
  {                                                                                                          \
    const size_t ko_ = (size_t)(KT) << 13;                                                                   \
    _Pragma("unroll") for (int i = 0; i < 4; ++i) {                                                          \
      RA[i] = *(const u32x4*)(ga + (i >> 1) * rts + (i & 1) * 4096 + ko_);                                   \
      RB[i] = *(const u32x4*)(gb + (i >> 1) * rts + (i & 1) * 4096 + ko_);                                   \
    }                                                                                                        \
  }
#define H_STORE(RA, RB, BUF)                                                                                 \
  {                                                                                                          \
    _Pragma("unroll") for (int i = 0; i < 4; ++i) {                                                          \
      *(u32x4*)(sA + (BUF) * TE + (lrow + 64 * i) * LDT + lkc) = RA[i];                                      \
      *(u32x4*)(sB + (BUF) * TE + (lrow + 64 * i) * LDT + lkc) = RB[i];                                      \
    }                                                                                                        \
  }
#define H_COMPUTE(BUF, KS0, KS1)                                                                             \
  {                                                                                                          \
    const bf16_t* cA = sA + (BUF) * TE + (wm * 128 + r) * LDT + h * 8;                                       \
    const bf16_t* cB = sB + (BUF) * TE + (wn * 64 + r) * LDT + h * 8;                                        \
    _Pragma("unroll") for (int ks = KS0; ks < KS1; ++ks) {                                                   \
      bf16x8 b0 = *(const bf16x8*)(cB + ks * 16);                                                            \
      bf16x8 b1 = *(const bf16x8*)(cB + 32 * LDT + ks * 16);                                                 \
      _Pragma("unroll") for (int mi = 0; mi < 4; ++mi) {                                                     \
        bf16x8 a0 = *(const bf16x8*)(cA + mi * 32 * LDT + ks * 16);                                          \
        acc[mi][0] = MFMA32(a0, b0, acc[mi][0]);                                                             \
        acc[mi][1] = MFMA32(a0, b1, acc[mi][1]);                                                             \
      }                                                                                                      \
    }                                                                                                        \
  }
  H_LOAD(r0a, r0b, 0);
  H_LOAD(r1a, r1b, (nk > 1 ? 1 : 0));
  __syncthreads();
  H_STORE(r0a, r0b, 0);
  __syncthreads();
  for (int kt = 0; kt < nk; kt += 2) {
    H_LOAD(r0a, r0b, (kt + 2 < nk ? kt + 2 : nk - 1));
    __builtin_amdgcn_sched_barrier(0);
    H_COMPUTE(0, 0, 2);
    __builtin_amdgcn_sched_barrier(0);
    if (kt + 1 < nk) H_STORE(r1a, r1b, 1);
    __builtin_amdgcn_sched_barrier(0);
    H_COMPUTE(0, 2, 4);
    __syncthreads();
    if (kt + 1 < nk) {
      H_LOAD(r1a, r1b, (kt + 3 < nk ? kt + 3 : nk - 1));
      __builtin_amdgcn_sched_barrier(0);
      H_COMPUTE(1, 0, 2);
      __builtin_amdgcn_sched_barrier(0);
      if (kt + 2 < nk) H_STORE(r0a, r0b, 0);
      __builtin_amdgcn_sched_barrier(0);
      H_COMPUTE(1, 2, 4);
      __syncthreads();
    }
  }
#undef H_LOAD
#undef H_STORE
#undef H_COMPUTE
}
DI void zero_acc42(f32x16 (&acc)[4][2]) {
#pragma unroll
  for (int a = 0; a < 4; ++a)
#pragma unroll
    for (int b = 0; b < 2; ++b)
#pragma unroll
      for (int i = 0; i < 16; ++i) acc[a][b][i] = 0.f;
}
struct TileIter256 {
  int x, i, step, ntn, total, tmw_l2, ngm_l2, tnw;
  DI TileIter256(int ntn_, int tnw_l2) {
    const int b = get_bid_real(), nb = get_nb_real();
    x = b & 7; i = b >> 3; step = nb >> 3; ntn = ntn_;
    tnw = 1 << tnw_l2; tmw_l2 = 5 - tnw_l2; ngm_l2 = 4 - tmw_l2;
    total = (32 << ngm_l2) * (ntn_ >> tnw_l2);
  }
  DI bool next(int& tm, int& tn) {
    if (i >= total) return false;
    const int sup = i >> 5, within = i & 31;
    tm = x * 16 + ((sup & ((1 << ngm_l2) - 1)) << tmw_l2) + (within & ((1 << tmw_l2) - 1));
    tn = (sup >> ngm_l2) * tnw + (within >> tmw_l2);
    i += step;
    return true;
  }
};

DI void tile_map(int t, int ntn, int& tm, int& tn) {
  int per = 8 * ntn; int g = t / per; int rem = t - g * per;
  tm = g * 8 + (rem & 7); tn = rem >> 3;
}
struct TileIter {
  int x, i, step, ntn, total;
  DI TileIter(int ntn_) {
    const int b = get_bid(), nb = get_nb();
    x = b & 7; i = b >> 3; step = nb >> 3; ntn = ntn_;
    total = 32 * ((ntn_ + 7) & ~7);
  }
  DI bool next(int& tm, int& tn) {
    while (i < total) {
      const int blk = i >> 6, within = i & 63;
      tm = x * 32 + (blk & 3) * 8 + (within & 7);
      tn = (blk >> 2) * 8 + (within >> 3);
      i += step;
      if (tn < ntn) return true;
    }
    return false;
  }
};

DI void phase_init(const Params& p, char* WS, char* smem) {
  const int tid = get_tid(), lane = tid & 63, wave = tid >> 6;
  const size_t gtid = (size_t)get_bid() * NTHREADS + tid, gsz = (size_t)get_nb() * NTHREADS;
  const float4* src = (const float4*)p.x; float4* dst = (float4*)p.xo;
  for (size_t i = gtid; i < (size_t)T * D / 4; i += gsz) dst[i] = src[i];
  float* rope = (float*)(WS + OFF_ROPE);
  for (size_t i = gtid; i < (size_t)T * 28; i += gsz) {
    int t = (int)(i / 28), j = (int)(i % 28);
    float ex; int co, so;
    if (j < 16) { ex = (float)(2 * j) / 32.f; co = j; so = 16 + j; }
    else if (j < 24) { ex = (float)(2 * (j - 16)) / 16.f; co = 32 + j - 16; so = 40 + j - 16; }
    else { ex = (float)(2 * (j - 24)) / 8.f; co = 48 + j - 24; so = 52 + j - 24; }
    float inv = exp2f(-ex * 18.931568569324174f);
    float ang = (float)p.pos[t] * inv;
    float s, c; sincos_rev(ang, &s, &c);
    rope[(size_t)t * 56 + co] = c; rope[(size_t)t * 56 + so] = s;
  }
  float* cact = (float*)smem;
  float* part = (float*)(smem + 16384);
  float* mod = (float*)(WS + OFF_MOD);
  for (int it = get_bid(); it < NL * 144; it += get_nb()) {
    const int l = it / 144, c0 = (it % 144) * 64;
    float acc[16];
#pragma unroll
    for (int b = 0; b < 16; ++b) acc[b] = 0.f;
    for (int kc = 0; kc < 4; ++kc) {
      __syncthreads();
      for (int e = tid; e < 4096; e += NTHREADS) {
        int kk = e >> 4, b = e & 15; float cv = p.c[b * 1024 + kc * 256 + kk];
        cact[e] = cv / (1.f + __expf(-cv));
      }
      __syncthreads();
      const float* wp = p.ada_w + ((size_t)l * 1024 + kc * 256 + wave * 64) * 9216 + c0 + lane;
#pragma unroll 8
      for (int kk = 0; kk < 64; ++kk) {
        float w = wp[(size_t)kk * 9216];
        const float4* cv = (const float4*)(cact + (wave * 64 + kk) * 16);
        float4 c0v = cv[0], c1v = cv[1], c2v = cv[2], c3v = cv[3];
        acc[0] += c0v.x * w; acc[1] += c0v.y * w; acc[2] += c0v.z * w; acc[3] += c0v.w * w;
        acc[4] += c1v.x * w; acc[5] += c1v.y * w; acc[6] += c1v.z * w; acc[7] += c1v.w * w;
        acc[8] += c2v.x * w; acc[9] += c2v.y * w; acc[10] += c2v.z * w; acc[11] += c2v.w * w;
        acc[12] += c3v.x * w; acc[13] += c3v.y * w; acc[14] += c3v.z * w; acc[15] += c3v.w * w;
      }
    }
    __syncthreads();
#pragma unroll
    for (int b = 0; b < 16; ++b) part[(wave * 16 + b) * 64 + lane] = acc[b];
    __syncthreads();
    for (int e = tid; e < 1024; e += NTHREADS) {
      int b = e >> 6, cl = e & 63;
      float s = part[(0 * 16 + b) * 64 + cl] + part[(1 * 16 + b) * 64 + cl] + part[(2 * 16 + b) * 64 + cl] +
                part[(3 * 16 + b) * 64 + cl] + p.ada_b[l * 9216 + c0 + cl];
      mod[((size_t)l * 16 + b) * 9216 + c0 + cl] = s;
    }
  }
}

DI void conv_tile(const float* __restrict__ src, int lds_, int jmax, bf16_t* __restrict__ dst, int ldd,
                          const float* __restrict__ scale, float* tile) {
  const int tid = get_tid();
  __syncthreads();
  {
    const int j = tid & 31, kb = tid >> 5;
#pragma unroll
    for (int i = 0; i < 8; ++i) {
      int kk = kb + 8 * i;
      float v = (j < jmax) ? src[(size_t)kk * lds_ + j] : 0.f;
      if (scale) v *= scale[kk];
      tile[kk * 33 + j] = v;
    }
  }
  __syncthreads();
  {
    const int j = tid >> 3, kq = (tid & 7) * 8;
    float f[8];
#pragma unroll
    for (int e = 0; e < 8; ++e) f[e] = tile[(kq + e) * 33 + j];
    *(u32x4*)(dst + (size_t)j * ldd + kq) = pack8(f);
  }
}

DI void phase_convert(const Params& p, char* WS, int l, char* smem) {
  float* tile = (float*)smem;
  char* ws = WS;
  constexpr int J0 = 2816, J1 = 2816, J2 = 1408, J3 = 1408, J4 = 3520, J5 = 1024, J6 = 512, J7 = 96, J8 = 64, J9 = 32, J10 = 128, J11 = 8;
  constexpr int E0 = J0, E1 = E0 + J1, E2 = E1 + J2, E3 = E2 + J3, E4 = E3 + J4, E5 = E4 + J5, E6 = E5 + J6, E7 = E6 + J7,
                E8 = E7 + J8, E9 = E8 + J9, E10 = E9 + J10, E11 = E10 + J11;
  for (int it = get_bid(); it < E11; it += get_nb()) {
    if (it < E1) {
      int a = it >= E0; int t = it - (a ? E0 : 0);
      int G = t >> 4, kt = t & 15; int grp = G >> 1, which = G & 1;
      const float* w = (which ? p.ffn_w3 : p.ffn_w1) + ((size_t)(l * 2 + a) * 1024 + kt * 64) * DFF + grp * 32;
      bf16_t* d = (bf16_t*)(ws + OFF_WUP) + (size_t)a * 5632 * 1024 + tiled_off(G * 32, kt * 64, 16);
      conv_tile(w, DFF, 32, d, 64, nullptr, tile);
    } else if (it < E3) {
      int a = it >= E2; int t = it - (a ? E2 : E1);
      int G = t / 44, kt = t % 44;
      const float* w = p.ffn_w2 + ((size_t)(l * 2 + a) * DFF + kt * 64) * 1024 + G * 32;
      bf16_t* d = (bf16_t*)(ws + OFF_WDN) + (size_t)a * 1024 * DFF + tiled_off(G * 32, kt * 64, 44);
      conv_tile(w, 1024, 32, d, 64, nullptr, tile);
    } else if (it < E4) {
      int t = it - E3; int G = t >> 4, kt = t & 15;
      const int scol = (G < 92) ? G * 32 : Z_GATES + (G - 92) * 32;
      const float* w = p.w_in + ((size_t)l * 1024 + kt * 64) * DIN + scol;
      bf16_t* d = (G < 92) ? (bf16_t*)(ws + OFF_WIN) + tiled_off(G * 32, kt * 64, 16)
                           : (bf16_t*)(ws + OFF_WIN) + (size_t)2944 * 1024 + tiled_off((G - 92) * 32, kt * 64, 16);
      conv_tile(w, DIN, 32, d, 64, nullptr, tile);
    } else if (it < E5) {
      int t = it - E4; int n = t >> 8; int rem = t & 255; int G = rem >> 3, kt = rem & 7;
      const float* w = p.w_branch + ((size_t)(l * 4 + n) * 512 + kt * 64) * 1024 + G * 32;
      bf16_t* d = (bf16_t*)(ws + OFF_WBR) + (size_t)n * 1024 * 512 + tiled_off(G * 32, kt * 64, 8);
      conv_tile(w, 1024, 32, d, 64, nullptr, tile);
    } else if (it < E6) {
      int t = it - E5; int G = t >> 4, kt = t & 15;
      const float* w = p.w_out + ((size_t)l * 1024 + kt * 64) * 1024 + G * 32;
      bf16_t* d = (bf16_t*)(ws + OFF_WOUT) + tiled_off(G * 32, kt * 64, 16);
      conv_tile(w, 1024, 32, d, 64, nullptr, tile);
    } else if (it < E7) {
      int t = it - E6; int G = t >> 2, kt = t & 3;
      const float* w = p.mla_w_uq + ((size_t)l * 256 + kt * 64) * 768 + G * 32;
      bf16_t* d = (bf16_t*)(ws + OFF_WUQ) + tiled_off(G * 32, kt * 64, 4);
      conv_tile(w, 768, 32, d, 64, p.mla_q_norm + l * 256 + kt * 64, tile);
    } else if (it < E8) {
      int t = it - E7; int G = t >> 1, kt = t & 1;
      const float* w = p.mla_w_ukv + ((size_t)l * 128 + kt * 64) * 1024 + G * 32;
      bf16_t* d = (bf16_t*)(ws + OFF_WUKV) + tiled_off(G * 32, kt * 64, 2);
      conv_tile(w, 1024, 32, d, 64, p.mla_kv_norm + l * 128 + kt * 64, tile);
    } else if (it < E9) {
      int t = it - E8; int hd = t >> 2, G = t & 3; int half = G >> 1, which = G & 1;
      const float* w = (which ? p.rg_wx : p.rg_wa) + ((size_t)(l * 8 + hd) * 64) * 64 + half * 32;
      bf16_t* d = (bf16_t*)(ws + OFF_WRG) + ((size_t)hd * 128 + G * 32) * 64;
      conv_tile(w, 64, 32, d, 64, nullptr, tile);
    } else if (it < E10) {
      int t = it - E9; int G = t >> 3, kt = t & 7;
      const float* w = p.s5_wglu + ((size_t)l * 512 + kt * 64) * 512 + G * 32;
      bf16_t* d = (bf16_t*)(ws + OFF_WGLU) + tiled_off(G * 32, kt * 64, 8);
      conv_tile(w, 512, 32, d, 64, nullptr, tile);
    } else {
      int idx = (it - E10) * 256 + get_tid();
      int g = idx >> 6, pst = idx & 63;
      float lr = p.s5_lre[(l * 32 + g) * 64 + pst], li = p.s5_lim[(l * 32 + g) * 64 + pst];
      float dt = expf(p.s5_logdt[l * 32 + g]);
      float mag = expf(lr * dt);
      float sn, cs; sincos_rev(li * dt, &sn, &cs);
      float abr = mag * cs, abi = mag * sn;
      float den = lr * lr + li * li;
      float nr = abr - 1.f, ni = abi;
      float fr = (nr * lr + ni * li) / den, fi = (ni * lr - nr * li) / den;
      float pr = abr, pi = abi;
#pragma unroll
      for (int q = 0; q < 6; ++q) { float tr = pr * pr - pi * pi, ti = pr * pi; ti = ti + ti; pr = tr; pi = ti; }
      float* ab = (float*)(ws + OFF_S5AB) + (size_t)idx * 4;
      ab[0] = abr; ab[1] = abi; ab[2] = pr; ab[3] = pi;
      const float* br = p.s5_bre + ((size_t)(l * 32 + g) * 64 + pst) * 16;
      const float* bi = p.s5_bim + ((size_t)(l * 32 + g) * 64 + pst) * 16;
      bf16_t* bb = (bf16_t*)(ws + OFF_S5BB) + (size_t)g * 128 * 16;
#pragma unroll
      for (int j = 0; j < 16; ++j) {
        float r_ = br[j], i_ = bi[j];
        bb[(pst) * 16 + j] = f2bf(fr * r_ - fi * i_);
        bb[(64 + pst) * 16 + j] = f2bf(fr * i_ + fi * r_);
      }
      bf16_t* ct = (bf16_t*)(ws + OFF_S5CT) + (size_t)g * 16 * 128;
#pragma unroll
      for (int j = 0; j < 16; ++j) {
        ct[j * 128 + pst] = f2bf(p.s5_cre[((size_t)(l * 32 + g) * 16 + j) * 64 + pst]);
        ct[j * 128 + 64 + pst] = f2bf(-p.s5_cim[((size_t)(l * 32 + g) * 16 + j) * 64 + pst]);
      }
    }
  }
}

DI void phase_norm(const Params& p, char* WS, int l, int which) {
  const int tid = get_tid(), lane = tid & 63, wave = tid >> 6;
  const float* g = p.norm_g + (l * 3 + which) * 1024;
  const float* mod = (const float*)(WS + OFF_MOD) + (size_t)l * 16 * 9216;
  bf16_t* U = (bf16_t*)(WS + OFF_U);
  const float* xo = p.xo;
  for (int row0 = (get_bid() * 4 + wave) * 4; row0 < T; row0 += get_nb() * 16) {
    float4 v[4][4]; float ss[4];
#pragma unroll
    for (int q = 0; q < 4; ++q) {
      const float4* xr = (const float4*)(xo + (size_t)(row0 + q) * 1024);
#pragma unroll
      for (int i = 0; i < 4; ++i) v[q][i] = xr[lane + 64 * i];
    }
#pragma unroll
    for (int q = 0; q < 4; ++q) {
      float a = 0.f;
#pragma unroll
      for (int i = 0; i < 4; ++i) a += v[q][i].x * v[q][i].x + v[q][i].y * v[q][i].y + v[q][i].z * v[q][i].z + v[q][i].w * v[q][i].w;
      ss[q] = a;
    }
#pragma unroll
    for (int o = 32; o > 0; o >>= 1) {
#pragma unroll
      for (int q = 0; q < 4; ++q) ss[q] += xshfl_xor(ss[q], o);
    }
    const int b = row0 >> 11;
    const float* sh = mod + (size_t)b * 9216 + (3 * which) * 1024;
    const float* sc = sh + 1024;
#pragma unroll
    for (int i = 0; i < 4; ++i) {
      const int c = (lane + 64 * i) * 4;
      float4 gg = *(const float4*)(g + c), s4 = *(const float4*)(sh + c), c4 = *(const float4*)(sc + c);
      const float m0 = gg.x * (1.f + c4.x), m1 = gg.y * (1.f + c4.y), m2 = gg.z * (1.f + c4.z), m3 = gg.w * (1.f + c4.w);
#pragma unroll
      for (int q = 0; q < 4; ++q) {
        const float rstd = rsqrtf(ss[q] * (1.f / 1024.f) + 1e-6f);
        u32x2 o;
        o.x = pack2(v[q][i].x * rstd * m0 + s4.x, v[q][i].y * rstd * m1 + s4.y);
        o.y = pack2(v[q][i].z * rstd * m2 + s4.z, v[q][i].w * rstd * m3 + s4.w);
        *(u32x2*)(U + tiled_off(row0 + q, c, 16)) = o;
      }
    }
  }
}

DI void phase_ffn_up(const Params& p, char* WS, int a, char* smem) {
  const int tid = get_tid512(), lane = tid & 63, wave = tid >> 6, wm = wave >> 2, wn = wave & 3, r = lane & 31, h = lane >> 5;
  const bf16_t* U = (const bf16_t*)(WS + OFF_U);
  const bf16_t* W = (const bf16_t*)(WS + OFF_WUP) + (size_t)a * 5632 * 1024;
  bf16_t* H = (bf16_t*)(WS + OFF_HZ);
  TileIter256 ti(22, 1);
  for (int tm, tn; ti.next(tm, tn);) {
    f32x16 acc[4][2]; zero_acc42(acc);
    gemm256_main(U + ((size_t)tm * 2 * 16 << 13), W + ((size_t)tn * 2 * 16 << 13), 1024, (bf16_t*)smem, acc);
    {
      constexpr int SLD = 128 + 8;
      bf16_t* st = (bf16_t*)smem;
#pragma unroll
      for (int mi = 0; mi < 4; ++mi)
#pragma unroll
        for (int i = 0; i < 16; ++i) {
          float v1 = acc[mi][0][i], v3 = acc[mi][1][i];
          st[(wm * 128 + mi * 32 + crow(i, h)) * SLD + wn * 32 + r] = f2bf(v1 * sigmoidf_(v1) * v3);
        }
      __syncthreads();
#pragma unroll
      for (int q = 0; q < 8; ++q) {
        const int c = get_tid512() + 512 * q;
        const int row = c >> 4, cc = (c & 15) * 8;
        u32x4 v = *(const u32x4*)(st + row * SLD + cc);
        *(u32x4*)(H + tiled_off(tm * 256 + row, tn * 128 + cc, 44)) = v;
      }
    }
  }
}

DI void phase_gemm_resid(const Params& p, char* WS, const bf16_t* A, const bf16_t* Bt, int K, const float* gmod,
                         float coef, char* smem) {
  const int tid = get_tid512(), lane = tid & 63, wave = tid >> 6, wm = wave >> 2, wn = wave & 3, r = lane & 31, h = lane >> 5;
  float* xo = p.xo;
  TileIter256 ti(4, 2);
  for (int tm, tn; ti.next(tm, tn);) {
    f32x16 acc[4][2]; zero_acc42(acc);
    gemm256_main(A + ((size_t)tm * 2 * (K >> 6) << 13), Bt + ((size_t)tn * 2 * (K >> 6) << 13), K, (bf16_t*)smem, acc);
    const int b = (tm * 256) >> 11;
#pragma unroll
    for (int ni = 0; ni < 2; ++ni) {
      const int col = tn * 256 + wn * 64 + ni * 32 + r;
      const float gs = coef * (1.f + gmod[(size_t)b * 9216 + col]);
#pragma unroll
      for (int mi = 0; mi < 4; ++mi)
#pragma unroll
        for (int i = 0; i < 16; ++i) {
          int row = tm * 256 + wm * 128 + mi * 32 + crow(i, h);
          float* xp = xo + (size_t)row * 1024 + col;
          *xp = *xp + gs * acc[mi][ni][i];
        }
    }
  }
}

DI void phase_inproj(const Params& p, char* WS, char* smem) {
  const int tid = get_tid512(), lane = tid & 63, wave = tid >> 6, wm = wave >> 2, wn = wave & 3, r = lane & 31, h = lane >> 5;
  const bf16_t* U = (const bf16_t*)(WS + OFF_U);
  const bf16_t* W = (const bf16_t*)(WS + OFF_WIN);
  bf16_t* Z = (bf16_t*)(WS + OFF_HZ);
  TileIter256 ti(12, 2);
  for (int tm, tn; ti.next(tm, tn);) {
    f32x16 acc[4][2]; zero_acc42(acc);
    gemm256_main(U + ((size_t)tm * 2 * 16 << 13), W + ((size_t)tn * 2 * 16 << 13), 1024, (bf16_t*)smem, acc);
    {
      constexpr int SLD = 256 + 8;
      bf16_t* st = (bf16_t*)smem;
#pragma unroll
      for (int ni = 0; ni < 2; ++ni)
#pragma unroll
        for (int mi = 0; mi < 4; ++mi)
#pragma unroll
          for (int i = 0; i < 16; ++i)
            st[(wm * 128 + mi * 32 + crow(i, h)) * SLD + wn * 64 + ni * 32 + r] = f2bf(acc[mi][ni][i]);
      __syncthreads();
#pragma unroll
      for (int q = 0; q < 16; ++q) {
        const int c = get_tid512() + 512 * q;
        const int row = c >> 5, cc = (c & 31) * 8;
        if (tn * 256 + cc < ZW) {
          u32x4 v = *(const u32x4*)(st + row * SLD + cc);
          *(u32x4*)(Z + (size_t)(tm * 256 + row) * ZW + tn * 256 + cc) = v;
        }
      }
    }
  }
}

DI void phase_merge(const Params& p, char* WS, char* smem) {
  const int tid = get_tid(), lane = tid & 63, wave = tid >> 6, wm = wave >> 1, wn = wave & 1, r = lane & 31, h = lane >> 5;
  const bf16_t* U = (const bf16_t*)(WS + OFF_U);
  const bf16_t* WG = (const bf16_t*)(WS + OFF_WIN) + (size_t)2944 * 1024;
  const bf16_t* WB = (const bf16_t*)(WS + OFF_WBR);
  bf16_t* M = (bf16_t*)(WS + OFF_MERGED);
  TileIter ti(16);
  for (int tm, tn; ti.next(tm, tn);) {
    f32x16 am[2][1];
#pragma unroll
    for (int i = 0; i < 16; ++i) { am[0][0][i] = 0.f; am[1][0][i] = 0.f; }
#pragma unroll 1
    for (int n = 0; n < 4; ++n) {
      const size_t yoff = (n == 0) ? OFF_YA : (n == 1) ? OFF_YB : (n == 2) ? OFF_YC : OFF_YD;
      const bf16_t* Y = (const bf16_t*)(WS + yoff);
      f32x16 ag[2][1], ab[2][1];
#pragma unroll
      for (int i = 0; i < 16; ++i) { ag[0][0][i] = 0.f; ag[1][0][i] = 0.f; ab[0][0][i] = 0.f; ab[1][0][i] = 0.f; }
      gemm_main<false, 4, 1>(U + ((size_t)tm * 16 << 13), 64, 8192,
                             WG + ((size_t)((n * 1024 + tn * 64) >> 7) * 16 << 13) + (tn & 1) * 64 * 64, 64, 8192, 1024,
                             (bf16_t*)smem, ag, nullptr);
      gemm_main<false, 4, 1>(Y + (size_t)tm * 128 * 512, 512, 64, WB + (size_t)n * 1024 * 512 + ((size_t)(tn >> 1) * 8 << 13) + (tn & 1) * 64 * 64, 64, 8192, 512, (bf16_t*)smem, ab, nullptr);
#pragma unroll
      for (int x = 0; x < 2; ++x)
#pragma unroll
        for (int i = 0; i < 16; ++i) am[x][0][i] += sigmoidf_(ag[x][0][i]) * ab[x][0][i];
    }
    {
      constexpr int SLD = 64 + 8;
      bf16_t* st = (bf16_t*)smem;
#pragma unroll
      for (int mi = 0; mi < 2; ++mi)
#pragma unroll
        for (int i = 0; i < 16; ++i) st[(wm * 64 + mi * 32 + crow(i, h)) * SLD + wn * 32 + r] = f2bf(am[mi][0][i]);
      __syncthreads();
#pragma unroll
      for (int q = 0; q < 4; ++q) {
        const int c = get_tid() + 256 * q;
        const int row = c >> 3, cc = (c & 7) * 8;
        u32x4 v = *(const u32x4*)(st + row * SLD + cc);
        *(u32x4*)(M + tiled_off(tm * 128 + row, tn * 64 + cc, 16)) = v;
      }
    }
  }
}

template <bool PASS2>
DI void s5_item(const Params& p, char* WS, int l, int item, char* smem) {
  const int tid = get_tid(), lane = tid & 63, wave = tid >> 6, r = lane & 31, h = lane >> 5;
  const int b = item >> 5, ck = item & 31;
  const int t0 = b * SEQ + ck * 64;
  const bf16_t* Z = (const bf16_t*)(WS + OFF_HZ);
  const float* AB = (const float*)(WS + OFF_S5AB);
  const bf16_t* BB = (const bf16_t*)(WS + OFF_S5BB);
  const bf16_t* CT = (const bf16_t*)(WS + OFF_S5CT);
  float* ENDS = (float*)(WS + OFF_ENDS);
  bf16_t* YS = (bf16_t*)(WS + OFF_YS5);
  constexpr int XLD = 136;
  bf16_t* img = (bf16_t*)smem + (size_t)wave * 64 * XLD;
  const int tokA = 32 * ((r >> 2) & 1) + (r & 3) + 4 * (r >> 3);
  for (int gi = 0; gi < 8; ++gi) {
    const int g = wave * 8 + gi;
    bf16x8 af[2];
#pragma unroll
    for (int m = 0; m < 2; ++m) af[m] = *(const bf16x8*)(Z + (size_t)(t0 + tokA + 16 * m) * ZW + Z_US5 + g * 16 + 8 * h);
    if (PASS2) __syncthreads();
#pragma unroll 1
    for (int sb = 0; sb < 2; ++sb) {
      const int st = sb * 32 + r;
      const float4 abv = *(const float4*)(AB + (size_t)(g * 64 + st) * 4);
      const float ar = abv.x, ai = abv.y;
      bf16x8 bfr = *(const bf16x8*)(BB + ((size_t)g * 128 + st) * 16 + 8 * h);
      bf16x8 bfi = *(const bf16x8*)(BB + ((size_t)g * 128 + 64 + st) * 16 + 8 * h);
      f32x16 zr;
#pragma unroll
      for (int i = 0; i < 16; ++i) zr[i] = 0.f;
      f32x16 bur0 = MFMA32(af[0], bfr, zr), bur1 = MFMA32(af[1], bfr, zr);
      f32x16 bui0 = MFMA32(af[0], bfi, zr), bui1 = MFMA32(af[1], bfi, zr);
      float cr = 0.f, ci = 0.f;
      if (PASS2) {
        const float a64r = abv.z, a64i = abv.w;
        for (int c2 = 0; c2 < ck; ++c2) {
          const float* e = ENDS + (((size_t)(b * 32 + c2) * 32 + g) * 128);
          float er = e[st], ei = e[64 + st];
          float nr = a64r * cr - a64i * ci + er, ni = a64r * ci + a64i * cr + ei;
          cr = nr; ci = ni;
        }
      }
      float xr = cr, xi = ci;
#pragma unroll
      for (int i = 0; i < 16; ++i) { float nr = ar * xr - ai * xi + bur0[i], ni = ar * xi + ai * xr + bui0[i]; xr = nr; xi = ni; }
#pragma unroll
      for (int i = 0; i < 16; ++i) { float nr = ar * xr - ai * xi + bur1[i], ni = ar * xi + ai * xr + bui1[i]; xr = nr; xi = ni; }
      float er0 = xshfl(xr, r), ei0 = xshfl(xi, r);
      xr = h ? er0 : cr; xi = h ? ei0 : ci;
#pragma unroll
      for (int i = 0; i < 16; ++i) {
        float nr = ar * xr - ai * xi + bur0[i], ni = ar * xi + ai * xr + bui0[i]; xr = nr; xi = ni;
        if (PASS2) { int tk = 32 * h + i; img[tk * XLD + st] = f2bf(xr); img[tk * XLD + 64 + st] = f2bf(xi); }
      }
#pragma unroll
      for (int i = 0; i < 16; ++i) {
        float nr = ar * xr - ai * xi + bur1[i], ni = ar * xi + ai * xr + bui1[i]; xr = nr; xi = ni;
        if (PASS2) { int tk = 32 * h + 16 + i; img[tk * XLD + st] = f2bf(xr); img[tk * XLD + 64 + st] = f2bf(xi); }
      }
      if (!PASS2) {
        if (h) { float* e = ENDS + (((size_t)(b * 32 + ck) * 32 + g) * 128); e[st] = xr; e[64 + st] = xi; }
      }
    }
    if (PASS2) {
      __syncthreads();
      f32x16 y0, y1;
#pragma unroll
      for (int i = 0; i < 16; ++i) { y0[i] = 0.f; y1[i] = 0.f; }
#pragma unroll
      for (int s = 0; s < 8; ++s) {
        bf16x8 cf;
        if (r < 16) cf = *(const bf16x8*)(CT + ((size_t)g * 16 + r) * 128 + 16 * s + 8 * h);
        else {
#pragma unroll
          for (int j = 0; j < 8; ++j) cf[j] = 0;
        }
        bf16x8 a0 = *(const bf16x8*)(img + (r)*XLD + 16 * s + 8 * h);
        bf16x8 a1 = *(const bf16x8*)(img + (32 + r) * XLD + 16 * s + 8 * h);
        y0 = MFMA32(a0, cf, y0); y1 = MFMA32(a1, cf, y1);
      }
      if (r < 16) {
        const int ch = g * 16 + r;
        const float dd = p.s5_d[l * 512 + ch];
#pragma unroll
        for (int i = 0; i < 16; ++i) {
          int tk = crow(i, h);
          float u0 = bf2f(Z[(size_t)(t0 + tk) * ZW + Z_US5 + ch]);
          float u1 = bf2f(Z[(size_t)(t0 + 32 + tk) * ZW + Z_US5 + ch]);
          YS[(size_t)(t0 + tk) * 512 + ch] = f2bf(gelu_tanh(y0[i] + dd * u0));
          YS[(size_t)(t0 + 32 + tk) * 512 + ch] = f2bf(gelu_tanh(y1[i] + dd * u1));
        }
      }
    }
  }
}

DI void dsa_prep_qk(const Params& p, char* WS, int l, int bitem) {
  const int idx = bitem * NTHREADS + get_tid();
  if (idx >= T * 9) return;
  const int t = idx / 9, role = idx % 9;
  bf16_t* Z = (bf16_t*)(WS + OFF_HZ);
  const float* rope = (const float*)(WS + OFF_ROPE) + (size_t)t * 56;
  bf16_t* src = Z + (size_t)t * ZW + (role < 8 ? Z_QDSA + role * 64 : Z_KDSA);
  bf16_t* dst = (role < 8) ? src : (bf16_t*)(WS + OFF_KD) + (size_t)t * 64;
  const float* gain = p.dsa_qk_gain + (l * 2 + (role < 8 ? 0 : 1)) * 64;
  float v[64];
#pragma unroll
  for (int q = 0; q < 8; ++q) unpack8(*(const u32x4*)(src + q * 8), v + q * 8);
  float ss = 0.f;
#pragma unroll
  for (int j = 0; j < 64; ++j) ss += v[j] * v[j];
  const float rs = rsqrtf(ss * (1.f / 64.f) + 1e-6f);
#pragma unroll
  for (int j = 0; j < 64; ++j) v[j] = v[j] * rs * gain[j];
#pragma unroll
  for (int i = 0; i < 8; ++i) {
    float c = rope[32 + i], s = rope[40 + i];
    float x1 = v[i], x2 = v[8 + i];
    v[i] = x1 * c - x2 * s; v[8 + i] = x2 * c + x1 * s;
  }
#pragma unroll
  for (int q = 0; q < 8; ++q) *(u32x4*)(dst + q * 8) = pack8(v + q * 8);
}
DI void dsa_prep_idx(const Params& p, char* WS, int bitem) {
  const int idx = bitem * NTHREADS + get_tid();
  if (idx >= T * 9) return;
  const int t = idx / 9, role = idx % 9;
  bf16_t* Z = (bf16_t*)(WS + OFF_HZ);
  const float* rope = (const float*)(WS + OFF_ROPE) + (size_t)t * 56;
  bf16_t* src = Z + (size_t)t * ZW + (role < 8 ? Z_QIDX + role * 32 : Z_KIDX);
  bf16_t* dst = (role < 8) ? src : (bf16_t*)(WS + OFF_KI) + (size_t)t * 32;
  float v[32];
#pragma unroll
  for (int q = 0; q < 4; ++q) unpack8(*(const u32x4*)(src + q * 8), v + q * 8);
#pragma unroll
  for (int i = 0; i < 4; ++i) {
    float c = rope[48 + i], s = rope[52 + i];
    float x1 = v[i], x2 = v[4 + i];
    v[i] = x1 * c - x2 * s; v[4 + i] = x2 * c + x1 * s;
  }
#pragma unroll
  for (int q = 0; q < 4; ++q) *(u32x4*)(dst + q * 8) = pack8(v + q * 8);
}
DI void dsa_prep_vt(const Params& p, char* WS, int item, char* smem) {
  const int tid = get_tid();
  const int b = item >> 5, ck = item & 31;
  const bf16_t* Z = (const bf16_t*)(WS + OFF_HZ);
  bf16_t* VTD = (bf16_t*)(WS + OFF_VTD);
  bf16_t* tile = (bf16_t*)smem;
  __syncthreads();
  {
    const int tt = tid >> 2, dq = (tid & 3) * 16;
    const bf16_t* s = Z + (size_t)(b * SEQ + ck * 64 + tt) * ZW + Z_VDSA + dq;
    u32x4 a = *(const u32x4*)s, c = *(const u32x4*)(s + 8);
    uint32_t w[8] = {a.x, a.y, a.z, a.w, c.x, c.y, c.z, c.w};
#pragma unroll
    for (int e = 0; e < 8; ++e) *(uint32_t*)(tile + tt * 66 + dq + 2 * e) = w[e];
  }
  __syncthreads();
  {
    const int d = tid >> 2, tq = (tid & 3) * 16;
    uint32_t w[8];
#pragma unroll
    for (int e = 0; e < 8; ++e) w[e] = (uint32_t)tile[(tq + 2 * e) * 66 + d] | ((uint32_t)tile[(tq + 2 * e + 1) * 66 + d] << 16);
    bf16_t* o = VTD + ((size_t)b * 64 + d) * SEQ + ck * 64 + tq;
    *(u32x4*)o = u32x4{w[0], w[1], w[2], w[3]};
    *(u32x4*)(o + 8) = u32x4{w[4], w[5], w[6], w[7]};
  }
}

DI void rg_conv(const Params& p, char* WS, int l, int bitem) {
  const int idx = bitem * NTHREADS + get_tid();
  const int t = idx >> 6, c0 = (idx & 63) * 8;
  const int tl = t & (SEQ - 1);
  const bf16_t* Z = (const bf16_t*)(WS + OFF_HZ);
  float acc[8];
#pragma unroll
  for (int e = 0; e < 8; ++e) acc[e] = p.conv_b[l * 512 + c0 + e];
#pragma unroll
  for (int w = 0; w < 4; ++w) {
    int dt = w - 3;
    if (tl + dt >= 0) {
      float f[8]; unpack8(*(const u32x4*)(Z + (size_t)(t + dt) * ZW + Z_XRNN + c0), f);
#pragma unroll
      for (int e = 0; e < 8; ++e) acc[e] += f[e] * p.conv_w[(l * 4 + w) * 512 + c0 + e];
    }
  }
  *(u32x4*)((bf16_t*)(WS + OFF_XC) + (size_t)t * 512 + c0) = pack8(acc);
}

DI void mla_up_tile(const Params& p, char* WS, int t, bool kv, char* smem) {
  const int tid = get_tid(), lane = tid & 63, wave = tid >> 6, wm = wave >> 1, wn = wave & 1, r = lane & 31, h = lane >> 5;
  const bf16_t* Z = (const bf16_t*)(WS + OFF_HZ);
  float* rowstat = (float*)(smem + 4 * TILE_ELEMS * 2);
  f32x16 acc[2][2]; zero_acc(acc);
  if (!kv) {
    const int tm = t / 6, tn = t % 6;
    gemm_main<true>(Z + (size_t)tm * 128 * ZW + Z_QLAT, ZW, 64, (const bf16_t*)(WS + OFF_WUQ) + ((size_t)tn * 4 << 13), 64, 8192, 256,
                    (bf16_t*)smem, acc, rowstat);
    bf16_t* Q = (bf16_t*)(WS + OFF_Q);
#pragma unroll
    for (int mi = 0; mi < 2; ++mi)
#pragma unroll
      for (int ni = 0; ni < 2; ++ni)
#pragma unroll
        for (int i = 0; i < 16; ++i) {
          int rl = wm * 64 + mi * 32 + crow(i, h);
          int col = tn * 128 + wn * 64 + ni * 32 + r;
          Q[(size_t)(tm * 128 + rl) * 768 + col] = f2bf(acc[mi][ni][i] * rowstat[rl]);
        }
  } else {
    const int tm = t >> 3, hd = t & 7;
    gemm_main<true>(Z + (size_t)tm * 128 * ZW + Z_KVLAT, ZW, 64, (const bf16_t*)(WS + OFF_WUKV) + ((size_t)hd * 2 << 13), 64, 8192, 128,
                    (bf16_t*)smem, acc, rowstat);
    if (wn == 0) {
      bf16_t* KN = (bf16_t*)(WS + OFF_KNOPE);
#pragma unroll
      for (int mi = 0; mi < 2; ++mi)
#pragma unroll
        for (int ni = 0; ni < 2; ++ni)
#pragma unroll
          for (int i = 0; i < 16; ++i) {
            int rl = wm * 64 + mi * 32 + crow(i, h);
            KN[(size_t)(tm * 128 + rl) * 512 + hd * 64 + ni * 32 + r] = f2bf(acc[mi][ni][i] * rowstat[rl]);
          }
    } else {
      bf16_t* VT = (bf16_t*)(WS + OFF_VT);
      const int b = (tm * 128) >> 11, tl0 = (tm * 128) & (SEQ - 1);
#pragma unroll
      for (int mi = 0; mi < 2; ++mi)
#pragma unroll
        for (int ni = 0; ni < 2; ++ni)
#pragma unroll
          for (int g4 = 0; g4 < 4; ++g4) {
            int rl = wm * 64 + mi * 32 + 8 * g4 + 4 * h;
            u32x2 o;
            o.x = pack2(acc[mi][ni][4 * g4] * rowstat[rl], acc[mi][ni][4 * g4 + 1] * rowstat[rl + 1]);
            o.y = pack2(acc[mi][ni][4 * g4 + 2] * rowstat[rl + 2], acc[mi][ni][4 * g4 + 3] * rowstat[rl + 3]);
            *(u32x2*)(VT + ((size_t)(b * 8 + hd) * 64 + ni * 32 + r) * SEQ + tl0 + rl) = o;
          }
    }
  }
}

DI void mla_elem(const Params& p, char* WS, int l, int bitem) {
  const int idx = bitem * NTHREADS + get_tid();
  const int t = idx >> 4, role = idx & 15;
  const int hd = role & 7; const bool isk = role >= 8;
  bf16_t* Q = (bf16_t*)(WS + OFF_Q);
  const bf16_t* Z = (const bf16_t*)(WS + OFF_HZ);
  const bf16_t* KN = (const bf16_t*)(WS + OFF_KNOPE);
  bf16_t* K = (bf16_t*)(WS + OFF_K);
  const float* rope = (const float*)(WS + OFF_ROPE) + (size_t)t * 56;
  const bf16_t* s0 = isk ? Z + (size_t)t * ZW + Z_KPE : Q + (size_t)t * 768 + hd * 96;
  const bf16_t* s1 = isk ? KN + (size_t)t * 512 + hd * 64 : Q + (size_t)t * 768 + hd * 96 + 32;
  bf16_t* dst = isk ? K + (size_t)t * 768 + hd * 96 : Q + (size_t)t * 768 + hd * 96;
  const float* gain = p.mla_qk_gain + (l * 2 + (isk ? 1 : 0)) * 96;
  float v[96];
#pragma unroll
  for (int q = 0; q < 4; ++q) unpack8(*(const u32x4*)(s0 + q * 8), v + q * 8);
#pragma unroll
  for (int q = 0; q < 8; ++q) unpack8(*(const u32x4*)(s1 + q * 8), v + 32 + q * 8);
  float ss = 0.f;
#pragma unroll
  for (int j = 0; j < 96; ++j) ss += v[j] * v[j];
  const float rs = rsqrtf(ss * (1.f / 96.f) + 1e-6f);
#pragma unroll
  for (int j = 0; j < 96; ++j) v[j] = v[j] * rs * gain[j];
#pragma unroll
  for (int i = 0; i < 16; ++i) {
    float c = rope[i], s = rope[16 + i];
    float x1 = v[i], x2 = v[16 + i];
    v[i] = x1 * c - x2 * s; v[16 + i] = x2 * c + x1 * s;
  }
#pragma unroll
  for (int q = 0; q < 12; ++q) *(u32x4*)(dst + q * 8) = pack8(v + q * 8);
}

DI void rg_gate_tile(const Params& p, char* WS, int l, int t, char* smem) {
  const int tid = get_tid(), lane = tid & 63, wave = tid >> 6, wm = wave >> 1, wn = wave & 1, r = lane & 31, h = lane >> 5;
  const int tm = t >> 3, hd = t & 7;
  const bf16_t* XC = (const bf16_t*)(WS + OFF_XC);
  f32x16 acc[2][2]; zero_acc(acc);
  gemm_main<false>(XC + (size_t)tm * 128 * 512 + hd * 64, 512, 64, (const bf16_t*)(WS + OFF_WRG) + (size_t)hd * 128 * 64, 64, 64, 64,
                   (bf16_t*)smem, acc, nullptr);
  const int ch = hd * 64 + wn * 32 + r;
  const float ba = p.rg_ba[l * 512 + ch], bx = p.rg_bx[l * 512 + ch];
  const float lam = p.rg_lambda[l * 512 + ch];
  const float sp = log1pf(__expf(-lam));
  bf16_t* LOGA = (bf16_t*)(WS + OFF_LOGA);
  bf16_t* INP = (bf16_t*)(WS + OFF_INP);
#pragma unroll
  for (int mi = 0; mi < 2; ++mi)
#pragma unroll
    for (int i = 0; i < 16; ++i) {
      int row = tm * 128 + wm * 64 + mi * 32 + crow(i, h);
      float rg = sigmoidf_(acc[mi][0][i] + ba), ig = sigmoidf_(acc[mi][1][i] + bx);
      float loga = -8.f * rg * sp;
      float mult = sqrtf(fmaxf(1.f - __expf(2.f * loga), 0.f));
      float xc = bf2f(XC[(size_t)row * 512 + ch]);
      LOGA[(size_t)row * 512 + ch] = f2bf(loga);
      INP[(size_t)row * 512 + ch] = f2bf(mult * ig * xc);
    }
}

DI void rg_scan_item(const Params& p, char* WS, int item, char* smem) {
  const int tid = get_tid(), c8 = tid & 7, seg = tid >> 3;
  const int b = item >> 3, hd = item & 7;
  const int ch = hd * 64 + c8 * 8;
  const bf16_t* LOGA = (const bf16_t*)(WS + OFF_LOGA) + (size_t)b * SEQ * 512 + ch;
  const bf16_t* INP = (const bf16_t*)(WS + OFF_INP) + (size_t)b * SEQ * 512 + ch;
  const bf16_t* G = (const bf16_t*)(WS + OFF_HZ) + (size_t)b * SEQ * ZW + Z_GATE + ch;
  bf16_t* YA = (bf16_t*)(WS + OFF_YA) + (size_t)b * SEQ * 512 + ch;
  float* ex = (float*)smem;
  const int ts = seg * 64;
  float P[8], hh[8];
#pragma unroll
  for (int e = 0; e < 8; ++e) { P[e] = 1.f; hh[e] = 0.f; }
#pragma unroll 4
  for (int i = 0; i < 64; ++i) {
    float la[8], in[8];
    unpack8(*(const u32x4*)(LOGA + (size_t)(ts + i) * 512), la);
    unpack8(*(const u32x4*)(INP + (size_t)(ts + i) * 512), in);
#pragma unroll
    for (int e = 0; e < 8; ++e) { float a = __expf(la[e]); hh[e] = a * hh[e] + in[e]; P[e] *= a; }
  }
  __syncthreads();
#pragma unroll
  for (int e = 0; e < 8; ++e) { ex[((seg * 64) + c8 * 8 + e) * 2] = P[e]; ex[((seg * 64) + c8 * 8 + e) * 2 + 1] = hh[e]; }
  __syncthreads();
#pragma unroll
  for (int e = 0; e < 8; ++e) hh[e] = 0.f;
  for (int s2 = 0; s2 < seg; ++s2) {
#pragma unroll
    for (int e = 0; e < 8; ++e) hh[e] = ex[((s2 * 64) + c8 * 8 + e) * 2] * hh[e] + ex[((s2 * 64) + c8 * 8 + e) * 2 + 1];
  }
#pragma unroll 4
  for (int i = 0; i < 64; ++i) {
    float la[8], in[8], gt[8], o[8];
    unpack8(*(const u32x4*)(LOGA + (size_t)(ts + i) * 512), la);
    unpack8(*(const u32x4*)(INP + (size_t)(ts + i) * 512), in);
    unpack8(*(const u32x4*)(G + (size_t)(ts + i) * ZW), gt);
#pragma unroll
    for (int e = 0; e < 8; ++e) { float a = __expf(la[e]); hh[e] = a * hh[e] + in[e]; o[e] = hh[e] * gelu_tanh(gt[e]); }
    *(u32x4*)(YA + (size_t)(ts + i) * 512) = pack8(o);
  }
}

DI void glu_tile(const Params& p, char* WS, int l, int t, char* smem) {
  const int tid = get_tid(), lane = tid & 63, wave = tid >> 6, wm = wave >> 1, wn = wave & 1, r = lane & 31, h = lane >> 5;
  const int tm = t >> 2, tn = t & 3;
  const bf16_t* YS = (const bf16_t*)(WS + OFF_YS5);
  bf16_t* YD = (bf16_t*)(WS + OFF_YD);
  f32x16 acc[2][2]; zero_acc(acc);
  gemm_main<false>(YS + (size_t)tm * 128 * 512, 512, 64, (const bf16_t*)(WS + OFF_WGLU) + ((size_t)tn * 8 << 13), 64, 8192, 512,
                   (bf16_t*)smem, acc, nullptr);
#pragma unroll
  for (int ni = 0; ni < 2; ++ni) {
    const int col = tn * 128 + wn * 64 + ni * 32 + r;
    const float bg = p.s5_bglu[l * 512 + col];
#pragma unroll
    for (int mi = 0; mi < 2; ++mi)
#pragma unroll
      for (int i = 0; i < 16; ++i) {
        int row = tm * 128 + wm * 64 + mi * 32 + crow(i, h);
        float y = bf2f(YS[(size_t)row * 512 + col]);
        YD[(size_t)row * 512 + col] = f2bf(y * sigmoidf_(acc[mi][ni][i] + bg));
      }
  }
}

DI void mla_attn_item(const Params& p, char* WS, int l, int item, char* smem) {
  const int tid = get_tid(), lane = tid & 63, wave = tid >> 6, r = lane & 31, h = lane >> 5;
  const int qt = 15 - (item >> 7); const int bh = item & 127; const int b = bh >> 3, hd = bh & 7;
  const int q0 = qt * 128 + wave * 32;
  constexpr int KLD = 104, VLD = 72;
  bf16_t* Kt = (bf16_t*)smem;
  bf16_t* Vt = Kt + 2 * 64 * KLD;
  const bf16_t* Qp = (const bf16_t*)(WS + OFF_Q) + (size_t)(b * SEQ + q0 + r) * 768 + hd * 96 + h * 8;
  bf16x8 bq[6];
#pragma unroll
  for (int s6 = 0; s6 < 6; ++s6) bq[s6] = *(const bf16x8*)(Qp + s6 * 16);
  const bf16_t* Kb = (const bf16_t*)(WS + OFF_K) + (size_t)b * SEQ * 768 + hd * 96;
  const bf16_t* Vb = (const bf16_t*)(WS + OFF_VT) + (size_t)(b * 8 + hd) * 64 * SEQ;
  const float* g0 = p.mla_qk_gain + (l * 2) * 96; const float* g1 = g0 + 96;
  float m0 = fmaxf(fabsf(g0[lane]), lane < 32 ? fabsf(g0[64 + lane]) : 0.f);
  float m1 = fmaxf(fabsf(g1[lane]), lane < 32 ? fabsf(g1[64 + lane]) : 0.f);
  m0 = wave_max(m0); m1 = wave_max(m1);
  const float LOG2E = 1.4426950408889634f;
  const float sc2 = 0.10206207261596577f * LOG2E;
  const float cc2 = 9.797958971132712f * m0 * m1 * LOG2E;
  int krow[3], kcol[3];
#pragma unroll
  for (int i = 0; i < 3; ++i) { int c = tid + 256 * i; krow[i] = c / 12; kcol[i] = (c % 12) * 8; }
  int vrow[2], vcol[2];
#pragma unroll
  for (int i = 0; i < 2; ++i) { int c = tid + 256 * i; vrow[i] = c >> 3; vcol[i] = (c & 7) * 8; }
  u32x4 rk0[3], rv0[2], rk1[3], rv1[2];
  f32x16 o0, o1;
#pragma unroll
  for (int i = 0; i < 16; ++i) { o0[i] = 0.f; o1[i] = 0.f; }
  float lsum = 0.f;
  const int nkt = qt * 2 + 2;
#define A_LOAD(RK, RV, KT)                                                                                  \
  {                                                                                                         \
    const int kk_ = ((KT) < nkt ? (KT) : nkt - 1) * 64;                                                     \
    _Pragma("unroll") for (int i = 0; i < 3; ++i) RK[i] = *(const u32x4*)(Kb + (size_t)(kk_ + krow[i]) * 768 + kcol[i]); \
    _Pragma("unroll") for (int i = 0; i < 2; ++i) RV[i] = *(const u32x4*)(Vb + (size_t)vrow[i] * SEQ + kk_ + vcol[i]);   \
  }
#define A_STORE(RK, RV, BUF)                                                                                \
  {                                                                                                         \
    _Pragma("unroll") for (int i = 0; i < 3; ++i) *(u32x4*)(Kt + (BUF) * 64 * KLD + krow[i] * KLD + kcol[i]) = RK[i]; \
    _Pragma("unroll") for (int i = 0; i < 2; ++i) *(u32x4*)(Vt + (BUF) * 64 * VLD + vrow[i] * VLD + vcol[i]) = RV[i]; \
  }
#define A_COMPUTE(BUF, KT)                                                                                  \
  {                                                                                                         \
    const int k0 = (KT) * 64;                                                                               \
    const bf16_t* kc = Kt + (BUF) * 64 * KLD;                                                               \
    const bf16_t* vc = Vt + (BUF) * 64 * VLD;                                                               \
    _Pragma("unroll") for (int sub = 0; sub < 2; ++sub) {                                                   \
      const int ks0 = k0 + sub * 32;                                                                        \
      if (ks0 <= q0 + 31) {                                                                                 \
        f32x16 sacc;                                                                                        \
        _Pragma("unroll") for (int i = 0; i < 16; ++i) sacc[i] = 0.f;                                       \
        _Pragma("unroll") for (int s6 = 0; s6 < 6; ++s6) {                                                  \
          bf16x8 ka = *(const bf16x8*)(kc + (sub * 32 + r) * KLD + s6 * 16 + h * 8);                        \
          sacc = MFMA32(ka, bq[s6], sacc);                                                                  \
        }                                                                                                   \
        const bool diag = (ks0 + 31 > q0);                                                                  \
        float pv[16];                                                                                       \
        _Pragma("unroll") for (int i = 0; i < 16; ++i) {                                                    \
          float e = __builtin_amdgcn_exp2f(sacc[i] * sc2 - cc2);                                            \
          if (diag && (ks0 + crow(i, h) > q0 + r)) e = 0.f;                                                 \
          pv[i] = e; lsum += e;                                                                             \
        }                                                                                                   \
        _Pragma("unroll") for (int s2 = 0; s2 < 2; ++s2) {                                                  \
          u32x4 pfu;                                                                                        \
          pfu.x = pack2_mfma(pv[8 * s2 + 0], pv[8 * s2 + 1]); pfu.y = pack2_mfma(pv[8 * s2 + 2], pv[8 * s2 + 3]); \
          pfu.z = pack2_mfma(pv[8 * s2 + 4], pv[8 * s2 + 5]); pfu.w = pack2_mfma(pv[8 * s2 + 6], pv[8 * s2 + 7]); \
          bf16x8 pf = __builtin_bit_cast(bf16x8, pfu);                                                      \
          const bf16_t* vp = vc + r * VLD + sub * 32 + 16 * s2 + 4 * h;                                     \
          bf16x4 l0 = *(const bf16x4*)vp, h0 = *(const bf16x4*)(vp + 8);                                    \
          bf16x4 l1 = *(const bf16x4*)(vp + 32 * VLD), h1 = *(const bf16x4*)(vp + 32 * VLD + 8);            \
          bf16x8 va0 = __builtin_shufflevector(l0, h0, 0, 1, 2, 3, 4, 5, 6, 7);                             \
          bf16x8 va1 = __builtin_shufflevector(l1, h1, 0, 1, 2, 3, 4, 5, 6, 7);                             \
          o0 = MFMA32(va0, pf, o0); o1 = MFMA32(va1, pf, o1);                                               \
        }                                                                                                   \
      }                                                                                                     \
    }                                                                                                       \
  }
  A_LOAD(rk0, rv0, 0);
  A_LOAD(rk1, rv1, 1);
  __syncthreads();
  A_STORE(rk0, rv0, 0);
  __syncthreads();
  for (int kt = 0; kt < nkt; kt += 2) {
    A_LOAD(rk0, rv0, kt + 2);
    __builtin_amdgcn_sched_barrier(0);
    A_COMPUTE(0, kt);
    __builtin_amdgcn_sched_barrier(0);
    A_STORE(rk1, rv1, 1);
    __syncthreads();
    A_LOAD(rk1, rv1, kt + 3);
    __builtin_amdgcn_sched_barrier(0);
    A_COMPUTE(1, kt + 1);
    __builtin_amdgcn_sched_barrier(0);
    A_STORE(rk0, rv0, 0);
    __syncthreads();
  }
#undef A_LOAD
#undef A_STORE
#undef A_COMPUTE
  const float lt = lsum + xshfl_xor(lsum, 32);
  const float inv = 1.f / lt;
  bf16_t* yb = (bf16_t*)(WS + OFF_YB) + (size_t)(b * SEQ + q0 + r) * 512 + hd * 64;
#pragma unroll
  for (int g4 = 0; g4 < 4; ++g4) {
    u32x2 a, c;
    a.x = pack2(o0[4 * g4] * inv, o0[4 * g4 + 1] * inv); a.y = pack2(o0[4 * g4 + 2] * inv, o0[4 * g4 + 3] * inv);
    c.x = pack2(o1[4 * g4] * inv, o1[4 * g4 + 1] * inv); c.y = pack2(o1[4 * g4 + 2] * inv, o1[4 * g4 + 3] * inv);
    *(u32x2*)(yb + 8 * g4 + 4 * h) = a;
    *(u32x2*)(yb + 32 + 8 * g4 + 4 * h) = c;
  }
}

DI uint32_t sortable(float f) { uint32_t u = __float_as_uint(f); return (u & 0x80000000u) ? ~u : (u | 0x80000000u); }
DI float idx_score(const f32x16& a, const uint32_t (&wvp)[8], int jq) {
  float s = 0.f;
#pragma unroll
  for (int hd = 0; hd < 8; ++hd) {
    const uint32_t pw = wvp[4 * jq + (hd >> 1)];
    const float w = __uint_as_float((hd & 1) ? (pw & 0xffff0000u) : (pw << 16));
    s = fmaf(w, fmaxf(a[8 * jq + hd], 0.f), s);
  }
  return s;
}
DI int half_sum(int v) {
#pragma unroll
  for (int o = 16; o > 0; o >>= 1) v += xshfl_xor_i(v, o);
  return v;
}
DI void dsa_scores(const bf16_t* KI, const bf16x8 (&aqi)[2], const uint32_t (&wv)[8], int r, int h, int myq0, int ktmax,
                   uint32_t (&sk)[64], uint32_t* stash) {
  const bf16_t* kp = KI + (size_t)r * 32 + 8 * h;
#pragma unroll
  for (int g4 = 0; g4 < 16; ++g4) {
    if (g4 * 4 <= ktmax) {
      asm volatile("" : "+v"(kp));
#pragma unroll
      for (int e = 0; e < 4; ++e) {
        const int kt = g4 * 4 + e;
        f32x16 a;
#pragma unroll
        for (int i = 0; i < 16; ++i) a[i] = 0.f;
#pragma unroll
        for (int s2 = 0; s2 < 2; ++s2) {
          bf16x8 kb = *(const bf16x8*)(kp + e * 1024 + 16 * s2);
          a = MFMA32(aqi[s2], kb, a);
        }
        const int key = kt * 32 + r;
        const float s0 = idx_score(a, wv, 0), s1 = idx_score(a, wv, 1);
        sk[kt] = (key <= myq0) ? sortable(s0) : 0u;
        stash[kt * 64] = (key <= myq0 + 1) ? sortable(s1) : 0u;
      }
      kp += 4 * 1024;
    } else {
#pragma unroll
      for (int e = 0; e < 4; ++e) { sk[4 * g4 + e] = 0u; stash[(4 * g4 + e) * 64] = 0u; }
    }
  }
}
DI void dsa_unstash(uint32_t (&sk)[64], const uint32_t* stash, int ktmax) {
#pragma unroll
  for (int g8 = 0; g8 < 8; ++g8) {
    if (g8 * 8 <= ktmax) {
#pragma unroll
      for (int e = 0; e < 8; ++e) sk[8 * g8 + e] = stash[(8 * g8 + e) * 64];
    } else {
#pragma unroll
      for (int e = 0; e < 8; ++e) sk[8 * g8 + e] = 0u;
    }
  }
}
DI void dsa_threshold(const uint32_t (&sk)[64], int r, int ktmax, uint32_t& thr_out, int& cut_out) {
  uint32_t prefix = 0u;
#pragma unroll 1
  for (int bit = 31; bit >= 0; --bit) {
    const uint32_t cand = prefix | (1u << bit);
    int cnt = 0;
#pragma unroll
    for (int g8 = 0; g8 < 8; ++g8) {
      if (g8 * 8 <= ktmax) {
#pragma unroll
        for (int e = 0; e < 8; ++e) cnt += (sk[g8 * 8 + e] >= cand) ? 1 : 0;
      }
    }
    cnt = half_sum(cnt);
    if (cnt >= 256) prefix = cand;
  }
  int cgt = 0, ceq = 0;
#pragma unroll
  for (int kt = 0; kt < 64; ++kt) { cgt += (sk[kt] > prefix) ? 1 : 0; ceq += (sk[kt] == prefix) ? 1 : 0; }
  cgt = half_sum(cgt); ceq = half_sum(ceq);
  const int need = 256 - cgt;
  int c = 0x7fffffff;
  const bool excess = (prefix != 0u) && (ceq > need);
  if (__any(excess)) {
    int cc = 0;
#pragma unroll 1
    for (int bit = 10; bit >= 0; --bit) {
      const int test = cc | (1 << bit);
      int cnt = 0;
#pragma unroll
      for (int kt = 0; kt < 64; ++kt) cnt += (sk[kt] == prefix && (kt * 32 + r) < test) ? 1 : 0;
      cnt = half_sum(cnt);
      if (cnt < need) cc = test;
    }
    if (excess) c = cc;
  }
  thr_out = prefix; cut_out = c;
}

DI void dsa_item(const Params& p, char* WS, int l, int item, char* smem) {
  const int tid = get_tid(), lane = tid & 63, wave = tid >> 6, r = lane & 31, h = lane >> 5;
  const int qt = 127 - (item >> 4); const int b = item & 15;
  const int tq0 = qt * 16 + wave * 4;
  const bf16_t* Z = (const bf16_t*)(WS + OFF_HZ);
  const bf16_t* KI = (const bf16_t*)(WS + OFF_KI) + (size_t)b * SEQ * 32;
  const bf16_t* KD = (const bf16_t*)(WS + OFF_KD) + (size_t)b * SEQ * 64;
  const bf16_t* VTD = (const bf16_t*)(WS + OFF_VTD) + (size_t)b * 64 * SEQ;
  const int ai = (r & 3) + 4 * (r >> 3);
  const int aq = 2 * ((r >> 2) & 1) + (ai >> 3), ah = ai & 7;
  bf16x8 aqi[2];
#pragma unroll
  for (int s2 = 0; s2 < 2; ++s2)
    aqi[s2] = *(const bf16x8*)(Z + (size_t)(b * SEQ + tq0 + aq) * ZW + Z_QIDX + ah * 32 + 16 * s2 + 8 * h);
  uint32_t wv[8];
#pragma unroll
  for (int jq = 0; jq < 2; ++jq) {
    u32x4 w8 = *(const u32x4*)(Z + (size_t)(b * SEQ + tq0 + 2 * h + jq) * ZW + Z_WIDX);
    wv[4 * jq] = w8.x; wv[4 * jq + 1] = w8.y; wv[4 * jq + 2] = w8.z; wv[4 * jq + 3] = w8.w;
  }
  const int myq0 = tq0 + 2 * h;
  const int ktmax = (tq0 + 3) >> 5;
  uint32_t thr[2]; int cut[2];
  {
    uint32_t* stash = (uint32_t*)smem + (size_t)wave * 64 * 64 + lane;
    uint32_t sk[64];
    dsa_scores(KI, aqi, wv, r, h, myq0, ktmax, sk, stash);
    asm volatile("" ::: "memory");
    dsa_threshold(sk, r, ktmax, thr[0], cut[0]);
    dsa_unstash(sk, stash, ktmax);
    asm volatile("" ::: "memory");
    dsa_threshold(sk, r, ktmax, thr[1], cut[1]);
  }
  asm volatile("" ::: "memory");
  constexpr int KLD = 72, VLD = 72, ILD = 40;
  bf16_t* Kt = (bf16_t*)smem;
  bf16_t* Vt = Kt + 2 * 64 * KLD;
  bf16_t* It = Vt + 2 * 64 * VLD;
  const int cq = r >> 3, chd = r & 7;
  bf16x8 bq[4];
#pragma unroll
  for (int s4 = 0; s4 < 4; ++s4)
    bq[s4] = *(const bf16x8*)(Z + (size_t)(b * SEQ + tq0 + cq) * ZW + Z_QDSA + chd * 64 + 16 * s4 + 8 * h);
  const float* g0 = p.dsa_qk_gain + (l * 2) * 64; const float* g1 = g0 + 64;
  const float m0 = wave_max(fabsf(g0[lane])), m1 = wave_max(fabsf(g1[lane]));
  const float LOG2E = 1.4426950408889634f;
  const float sc2 = 0.125f * LOG2E;
  const float cc2 = 8.f * m0 * m1 * LOG2E;
  f32x16 o0, o1;
#pragma unroll
  for (int i = 0; i < 16; ++i) { o0[i] = 0.f; o1[i] = 0.f; }
  float lsum = 0.f;
  const int nkt = ((qt * 16 + 15) >> 6) + 1;
  const int srow0 = tid >> 3, scol0 = (tid & 7) * 8;
  const int irow = tid >> 2, icol = (tid & 3) * 8;
  u32x4 rk0[2], rv0[2], ri0, rk1[2], rv1[2], ri1;
#define D_LOAD(RK, RV, RI, KT)                                                                              \
  {                                                                                                         \
    const int kk_ = ((KT) < nkt ? (KT) : nkt - 1) * 64;                                                     \
    _Pragma("unroll") for (int i = 0; i < 2; ++i) {                                                         \
      RK[i] = *(const u32x4*)(KD + (size_t)(kk_ + srow0 + 32 * i) * 64 + scol0);                            \
      RV[i] = *(const u32x4*)(VTD + (size_t)(srow0 + 32 * i) * SEQ + kk_ + scol0);                          \
    }                                                                                                       \
    RI = *(const u32x4*)(KI + (size_t)(kk_ + irow) * 32 + icol);                                            \
  }
#define D_STORE(RK, RV, RI, BUF)                                                                            \
  {                                                                                                         \
    _Pragma("unroll") for (int i = 0; i < 2; ++i) {                                                         \
      *(u32x4*)(Kt + (BUF) * 64 * KLD + (srow0 + 32 * i) * KLD + scol0) = RK[i];                            \
      *(u32x4*)(Vt + (BUF) * 64 * VLD + (srow0 + 32 * i) * VLD + scol0) = RV[i];                            \
    }                                                                                                       \
    *(u32x4*)(It + (BUF) * 64 * ILD + irow * ILD + icol) = RI;                                              \
  }
#define D_COMPUTE(BUF, KT)                                                                                  \
  {                                                                                                         \
    const int k0 = (KT) * 64;                                                                               \
    const bf16_t* kc = Kt + (BUF) * 64 * KLD;                                                               \
    const bf16_t* vc = Vt + (BUF) * 64 * VLD;                                                               \
    const bf16_t* ic = It + (BUF) * 64 * ILD;                                                               \
    _Pragma("unroll") for (int sub = 0; sub < 2; ++sub) {                                                   \
      if ((KT) * 2 + sub <= ktmax) {                                                                        \
        const int ks0 = k0 + sub * 32;                                                                      \
        f32x16 a;                                                                                           \
        _Pragma("unroll") for (int i = 0; i < 16; ++i) a[i] = 0.f;                                          \
        _Pragma("unroll") for (int s2 = 0; s2 < 2; ++s2) {                                                  \
          bf16x8 kb = *(const bf16x8*)(ic + (sub * 32 + r) * ILD + 16 * s2 + 8 * h);                        \
          a = MFMA32(aqi[s2], kb, a);                                                                       \
        }                                                                                                   \
        const int key = ks0 + r;                                                                            \
        const uint32_t u0 = sortable(idx_score(a, wv, 0)), u1 = sortable(idx_score(a, wv, 1));              \
        const bool sel0 = (key <= myq0) && (u0 > thr[0] || (u0 == thr[0] && key <= cut[0]));                \
        const bool sel1 = (key <= myq0 + 1) && (u1 > thr[1] || (u1 == thr[1] && key <= cut[1]));            \
        const unsigned long long bl0 = __ballot(sel0), bl1 = __ballot(sel1);                                \
        const unsigned long long blq = (cq & 1) ? bl1 : bl0;                                                \
        const uint32_t mymask = (uint32_t)(blq >> (32 * (cq >> 1)));                                        \
        f32x16 sacc;                                                                                        \
        _Pragma("unroll") for (int i = 0; i < 16; ++i) sacc[i] = 0.f;                                       \
        _Pragma("unroll") for (int s4 = 0; s4 < 4; ++s4) {                                                  \
          bf16x8 ka = *(const bf16x8*)(kc + (sub * 32 + r) * KLD + 16 * s4 + 8 * h);                        \
          sacc = MFMA32(ka, bq[s4], sacc);                                                                  \
        }                                                                                                   \
        float pv[16];                                                                                       \
        _Pragma("unroll") for (int i = 0; i < 16; ++i) {                                                    \
          float e = __builtin_amdgcn_exp2f(sacc[i] * sc2 - cc2);                                            \
          e = ((mymask >> crow(i, h)) & 1u) ? e : 0.f;                                                      \
          pv[i] = e; lsum += e;                                                                             \
        }                                                                                                   \
        _Pragma("unroll") for (int s2 = 0; s2 < 2; ++s2) {                                                  \
          u32x4 pfu;                                                                                        \
          pfu.x = pack2_mfma(pv[8 * s2 + 0], pv[8 * s2 + 1]); pfu.y = pack2_mfma(pv[8 * s2 + 2], pv[8 * s2 + 3]); \
          pfu.z = pack2_mfma(pv[8 * s2 + 4], pv[8 * s2 + 5]); pfu.w = pack2_mfma(pv[8 * s2 + 6], pv[8 * s2 + 7]); \
          bf16x8 pf = __builtin_bit_cast(bf16x8, pfu);                                                      \
          const bf16_t* vp = vc + r * VLD + sub * 32 + 16 * s2 + 4 * h;                                     \
          bf16x4 l0 = *(const bf16x4*)vp, h0 = *(const bf16x4*)(vp + 8);                                    \
          bf16x4 l1 = *(const bf16x4*)(vp + 32 * VLD), h1 = *(const bf16x4*)(vp + 32 * VLD + 8);            \
          bf16x8 va0 = __builtin_shufflevector(l0, h0, 0, 1, 2, 3, 4, 5, 6, 7);                             \
          bf16x8 va1 = __builtin_shufflevector(l1, h1, 0, 1, 2, 3, 4, 5, 6, 7);                             \
          o0 = MFMA32(va0, pf, o0); o1 = MFMA32(va1, pf, o1);                                               \
        }                                                                                                   \
      }                                                                                                     \
    }                                                                                                       \
  }
  D_LOAD(rk0, rv0, ri0, 0);
  D_LOAD(rk1, rv1, ri1, 1);
  __syncthreads();
  D_STORE(rk0, rv0, ri0, 0);
  __syncthreads();
  for (int kt = 0; kt < nkt; kt += 2) {
    D_LOAD(rk0, rv0, ri0, kt + 2);
    __builtin_amdgcn_sched_barrier(0);
    D_COMPUTE(0, kt);
    __builtin_amdgcn_sched_barrier(0);
    D_STORE(rk1, rv1, ri1, 1);
    __syncthreads();
    D_LOAD(rk1, rv1, ri1, kt + 3);
    __builtin_amdgcn_sched_barrier(0);
    if (kt + 1 < nkt) D_COMPUTE(1, kt + 1);
    __builtin_amdgcn_sched_barrier(0);
    D_STORE(rk0, rv0, ri0, 0);
    __syncthreads();
  }
#undef D_LOAD
#undef D_STORE
#undef D_COMPUTE
  const float lt = lsum + xshfl_xor(lsum, 32);
  const float inv = 1.f / lt;
  bf16_t* yc = (bf16_t*)(WS + OFF_YC) + (size_t)(b * SEQ + tq0 + cq) * 512 + chd * 64;
#pragma unroll
  for (int g4 = 0; g4 < 4; ++g4) {
    u32x2 a2, c2;
    a2.x = pack2(o0[4 * g4] * inv, o0[4 * g4 + 1] * inv); a2.y = pack2(o0[4 * g4 + 2] * inv, o0[4 * g4 + 3] * inv);
    c2.x = pack2(o1[4 * g4] * inv, o1[4 * g4 + 1] * inv); c2.y = pack2(o1[4 * g4 + 2] * inv, o1[4 * g4 + 3] * inv);
    *(u32x2*)(yc + 8 * g4 + 4 * h) = a2;
    *(u32x2*)(yc + 32 + 8 * g4 + 4 * h) = c2;
  }
}

DI void phase_mix1(const Params& p, char* WS, int l, char* smem, int rep) {
  constexpr int N_S5 = 512, N_Q = 1536, N_KV = 2048, N_VT = 512, N_QK = (T * 9 + 255) / 256, N_IDX = N_QK, N_CONV = T * 64 / 256;
  constexpr int E0 = N_S5, E1 = E0 + N_Q, E2 = E1 + N_KV, E3 = E2 + N_VT, E4 = E3 + N_QK, E5 = E4 + N_IDX, E6 = E5 + N_CONV;
  for (int it = get_bid(); it < E6; it += get_nb()) {
    if (it < E0) s5_item<false>(p, WS, l, it, smem);
    else if (it < E1) mla_up_tile(p, WS, it - E0, false, smem);
    else if (it < E2) mla_up_tile(p, WS, it - E1, true, smem);
    else if (it < E3) dsa_prep_vt(p, WS, it - E2, smem);
    else if (it < E4) { if (rep == 0) dsa_prep_qk(p, WS, l, it - E3); }
    else if (it < E5) { if (rep == 0) dsa_prep_idx(p, WS, it - E4); }
    else rg_conv(p, WS, l, it - E5);
  }
}
DI void phase_mix2(const Params& p, char* WS, int l, char* smem, int rep) {
  constexpr int N_DSA = 2048, N_S5 = 512, N_RG = 2048, N_EL = T * 16 / 256;
  constexpr int E0 = N_DSA, E1 = E0 + N_S5, E2 = E1 + N_RG, E3 = E2 + N_EL;
  for (int it = get_bid(); it < E3; it += get_nb()) {
    if (it < E0) dsa_item(p, WS, l, it, smem);
    else if (it < E1) s5_item<true>(p, WS, l, it - E0, smem);
    else if (it < E2) rg_gate_tile(p, WS, l, it - E1, smem);
    else if (rep == 0) mla_elem(p, WS, l, it - E2);
  }
}
DI void phase_mix3(const Params& p, char* WS, int l, char* smem) {
  constexpr int N_RG = 128, N_ATT = 2048, N_GLU = 1024;
  constexpr int E0 = N_RG, E1 = E0 + N_ATT, E2 = E1 + N_GLU;
  for (int it = get_bid(); it < E2; it += get_nb()) {
    if (it < E0) rg_scan_item(p, WS, it, smem);
    else if (it < E1) mla_attn_item(p, WS, l, it - E0, smem);
    else glu_tile(p, WS, l, it - E1, smem);
  }
}

constexpr int NPHASE = 1 + NL * 13;

DI void run_phase(const Params& p, char* WS, int ph, char* smem_blk, int rep) {
  const int l = (ph - 1) / 13, s = (ph - 1) % 13;
  char* smem = smem_blk + get_team() * SMEM_BYTES;
#define MODP ((const float*)(WS + OFF_MOD) + (size_t)l * 16 * 9216)
  switch (s) {
    case 0: phase_convert(p, WS, l, smem); phase_norm(p, WS, l, 0); break;
    case 1: phase_ffn_up(p, WS, 0, smem_blk); break;
    case 2: phase_gemm_resid(p, WS, (const bf16_t*)(WS + OFF_HZ), (const bf16_t*)(WS + OFF_WDN), DFF, MODP + 2 * 1024, 0.5f, smem_blk); break;
    case 3: phase_norm(p, WS, l, 1); break;
    case 4: phase_inproj(p, WS, smem_blk); break;
    case 5: phase_mix1(p, WS, l, smem, rep); break;
    case 6: phase_mix2(p, WS, l, smem, rep); break;
    case 7: phase_mix3(p, WS, l, smem); break;
    case 8: phase_merge(p, WS, smem); break;
    case 9: phase_gemm_resid(p, WS, (const bf16_t*)(WS + OFF_MERGED), (const bf16_t*)(WS + OFF_WOUT), 1024, MODP + 5 * 1024, 1.0f, smem_blk); break;
    case 10: phase_norm(p, WS, l, 2); break;
    case 11: phase_ffn_up(p, WS, 1, smem_blk); break;
    case 12: phase_gemm_resid(p, WS, (const bf16_t*)(WS + OFF_HZ), (const bf16_t*)(WS + OFF_WDN) + (size_t)1024 * DFF, DFF, MODP + 8 * 1024, 0.5f, smem_blk); break;
  }
}

__global__ void __launch_bounds__(NTHREADS_BLK) mega_kernel(Params p, int ph_lo, int ph_hi, int probe) {
  __shared__ __attribute__((aligned(16))) char smem[SMEM_BLK];
  if (ph_lo == 0) {
    phase_init(p, p.ws, smem + get_team() * SMEM_BYTES);
    if (blockIdx.x == 0 && threadIdx.x == 0) {
      Params* tb = (Params*)(p.ws + OFF_TBL);
      tb->x = p.x;
      tb->c = p.c;
      tb->pos = p.pos;
      tb->ada_w = p.ada_w;
      tb->ada_b = p.ada_b;
      tb->norm_g = p.norm_g;
      tb->ffn_w1 = p.ffn_w1;
      tb->ffn_w3 = p.ffn_w3;
      tb->ffn_w2 = p.ffn_w2;
      tb->w_in = p.w_in;
      tb->conv_w = p.conv_w;
      tb->conv_b = p.conv_b;
      tb->rg_wa = p.rg_wa;
      tb->rg_ba = p.rg_ba;
      tb->rg_wx = p.rg_wx;
      tb->rg_bx = p.rg_bx;
      tb->rg_lambda = p.rg_lambda;
      tb->mla_q_norm = p.mla_q_norm;
      tb->mla_w_uq = p.mla_w_uq;
      tb->mla_kv_norm = p.mla_kv_norm;
      tb->mla_w_ukv = p.mla_w_ukv;
      tb->mla_qk_gain = p.mla_qk_gain;
      tb->dsa_qk_gain = p.dsa_qk_gain;
      tb->s5_lre = p.s5_lre;
      tb->s5_lim = p.s5_lim;
      tb->s5_logdt = p.s5_logdt;
      tb->s5_bre = p.s5_bre;
      tb->s5_bim = p.s5_bim;
      tb->s5_cre = p.s5_cre;
      tb->s5_cim = p.s5_cim;
      tb->s5_d = p.s5_d;
      tb->s5_wglu = p.s5_wglu;
      tb->s5_bglu = p.s5_bglu;
      tb->w_branch = p.w_branch;
      tb->w_out = p.w_out;
      tb->xo = p.xo;
      tb->ws = p.ws;
    }
    ph_lo = 1;
    if (ph_lo < ph_hi) cg::this_grid().sync();
  }
  for (int ph = ph_lo; ph < ph_hi; ++ph) {
    char* ws = p.ws;
    asm volatile("" : "+s"(ws));
    const Params& q = *(const Params*)(ws + OFF_TBL);
    const int nrep = (((ph - 1) % 13) == (probe & 255)) ? (probe >> 8) : 1;
    for (int rep = 0; rep < nrep; ++rep) {
      run_phase(q, ws, ph, smem, rep);
      if (rep + 1 < nrep) cg::this_grid().sync();
    }
    if (ph + 1 < ph_hi) cg::this_grid().sync();
  }
}

extern "C" void kernel_launch(void* const* d_in, const int* in_sizes, int n_in, void* d_out, int out_size, void* d_ws,
                              size_t ws_size, hipStream_t stream) {
  Params p{};
  p.x = (const float*)d_in[0]; p.c = (const float*)d_in[1]; p.pos = (const int*)d_in[2];
  p.ada_w = (const float*)d_in[3]; p.ada_b = (const float*)d_in[4]; p.norm_g = (const float*)d_in[5];
  p.ffn_w1 = (const float*)d_in[6]; p.ffn_w3 = (const float*)d_in[7]; p.ffn_w2 = (const float*)d_in[8];
  p.w_in = (const float*)d_in[9]; p.conv_w = (const float*)d_in[10]; p.conv_b = (const float*)d_in[11];
  p.rg_wa = (const float*)d_in[12]; p.rg_ba = (const float*)d_in[13]; p.rg_wx = (const float*)d_in[14];
  p.rg_bx = (const float*)d_in[15]; p.rg_lambda = (const float*)d_in[16]; p.mla_q_norm = (const float*)d_in[17];
  p.mla_w_uq = (const float*)d_in[18]; p.mla_kv_norm = (const float*)d_in[19]; p.mla_w_ukv = (const float*)d_in[20];
  p.mla_qk_gain = (const float*)d_in[21]; p.dsa_qk_gain = (const float*)d_in[22]; p.s5_lre = (const float*)d_in[23];
  p.s5_lim = (const float*)d_in[24]; p.s5_logdt = (const float*)d_in[25]; p.s5_bre = (const float*)d_in[26];
  p.s5_bim = (const float*)d_in[27]; p.s5_cre = (const float*)d_in[28]; p.s5_cim = (const float*)d_in[29];
  p.s5_d = (const float*)d_in[30]; p.s5_wglu = (const float*)d_in[31]; p.s5_bglu = (const float*)d_in[32];
  p.w_branch = (const float*)d_in[33]; p.w_out = (const float*)d_in[34];
  p.xo = (float*)d_out; p.ws = (char*)d_ws;
  if (ws_size < WS_NEED) fprintf(stderr, "workspace too small: %zu < %zu\n", ws_size, (size_t)WS_NEED);
  static int grid_blocks = 0;
  if (!grid_blocks) {
    int dev = 0, cus = 0, per_cu = 0;
    hipGetDevice(&dev);
    hipDeviceGetAttribute(&cus, hipDeviceAttributeMultiprocessorCount, dev);
    hipOccupancyMaxActiveBlocksPerMultiprocessor(&per_cu, mega_kernel, NTHREADS_BLK, 0);
    if (per_cu > 1) per_cu = 1;
    if (per_cu < 1) per_cu = 1;
    grid_blocks = cus * per_cu;
  }
#if MEGA
  int lo = 0, hi = NPHASE, probe = PROBE_CFG;
  void* args[] = {&p, &lo, &hi, &probe};
  hipError_t e = hipLaunchCooperativeKernel((void*)mega_kernel, dim3(grid_blocks), dim3(NTHREADS_BLK), args, 0, stream);
  if (e != hipSuccess) fprintf(stderr, "cooperative launch failed: %s (grid %d)\n", hipGetErrorString(e), grid_blocks);
#else
  for (int ph = 0; ph < NPHASE; ++ph) mega_kernel<<<grid_blocks, NTHREADS_BLK, 0, stream>>>(p, ph, ph + 1, PROBE_CFG);
#endif
}
```

```cpp
#include <hip/hip_runtime.h>
#include <hip/hip_cooperative_groups.h>
#include <stdint.h>
#include <stdio.h>
namespace cg = cooperative_groups;

#ifndef MEGA
#define MEGA 1
#endif
#ifndef PROBE_CFG
#define PROBE_CFG (255 | (1 << 8))
#endif

typedef unsigned short bf16_t;
using bf16x8 = __attribute__((ext_vector_type(8))) short;
using bf16x4 = __attribute__((ext_vector_type(4))) short;
using f32x16 = __attribute__((ext_vector_type(16))) float;
using u32x4 = __attribute__((ext_vector_type(4))) uint32_t;
using u32x2 = __attribute__((ext_vector_type(2))) uint32_t;

#define DI __device__ __forceinline__
#define MFMA32(a, b, c) __builtin_amdgcn_mfma_f32_32x32x16_bf16((a), (b), (c), 0, 0, 0)

constexpr int T = 32768, SEQ = 2048, NB = 16, D = 1024, DFF = 2816, ZW = 2944, DIN = 6984, NL = 4;
constexpr int NTHREADS = 256;
constexpr int NTHREADS_BLK = 512;
constexpr int Z_XRNN = 0, Z_GATE = 512, Z_QLAT = 1024, Z_KVLAT = 1280, Z_KPE = 1408, Z_QDSA = 1440, Z_KDSA = 1952,
              Z_VDSA = 2016, Z_QIDX = 2080, Z_KIDX = 2336, Z_WIDX = 2368, Z_US5 = 2376, Z_GATES = 2888;

constexpr size_t AL(size_t x) { return (x + 255) & ~(size_t)255; }
constexpr size_t OFF_WUP = 0;
constexpr size_t OFF_WDN = OFF_WUP + AL((size_t)2 * 5632 * 1024 * 2);
constexpr size_t OFF_WIN = OFF_WDN + AL((size_t)2 * 1024 * 2816 * 2);
constexpr size_t OFF_WBR = OFF_WIN + AL((size_t)7040 * 1024 * 2);
constexpr size_t OFF_WOUT = OFF_WBR + AL((size_t)4 * 1024 * 512 * 2);
constexpr size_t OFF_WUQ = OFF_WOUT + AL((size_t)1024 * 1024 * 2);
constexpr size_t OFF_WUKV = OFF_WUQ + AL((size_t)768 * 256 * 2);
constexpr size_t OFF_WRG = OFF_WUKV + AL((size_t)1024 * 128 * 2);
constexpr size_t OFF_WGLU = OFF_WRG + AL((size_t)8 * 128 * 64 * 2);
constexpr size_t OFF_S5AB = OFF_WGLU + AL((size_t)512 * 512 * 2);
constexpr size_t OFF_S5BB = OFF_S5AB + AL((size_t)32 * 64 * 4 * 4);
constexpr size_t OFF_S5CT = OFF_S5BB + AL((size_t)32 * 128 * 16 * 2);
constexpr size_t OFF_MOD = OFF_S5CT + AL((size_t)32 * 16 * 128 * 2);
constexpr size_t OFF_ROPE = OFF_MOD + AL((size_t)4 * 16 * 9216 * 4);
constexpr size_t OFF_U = OFF_ROPE + AL((size_t)T * 56 * 4);
constexpr size_t OFF_HZ = OFF_U + AL((size_t)T * 1024 * 2);
constexpr size_t OFF_XC = OFF_HZ + AL((size_t)T * ZW * 2);
constexpr size_t OFF_Q = OFF_XC + AL((size_t)T * 512 * 2);
constexpr size_t OFF_KNOPE = OFF_Q + AL((size_t)T * 768 * 2);
constexpr size_t OFF_VT = OFF_KNOPE + AL((size_t)T * 512 * 2);
constexpr size_t OFF_K = OFF_VT + AL((size_t)T * 512 * 2);
constexpr size_t OFF_KD = OFF_K + AL((size_t)T * 768 * 2);
constexpr size_t OFF_VTD = OFF_KD + AL((size_t)T * 64 * 2);
constexpr size_t OFF_KI = OFF_VTD + AL((size_t)T * 64 * 2);
constexpr size_t OFF_ENDS = OFF_KI + AL((size_t)T * 32 * 2);
constexpr size_t OFF_YS5 = OFF_ENDS + AL((size_t)16 * 32 * 32 * 128 * 4);
constexpr size_t OFF_LOGA = OFF_YS5 + AL((size_t)T * 512 * 2);
constexpr size_t OFF_INP = OFF_LOGA + AL((size_t)T * 512 * 2);
constexpr size_t OFF_YC = OFF_INP + AL((size_t)T * 512 * 2);
constexpr size_t OFF_YD = OFF_YC + AL((size_t)T * 512 * 2);
constexpr size_t OFF_TBL = OFF_YD + AL((size_t)T * 512 * 2);
constexpr size_t WS_NEED = OFF_TBL + 1024;
constexpr size_t OFF_YA = OFF_XC, OFF_YB = OFF_KNOPE, OFF_MERGED = OFF_HZ;

struct Params {
  const float* x; const float* c; const int* pos;
  const float *ada_w, *ada_b, *norm_g, *ffn_w1, *ffn_w3, *ffn_w2, *w_in, *conv_w, *conv_b, *rg_wa, *rg_ba, *rg_wx, *rg_bx,
      *rg_lambda, *mla_q_norm, *mla_w_uq, *mla_kv_norm, *mla_w_ukv, *mla_qk_gain, *dsa_qk_gain, *s5_lre, *s5_lim, *s5_logdt,
      *s5_bre, *s5_bim, *s5_cre, *s5_cim, *s5_d, *s5_wglu, *s5_bglu, *w_branch, *w_out;
  float* xo;
  char* ws;
};

DI int get_tid512() { int t = threadIdx.x; asm volatile("" : "+v"(t)); return t; }
DI int get_tid() { int t = threadIdx.x & 255; asm volatile("" : "+v"(t)); return t; }
DI int get_team() { int t = __builtin_amdgcn_readfirstlane(threadIdx.x >> 8); asm volatile("" : "+s"(t)); return t; }
DI int get_bid() { int b = blockIdx.x * 2 + __builtin_amdgcn_readfirstlane(threadIdx.x >> 8); asm volatile("" : "+s"(b)); return b; }
DI int get_nb() { int b = gridDim.x * 2; asm volatile("" : "+s"(b)); return b; }
DI int get_bid_real() { int b = blockIdx.x; asm volatile("" : "+s"(b)); return b; }
DI int get_nb_real() { int b = gridDim.x; asm volatile("" : "+s"(b)); return b; }
DI float xshfl_xor(float v, int m) { int l = (get_tid() & 63) ^ m; return __int_as_float(__builtin_amdgcn_ds_bpermute(l << 2, __float_as_int(v))); }
DI int xshfl_xor_i(int v, int m) { int l = (get_tid() & 63) ^ m; return __builtin_amdgcn_ds_bpermute(l << 2, v); }
DI float xshfl(float v, int src) { return __int_as_float(__builtin_amdgcn_ds_bpermute(src << 2, __float_as_int(v))); }
DI float bf2f(bf16_t v) { return __uint_as_float(((uint32_t)v) << 16); }
DI uint32_t pack2(float a, float b) { uint32_t r; asm("v_cvt_pk_bf16_f32 %0, %1, %2" : "=v"(r) : "v"(a), "v"(b)); return r; }
DI uint32_t pack2_mfma(float a, float b) { uint32_t r; asm volatile("v_cvt_pk_bf16_f32 %0, %1, %2\n\ts_nop 1" : "=v"(r) : "v"(a), "v"(b)); return r; }
DI bf16_t f2bf(float f) { return (bf16_t)(pack2(f, f) & 0xffffu); }
DI int crow(int i, int h) { return (i & 3) + 8 * (i >> 2) + 4 * h; }
DI float wave_sum(float v) {
#pragma unroll
  for (int o = 32; o > 0; o >>= 1) v += xshfl_xor(v, o);
  return v;
}
DI float wave_max(float v) {
#pragma unroll
  for (int o = 32; o > 0; o >>= 1) v = fmaxf(v, xshfl_xor(v, o));
  return v;
}
DI float sigmoidf_(float x) { return __builtin_amdgcn_rcpf(1.f + __expf(-x)); }
DI float gelu_tanh(float x) {
  float u = 0.7978845608028654f * (x + 0.044715f * x * x * x);
  float t = 1.f - 2.f * __builtin_amdgcn_rcpf(1.f + __expf(2.f * u));
  return 0.5f * x * (1.f + t);
}
DI void unpack8(u32x4 v, float* f) {
  f[0] = __uint_as_float(v.x << 16); f[1] = __uint_as_float(v.x & 0xffff0000u);
  f[2] = __uint_as_float(v.y << 16); f[3] = __uint_as_float(v.y & 0xffff0000u);
  f[4] = __uint_as_float(v.z << 16); f[5] = __uint_as_float(v.z & 0xffff0000u);
  f[6] = __uint_as_float(v.w << 16); f[7] = __uint_as_float(v.w & 0xffff0000u);
}
DI u32x4 pack8(const float* f) {
  u32x4 v; v.x = pack2(f[0], f[1]); v.y = pack2(f[2], f[3]); v.z = pack2(f[4], f[5]); v.w = pack2(f[6], f[7]); return v;
}
DI void sincos_rev(float ang, float* s, float* c) {
  double rev = (double)ang * 0.15915494309189535; rev -= rint(rev);
  float rv = (float)rev;
  *s = __builtin_amdgcn_sinf(rv); *c = __builtin_amdgcn_cosf(rv);
}

constexpr int LDT = 72;
constexpr int TILE_ELEMS = 128 * LDT;
constexpr int SMEM_BYTES = 4 * TILE_ELEMS * 2 + 1024;
constexpr int SMEM_BLK = 2 * SMEM_BYTES;

template <int NI>
struct Stage { u32x4 a[4]; u32x4 b[2 * NI]; };

template <bool SUMSQ, int UNR = 4, int NI = 2>
DI void gemm_main(const bf16_t* __restrict__ A, int lda, int ksa, const bf16_t* __restrict__ Bt, int ldb, int ksb, int K, bf16_t* sm,
                  f32x16 (&acc)[2][NI], float* rowstat) {
  const int tid = get_tid(), lane = tid & 63, wave = tid >> 6;
  const int wm = wave >> 1, wn = wave & 1, r = lane & 31, h = lane >> 5;
  const int lrow = tid >> 3, lkc = (tid & 7) * 8;
  const bf16_t* ga = A + (size_t)lrow * lda + lkc;
  const bf16_t* gb = Bt + (size_t)lrow * ldb + lkc;
  bf16_t* sA = sm;
  bf16_t* sB = sm + 2 * TILE_ELEMS;
  const int nk = K >> 6;
  float ss[4] = {0.f, 0.f, 0.f, 0.f};
  u32x4 r0a[4], r0b[2 * NI], r1a[4], r1b[2 * NI];
#define G_LOAD(RA, RB, KT)                                                                          \
  {                                                                                                 \
    const size_t ka_ = (size_t)(KT) * ksa, kb_ = (size_t)(KT) * ksb;                                \
    _Pragma("unroll") for (int i = 0; i < 4; ++i) RA[i] = *(const u32x4*)(ga + (size_t)(32 * i) * lda + ka_);      \
    _Pragma("unroll") for (int i = 0; i < 2 * NI; ++i) RB[i] = *(const u32x4*)(gb + (size_t)(32 * i) * ldb + kb_); \
  }
#define G_STORE(RA, RB, BUF)                                                                        \
  {                                                                                                 \
    bf16_t* nA_ = sA + (BUF) * TILE_ELEMS; bf16_t* nB_ = sB + (BUF) * TILE_ELEMS;                   \
    _Pragma("unroll") for (int i = 0; i < 4; ++i) {                                                 \
      *(u32x4*)(nA_ + (lrow + 32 * i) * LDT + lkc) = RA[i];                                         \
      if (SUMSQ) { float f_[8]; unpack8(RA[i], f_);                                                 \
        _Pragma("unroll") for (int e = 0; e < 8; ++e) ss[i] += f_[e] * f_[e]; }                     \
    }                                                                                               \
    _Pragma("unroll") for (int i = 0; i < 2 * NI; ++i) *(u32x4*)(nB_ + (lrow + 32 * i) * LDT + lkc) = RB[i]; \
  }
#define G_COMPUTE(BUF)                                                                              \
  {                                                                                                 \
    const bf16_t* cA = sA + (BUF) * TILE_ELEMS + (wm * 64 + r) * LDT + h * 8;                       \
    const bf16_t* cB = sB + (BUF) * TILE_ELEMS + (wn * 32 * NI + r) * LDT + h * 8;                  \
    _Pragma("unroll") for (int ks = 0; ks < 4; ++ks) {                                              \
      bf16x8 a0 = *(const bf16x8*)(cA + ks * 16);                                                   \
      bf16x8 a1 = *(const bf16x8*)(cA + 32 * LDT + ks * 16);                                        \
      _Pragma("unroll") for (int ni = 0; ni < NI; ++ni) {                                           \
        bf16x8 b0 = *(const bf16x8*)(cB + ni * 32 * LDT + ks * 16);                                 \
        acc[0][ni] = MFMA32(a0, b0, acc[0][ni]);                                                    \
        acc[1][ni] = MFMA32(a1, b0, acc[1][ni]);                                                    \
      }                                                                                             \
    }                                                                                               \
  }
  G_LOAD(r0a, r0b, 0);
  G_LOAD(r1a, r1b, (nk > 1 ? 1 : 0));
  __syncthreads();
  G_STORE(r0a, r0b, 0);
  __syncthreads();
  for (int kt = 0; kt < nk; kt += 2) {
    G_LOAD(r0a, r0b, (kt + 2 < nk ? kt + 2 : nk - 1));
    __builtin_amdgcn_sched_barrier(0);
    G_COMPUTE(0);
    __builtin_amdgcn_sched_barrier(0);
    if (kt + 1 < nk) G_STORE(r1a, r1b, 1);
    __syncthreads();
    if (kt + 1 < nk) {
      G_LOAD(r1a, r1b, (kt + 3 < nk ? kt + 3 : nk - 1));
      __builtin_amdgcn_sched_barrier(0);
      G_COMPUTE(1);
      __builtin_amdgcn_sched_barrier(0);
      if (kt + 2 < nk) G_STORE(r0a, r0b, 0);
      __syncthreads();
    }
  }
#undef G_LOAD
#undef G_STORE
#undef G_COMPUTE
  if (SUMSQ) {
#pragma unroll
    for (int i = 0; i < 4; ++i) {
      float v = ss[i];
      v += xshfl_xor(v, 1); v += xshfl_xor(v, 2); v += xshfl_xor(v, 4);
      if ((tid & 7) == 0) rowstat[lrow + 32 * i] = rsqrtf(v / (float)K + 1e-6f);
    }
    __syncthreads();
  }
}

DI size_t tiled_off(int row, int col, int nk) {
  return ((size_t)((row >> 7) * nk + (col >> 6)) << 13) + ((row & 127) << 6) + (col & 63);
}
DI void zero_acc(f32x16 (&acc)[2][2]) {
#pragma unroll
  for (int a = 0; a < 2; ++a)
#pragma unroll
    for (int b = 0; b < 2; ++b)
#pragma unroll
      for (int i = 0; i < 16; ++i) acc[a][b][i] = 0.f;
}
DI void gemm256_main(const bf16_t* __restrict__ A, const bf16_t* __restrict__ Bt, int K, bf16_t* sm, f32x16 (&acc)[4][2]) {
  const int tid = get_tid512(), lane = tid & 63, wave = tid >> 6;
  const int wm = wave >> 2, wn = wave & 3, r = lane & 31, h = lane >> 5;
  const int lrow = tid >> 3, lkc = (tid & 7) * 8;
  const int nk = K >> 6;
  const bf16_t* ga = A + (size_t)lrow * 64 + lkc;
  const bf16_t* gb = Bt + (size_t)lrow * 64 + lkc;
  const size_t rts = (size_t)nk << 13;
  constexpr int TE = 256 * LDT;
  bf16_t* sA = sm;
  bf16_t* sB = sm + 2 * TE;
  u32x4 r0a[4], r0b[4], r1a[4], r1b[4];
#define H_LOAD(RA, RB, KT)                                                                                   \
  {                                                                                                          \
    const size_t ko_ = (size_t)(KT) << 13;                                                                   \
    _Pragma("unroll") for (int i = 0; i < 4; ++i) {                                                          \
      RA[i] = *(const u32x4*)(ga + (i >> 1) * rts + (i & 1) * 4096 + ko_);                                   \
      RB[i] = *(const u32x4*)(gb + (i >> 1) * rts + (i & 1) * 4096 + ko_);                                   \
    }                                                                                                        \
  }
#define H_STORE(RA, RB, BUF)                                                                                 \
  {                                                                                                          \
    _Pragma("unroll") for (int i = 0; i < 4; ++i) {                                                          \
      *(u32x4*)(sA + (BUF) * TE + (lrow + 64 * i) * LDT + lkc) = RA[i];                                      \
      *(u32x4*)(sB + (BUF) * TE + (lrow + 64 * i) * LDT + lkc) = RB[i];                                      \
    }                                                                                                        \
  }
#define H_COMPUTE(BUF, KS0, KS1)                                                                             \
  {                                                                                                          \
    const bf16_t* cA = sA + (BUF) * TE + (wm * 128 + r) * LDT + h * 8;                                       \
    const bf16_t* cB = sB + (BUF) * TE + (wn * 64 + r) * LDT + h * 8;                                        \
    _Pragma("unroll") for (int ks = KS0; ks < KS1; ++ks) {                                                   \
      bf16x8 b0 = *(const bf16x8*)(cB + ks * 16);                                                            \
      bf16x8 b1 = *(const bf16x8*)(cB + 32 * LDT + ks * 16);                                                 \
      _Pragma("unroll") for (int mi = 0; mi < 4; ++mi) {                                                     \
        bf16x8 a0 = *(const bf16x8*)(cA + mi * 32 * LDT + ks * 16);                                          \
        acc[mi][0] = MFMA32(a0, b0, acc[mi][0]);                                                             \
        acc[mi][1] = MFMA32(a0, b1, acc[mi][1]);                                                             \
      }                                                                                                      \
    }                                                                                                        \
  }
  H_LOAD(r0a, r0b, 0);
  H_LOAD(r1a, r1b, (nk > 1 ? 1 : 0));
  __syncthreads();
  H_STORE(r0a, r0b, 0);
  __syncthreads();
  for (int kt = 0; kt < nk; kt += 2) {
    H_LOAD(r0a, r0b, (kt + 2 < nk ? kt + 2 : nk - 1));
    __builtin_amdgcn_sched_barrier(0);
    H_COMPUTE(0, 0, 2);
    __builtin_amdgcn_sched_barrier(0);
    if (kt + 1 < nk) H_STORE(r1a, r1b, 1);
    __builtin_amdgcn_sched_barrier(0);
    H_COMPUTE(0, 2, 4);
    __syncthreads();
    if (kt + 1 < nk) {
      H_LOAD(r1a, r1b, (kt + 3 < nk ? kt + 3 : nk - 1));
      __builtin_amdgcn_sched_barrier(0);
      H_COMPUTE(1, 0, 2);
      __builtin_amdgcn_sched_barrier(0);
      if (kt + 2 < nk) H_STORE(r0a, r0b, 0);
      __builtin_amdgcn_sched_barrier(0);
      H_COMPUTE(1, 2, 4);
      __syncthreads();
    }
  }
#undef H_LOAD
#undef H_STORE
#undef H_COMPUTE
}
DI void zero_acc42(f32x16 (&acc)[4][2]) {
#pragma unroll
  for (int a = 0; a < 4; ++a)
#pragma unroll
    for (int b = 0; b < 2; ++b)
#pragma unroll
      for (int i = 0; i < 16; ++i) acc[a][b][i] = 0.f;
}
struct TileIter256 {
  int x, i, step, ntn, total, tmw_l2, ngm_l2, tnw;
  DI TileIter256(int ntn_, int tnw_l2) {
    const int b = get_bid_real(), nb = get_nb_real();
    x = b & 7; i = b >> 3; step = nb >> 3; ntn = ntn_;
    tnw = 1 << tnw_l2; tmw_l2 = 5 - tnw_l2; ngm_l2 = 4 - tmw_l2;
    total = (32 << ngm_l2) * (ntn_ >> tnw_l2);
  }
  DI bool next(int& tm, int& tn) {
    if (i >= total) return false;
    const int sup = i >> 5, within = i & 31;
    tm = x * 16 + ((sup & ((1 << ngm_l2) - 1)) << tmw_l2) + (within & ((1 << tmw_l2) - 1));
    tn = (sup >> ngm_l2) * tnw + (within >> tmw_l2);
    i += step;
    return true;
  }
};

DI void tile_map(int t, int ntn, int& tm, int& tn) {
  int per = 8 * ntn; int g = t / per; int rem = t - g * per;
  tm = g * 8 + (rem & 7); tn = rem >> 3;
}
struct TileIter {
  int x, i, step, ntn, total;
  DI TileIter(int ntn_) {
    const int b = get_bid(), nb = get_nb();
    x = b & 7; i = b >> 3; step = nb >> 3; ntn = ntn_;
    total = 32 * ((ntn_ + 7) & ~7);
  }
  DI bool next(int& tm, int& tn) {
    while (i < total) {
      const int blk = i >> 6, within = i & 63;
      tm = x * 32 + (blk & 3) * 8 + (within & 7);
      tn = (blk >> 2) * 8 + (within >> 3);
      i += step;
      if (tn < ntn) return true;
    }
    return false;
  }
};

DI void phase_init(const Params& p, char* WS, char* smem) {
  const int tid = get_tid(), lane = tid & 63, wave = tid >> 6;
  const size_t gtid = (size_t)get_bid() * NTHREADS + tid, gsz = (size_t)get_nb() * NTHREADS;
  const float4* src = (const float4*)p.x; float4* dst = (float4*)p.xo;
  for (size_t i = gtid; i < (size_t)T * D / 4; i += gsz) dst[i] = src[i];
  float* rope = (float*)(WS + OFF_ROPE);
  for (size_t i = gtid; i < (size_t)T * 28; i += gsz) {
    int t = (int)(i / 28), j = (int)(i % 28);
    float ex; int co, so;
    if (j < 16) { ex = (float)(2 * j) / 32.f; co = j; so = 16 + j; }
    else if (j < 24) { ex = (float)(2 * (j - 16)) / 16.f; co = 32 + j - 16; so = 40 + j - 16; }
    else { ex = (float)(2 * (j - 24)) / 8.f; co = 48 + j - 24; so = 52 + j - 24; }
    float inv = exp2f(-ex * 18.931568569324174f);
    float ang = (float)p.pos[t] * inv;
    float s, c; sincos_rev(ang, &s, &c);
    rope[(size_t)t * 56 + co] = c; rope[(size_t)t * 56 + so] = s;
  }
  float* cact = (float*)smem;
  float* part = (float*)(smem + 16384);
  float* mod = (float*)(WS + OFF_MOD);
  for (int it = get_bid(); it < NL * 144; it += get_nb()) {
    const int l = it / 144, c0 = (it % 144) * 64;
    float acc[16];
#pragma unroll
    for (int b = 0; b < 16; ++b) acc[b] = 0.f;
    for (int kc = 0; kc < 4; ++kc) {
      __syncthreads();
      for (int e = tid; e < 4096; e += NTHREADS) {
        int kk = e >> 4, b = e & 15; float cv = p.c[b * 1024 + kc * 256 + kk];
        cact[e] = cv / (1.f + __expf(-cv));
      }
      __syncthreads();
      const float* wp = p.ada_w + ((size_t)l * 1024 + kc * 256 + wave * 64) * 9216 + c0 + lane;
#pragma unroll 8
      for (int kk = 0; kk < 64; ++kk) {
        float w = wp[(size_t)kk * 9216];
        const float4* cv = (const float4*)(cact + (wave * 64 + kk) * 16);
        float4 c0v = cv[0], c1v = cv[1], c2v = cv[2], c3v = cv[3];
        acc[0] += c0v.x * w; acc[1] += c0v.y * w; acc[2] += c0v.z * w; acc[3] += c0v.w * w;
        acc[4] += c1v.x * w; acc[5] += c1v.y * w; acc[6] += c1v.z * w; acc[7] += c1v.w * w;
        acc[8] += c2v.x * w; acc[9] += c2v.y * w; acc[10] += c2v.z * w; acc[11] += c2v.w * w;
        acc[12] += c3v.x * w; acc[13] += c3v.y * w; acc[14] += c3v.z * w; acc[15] += c3v.w * w;
      }
    }
    __syncthreads();
#pragma unroll
    for (int b = 0; b < 16; ++b) part[(wave * 16 + b) * 64 + lane] = acc[b];
    __syncthreads();
    for (int e = tid; e < 1024; e += NTHREADS) {
      int b = e >> 6, cl = e & 63;
      float s = part[(0 * 16 + b) * 64 + cl] + part[(1 * 16 + b) * 64 + cl] + part[(2 * 16 + b) * 64 + cl] +
                part[(3 * 16 + b) * 64 + cl] + p.ada_b[l * 9216 + c0 + cl];
      mod[((size_t)l * 16 + b) * 9216 + c0 + cl] = s;
    }
  }
}

DI void conv_tile(const float* __restrict__ src, int lds_, int jmax, bf16_t* __restrict__ dst, int ldd,
                          const float* __restrict__ scale, float* tile) {
  const int tid = get_tid();
  __syncthreads();
  {
    const int j = tid & 31, kb = tid >> 5;
#pragma unroll
    for (int i = 0; i < 8; ++i) {
      int kk = kb + 8 * i;
      float v = (j < jmax) ? src[(size_t)kk * lds_ + j] : 0.f;
      if (scale) v *= scale[kk];
      tile[kk * 33 + j] = v;
    }
  }
  __syncthreads();
  {
    const int j = tid >> 3, kq = (tid & 7) * 8;
    float f[8];
#pragma unroll
    for (int e = 0; e < 8; ++e) f[e] = tile[(kq + e) * 33 + j];
    *(u32x4*)(dst + (size_t)j * ldd + kq) = pack8(f);
  }
}

DI void phase_convert(const Params& p, char* WS, int l, char* smem) {
  float* tile = (float*)smem;
  char* ws = WS;
  constexpr int J0 = 2816, J1 = 2816, J2 = 1408, J3 = 1408, J4 = 3520, J5 = 1024, J6 = 512, J7 = 96, J8 = 64, J9 = 32, J10 = 128, J11 = 8;
  constexpr int E0 = J0, E1 = E0 + J1, E2 = E1 + J2, E3 = E2 + J3, E4 = E3 + J4, E5 = E4 + J5, E6 = E5 + J6, E7 = E6 + J7,
                E8 = E7 + J8, E9 = E8 + J9, E10 = E9 + J10, E11 = E10 + J11;
  for (int it = get_bid(); it < E11; it += get_nb()) {
    if (it < E1) {
      int a = it >= E0; int t = it - (a ? E0 : 0);
      int G = t >> 4, kt = t & 15; int grp = G >> 1, which = G & 1;
      const float* w = (which ? p.ffn_w3 : p.ffn_w1) + ((size_t)(l * 2 + a) * 1024 + kt * 64) * DFF + grp * 32;
      bf16_t* d = (bf16_t*)(ws + OFF_WUP) + (size_t)a * 5632 * 1024 + tiled_off(G * 32, kt * 64, 16);
      conv_tile(w, DFF, 32, d, 64, nullptr, tile);
    } else if (it < E3) {
      int a = it >= E2; int t = it - (a ? E2 : E1);
      int G = t / 44, kt = t % 44;
      const float* w = p.ffn_w2 + ((size_t)(l * 2 + a) * DFF + kt * 64) * 1024 + G * 32;
      bf16_t* d = (bf16_t*)(ws + OFF_WDN) + (size_t)a * 1024 * DFF + tiled_off(G * 32, kt * 64, 44);
      conv_tile(w, 1024, 32, d, 64, nullptr, tile);
    } else if (it < E4) {
      int t = it - E3; int G = t >> 4, kt = t & 15;
      const int scol = (G < 92) ? G * 32 : Z_GATES + (G - 92) * 32;
      const float* w = p.w_in + ((size_t)l * 1024 + kt * 64) * DIN + scol;
      bf16_t* d = (G < 92) ? (bf16_t*)(ws + OFF_WIN) + tiled_off(G * 32, kt * 64, 16)
                           : (bf16_t*)(ws + OFF_WIN) + (size_t)2944 * 1024 + tiled_off((G - 92) * 32, kt * 64, 16);
      conv_tile(w, DIN, 32, d, 64, nullptr, tile);
    } else if (it < E5) {
      int t = it - E4; int n = t >> 8; int rem = t & 255; int G = rem >> 3, kt = rem & 7;
      const float* w = p.w_branch + ((size_t)(l * 4 + n) * 512 + kt * 64) * 1024 + G * 32;
      bf16_t* d = (bf16_t*)(ws + OFF_WBR) + (size_t)n * 1024 * 512 + tiled_off(G * 32, kt * 64, 8);
      conv_tile(w, 1024, 32, d, 64, nullptr, tile);
    } else if (it < E6) {
      int t = it - E5; int G = t >> 4, kt = t & 15;
      const float* w = p.w_out + ((size_t)l * 1024 + kt * 64) * 1024 + G * 32;
      bf16_t* d = (bf16_t*)(ws + OFF_WOUT) + tiled_off(G * 32, kt * 64, 16);
      conv_tile(w, 1024, 32, d, 64, nullptr, tile);
    } else if (it < E7) {
      int t = it - E6; int G = t >> 2, kt = t & 3;
      const float* w = p.mla_w_uq + ((size_t)l * 256 + kt * 64) * 768 + G * 32;
      bf16_t* d = (bf16_t*)(ws + OFF_WUQ) + tiled_off(G * 32, kt * 64, 4);
      conv_tile(w, 768, 32, d, 64, p.mla_q_norm + l * 256 + kt * 64, tile);
    } else if (it < E8) {
      int t = it - E7; int G = t >> 1, kt = t & 1;
      const float* w = p.mla_w_ukv + ((size_t)l * 128 + kt * 64) * 1024 + G * 32;
      bf16_t* d = (bf16_t*)(ws + OFF_WUKV) + tiled_off(G * 32, kt * 64, 2);
      conv_tile(w, 1024, 32, d, 64, p.mla_kv_norm + l * 128 + kt * 64, tile);
    } else if (it < E9) {
      int t = it - E8; int hd = t >> 2, G = t & 3; int half = G >> 1, which = G & 1;
      const float* w = (which ? p.rg_wx : p.rg_wa) + ((size_t)(l * 8 + hd) * 64) * 64 + half * 32;
      bf16_t* d = (bf16_t*)(ws + OFF_WRG) + ((size_t)hd * 128 + G * 32) * 64;
      conv_tile(w, 64, 32, d, 64, nullptr, tile);
    } else if (it < E10) {
      int t = it - E9; int G = t >> 3, kt = t & 7;
      const float* w = p.s5_wglu + ((size_t)l * 512 + kt * 64) * 512 + G * 32;
      bf16_t* d = (bf16_t*)(ws + OFF_WGLU) + tiled_off(G * 32, kt * 64, 8);
      conv_tile(w, 512, 32, d, 64, nullptr, tile);
    } else {
      int idx = (it - E10) * 256 + get_tid();
      int g = idx >> 6, pst = idx & 63;
      float lr = p.s5_lre[(l * 32 + g) * 64 + pst], li = p.s5_lim[(l * 32 + g) * 64 + pst];
      float dt = expf(p.s5_logdt[l * 32 + g]);
      float mag = expf(lr * dt);
      float sn, cs; sincos_rev(li * dt, &sn, &cs);
      float abr = mag * cs, abi = mag * sn;
      float den = lr * lr + li * li;
      float nr = abr - 1.f, ni = abi;
      float fr = (nr * lr + ni * li) / den, fi = (ni * lr - nr * li) / den;
      float pr = abr, pi = abi;
#pragma unroll
      for (int q = 0; q < 6; ++q) { float tr = pr * pr - pi * pi, ti = pr * pi; ti = ti + ti; pr = tr; pi = ti; }
      float* ab = (float*)(ws + OFF_S5AB) + (size_t)idx * 4;
      ab[0] = abr; ab[1] = abi; ab[2] = pr; ab[3] = pi;
      const float* br = p.s5_bre + ((size_t)(l * 32 + g) * 64 + pst) * 16;
      const float* bi = p.s5_bim + ((size_t)(l * 32 + g) * 64 + pst) * 16;
      bf16_t* bb = (bf16_t*)(ws + OFF_S5BB) + (size_t)g * 128 * 16;
#pragma unroll
      for (int j = 0; j < 16; ++j) {
        float r_ = br[j], i_ = bi[j];
        bb[(pst) * 16 + j] = f2bf(fr * r_ - fi * i_);
        bb[(64 + pst) * 16 + j] = f2bf(fr * i_ + fi * r_);
      }
      bf16_t* ct = (bf16_t*)(ws + OFF_S5CT) + (size_t)g * 16 * 128;
#pragma unroll
      for (int j = 0; j < 16; ++j) {
        ct[j * 128 + pst] = f2bf(p.s5_cre[((size_t)(l * 32 + g) * 16 + j) * 64 + pst]);
        ct[j * 128 + 64 + pst] = f2bf(-p.s5_cim[((size_t)(l * 32 + g) * 16 + j) * 64 + pst]);
      }
    }
  }
}

DI void phase_norm(const Params& p, char* WS, int l, int which) {
  const int tid = get_tid(), lane = tid & 63, wave = tid >> 6;
  const float* g = p.norm_g + (l * 3 + which) * 1024;
  const float* mod = (const float*)(WS + OFF_MOD) + (size_t)l * 16 * 9216;
  bf16_t* U = (bf16_t*)(WS + OFF_U);
  const float* xo = p.xo;
  for (int row0 = (get_bid() * 4 + wave) * 4; row0 < T; row0 += get_nb() * 16) {
    float4 v[4][4]; float ss[4];
#pragma unroll
    for (int q = 0; q < 4; ++q) {
      const float4* xr = (const float4*)(xo + (size_t)(row0 + q) * 1024);
#pragma unroll
      for (int i = 0; i < 4; ++i) v[q][i] = xr[lane + 64 * i];
    }
#pragma unroll
    for (int q = 0; q < 4; ++q) {
      float a = 0.f;
#pragma unroll
      for (int i = 0; i < 4; ++i) a += v[q][i].x * v[q][i].x + v[q][i].y * v[q][i].y + v[q][i].z * v[q][i].z + v[q][i].w * v[q][i].w;
      ss[q] = a;
    }
#pragma unroll
    for (int o = 32; o > 0; o >>= 1) {
#pragma unroll
      for (int q = 0; q < 4; ++q) ss[q] += xshfl_xor(ss[q], o);
    }
    const int b = row0 >> 11;
    const float* sh = mod + (size_t)b * 9216 + (3 * which) * 1024;
    const float* sc = sh + 1024;
#pragma unroll
    for (int i = 0; i < 4; ++i) {
      const int c = (lane + 64 * i) * 4;
      float4 gg = *(const float4*)(g + c), s4 = *(const float4*)(sh + c), c4 = *(const float4*)(sc + c);
      const float m0 = gg.x * (1.f + c4.x), m1 = gg.y * (1.f + c4.y), m2 = gg.z * (1.f + c4.z), m3 = gg.w * (1.f + c4.w);
#pragma unroll
      for (int q = 0; q < 4; ++q) {
        const float rstd = rsqrtf(ss[q] * (1.f / 1024.f) + 1e-6f);
        u32x2 o;
        o.x = pack2(v[q][i].x * rstd * m0 + s4.x, v[q][i].y * rstd * m1 + s4.y);
        o.y = pack2(v[q][i].z * rstd * m2 + s4.z, v[q][i].w * rstd * m3 + s4.w);
        *(u32x2*)(U + tiled_off(row0 + q, c, 16)) = o;
      }
    }
  }
}

DI void phase_ffn_up(const Params& p, char* WS, int a, char* smem) {
  const int tid = get_tid512(), lane = tid & 63, wave = tid >> 6, wm = wave >> 2, wn = wave & 3, r = lane & 31, h = lane >> 5;
  const bf16_t* U = (const bf16_t*)(WS + OFF_U);
  const bf16_t* W = (const bf16_t*)(WS + OFF_WUP) + (size_t)a * 5632 * 1024;
  bf16_t* H = (bf16_t*)(WS + OFF_HZ);
  TileIter256 ti(22, 1);
  for (int tm, tn; ti.next(tm, tn);) {
    f32x16 acc[4][2]; zero_acc42(acc);
    gemm256_main(U + ((size_t)tm * 2 * 16 << 13), W + ((size_t)tn * 2 * 16 << 13), 1024, (bf16_t*)smem, acc);
    {
      constexpr int SLD = 128 + 8;
      bf16_t* st = (bf16_t*)smem;
#pragma unroll
      for (int mi = 0; mi < 4; ++mi)
#pragma unroll
        for (int i = 0; i < 16; ++i) {
          float v1 = acc[mi][0][i], v3 = acc[mi][1][i];
          st[(wm * 128 + mi * 32 + crow(i, h)) * SLD + wn * 32 + r] = f2bf(v1 * sigmoidf_(v1) * v3);
        }
      __syncthreads();
#pragma unroll
      for (int q = 0; q < 8; ++q) {
        const int c = get_tid512() + 512 * q;
        const int row = c >> 4, cc = (c & 15) * 8;
        u32x4 v = *(const u32x4*)(st + row * SLD + cc);
        *(u32x4*)(H + tiled_off(tm * 256 + row, tn * 128 + cc, 44)) = v;
      }
    }
  }
}

DI void phase_gemm_resid(const Params& p, char* WS, const bf16_t* A, const bf16_t* Bt, int K, const float* gmod,
                         float coef, char* smem) {
  const int tid = get_tid512(), lane = tid & 63, wave = tid >> 6, wm = wave >> 2, wn = wave & 3, r = lane & 31, h = lane >> 5;
  float* xo = p.xo;
  TileIter256 ti(4, 2);
  for (int tm, tn; ti.next(tm, tn);) {
    f32x16 acc[4][2]; zero_acc42(acc);
    gemm256_main(A + ((size_t)tm * 2 * (K >> 6) << 13), Bt + ((size_t)tn * 2 * (K >> 6) << 13), K, (bf16_t*)smem, acc);
    const int b = (tm * 256) >> 11;
#pragma unroll
    for (int ni = 0; ni < 2; ++ni) {
      const int col = tn * 256 + wn * 64 + ni * 32 + r;
      const float gs = coef * (1.f + gmod[(size_t)b * 9216 + col]);
#pragma unroll
      for (int mi = 0; mi < 4; ++mi)
#pragma unroll
        for (int i = 0; i < 16; ++i) {
          int row = tm * 256 + wm * 128 + mi * 32 + crow(i, h);
          float* xp = xo + (size_t)row * 1024 + col;
          *xp = *xp + gs * acc[mi][ni][i];
        }
    }
  }
}

DI void phase_inproj(const Params& p, char* WS, char* smem) {
  const int tid = get_tid512(), lane = tid & 63, wave = tid >> 6, wm = wave >> 2, wn = wave & 3, r = lane & 31, h = lane >> 5;
  const bf16_t* U = (const bf16_t*)(WS + OFF_U);
  const bf16_t* W = (const bf16_t*)(WS + OFF_WIN);
  bf16_t* Z = (bf16_t*)(WS + OFF_HZ);
  TileIter256 ti(12, 2);
  for (int tm, tn; ti.next(tm, tn);) {
    f32x16 acc[4][2]; zero_acc42(acc);
    gemm256_main(U + ((size_t)tm * 2 * 16 << 13), W + ((size_t)tn * 2 * 16 << 13), 1024, (bf16_t*)smem, acc);
    {
      constexpr int SLD = 256 + 8;
      bf16_t* st = (bf16_t*)smem;
#pragma unroll
      for (int ni = 0; ni < 2; ++ni)
#pragma unroll
        for (int mi = 0; mi < 4; ++mi)
#pragma unroll
          for (int i = 0; i < 16; ++i)
            st[(wm * 128 + mi * 32 + crow(i, h)) * SLD + wn * 64 + ni * 32 + r] = f2bf(acc[mi][ni][i]);
      __syncthreads();
#pragma unroll
      for (int q = 0; q < 16; ++q) {
        const int c = get_tid512() + 512 * q;
        const int row = c >> 5, cc = (c & 31) * 8;
        if (tn * 256 + cc < ZW) {
          u32x4 v = *(const u32x4*)(st + row * SLD + cc);
          *(u32x4*)(Z + (size_t)(tm * 256 + row) * ZW + tn * 256 + cc) = v;
        }
      }
    }
  }
}

DI void phase_merge(const Params& p, char* WS, char* smem) {
  const int tid = get_tid(), lane = tid & 63, wave = tid >> 6, wm = wave >> 1, wn = wave & 1, r = lane & 31, h = lane >> 5;
  const bf16_t* U = (const bf16_t*)(WS + OFF_U);
  const bf16_t* WG = (const bf16_t*)(WS + OFF_WIN) + (size_t)2944 * 1024;
  const bf16_t* WB = (const bf16_t*)(WS + OFF_WBR);
  bf16_t* M = (bf16_t*)(WS + OFF_MERGED);
  TileIter ti(16);
  for (int tm, tn; ti.next(tm, tn);) {
    f32x16 am[2][1];
#pragma unroll
    for (int i = 0; i < 16; ++i) { am[0][0][i] = 0.f; am[1][0][i] = 0.f; }
#pragma unroll 1
    for (int n = 0; n < 4; ++n) {
      const size_t yoff = (n == 0) ? OFF_YA : (n == 1) ? OFF_YB : (n == 2) ? OFF_YC : OFF_YD;
      const bf16_t* Y = (const bf16_t*)(WS + yoff);
      f32x16 ag[2][1], ab[2][1];
#pragma unroll
      for (int i = 0; i < 16; ++i) { ag[0][0][i] = 0.f; ag[1][0][i] = 0.f; ab[0][0][i] = 0.f; ab[1][0][i] = 0.f; }
      gemm_main<false, 4, 1>(U + ((size_t)tm * 16 << 13), 64, 8192,
                             WG + ((size_t)((n * 1024 + tn * 64) >> 7) * 16 << 13) + (tn & 1) * 64 * 64, 64, 8192, 1024,
                             (bf16_t*)smem, ag, nullptr);
      gemm_main<false, 4, 1>(Y + (size_t)tm * 128 * 512, 512, 64, WB + (size_t)n * 1024 * 512 + ((size_t)(tn >> 1) * 8 << 13) + (tn & 1) * 64 * 64, 64, 8192, 512, (bf16_t*)smem, ab, nullptr);
#pragma unroll
      for (int x = 0; x < 2; ++x)
#pragma unroll
        for (int i = 0; i < 16; ++i) am[x][0][i] += sigmoidf_(ag[x][0][i]) * ab[x][0][i];
    }
    {
      constexpr int SLD = 64 + 8;
      bf16_t* st = (bf16_t*)smem;
#pragma unroll
      for (int mi = 0; mi < 2; ++mi)
#pragma unroll
        for (int i = 0; i < 16; ++i) st[(wm * 64 + mi * 32 + crow(i, h)) * SLD + wn * 32 + r] = f2bf(am[mi][0][i]);
      __syncthreads();
#pragma unroll
      for (int q = 0; q < 4; ++q) {
        const int c = get_tid() + 256 * q;
        const int row = c >> 3, cc = (c & 7) * 8;
        u32x4 v = *(const u32x4*)(st + row * SLD + cc);
        *(u32x4*)(M + tiled_off(tm * 128 + row, tn * 64 + cc, 16)) = v;
      }
    }
  }
}

template <bool PASS2>
DI void s5_item(const Params& p, char* WS, int l, int item, char* smem) {
  const int tid = get_tid(), lane = tid & 63, wave = tid >> 6, r = lane & 31, h = lane >> 5;
  const int b = item >> 5, ck = item & 31;
  const int t0 = b * SEQ + ck * 64;
  const bf16_t* Z = (const bf16_t*)(WS + OFF_HZ);
  const float* AB = (const float*)(WS + OFF_S5AB);
  const bf16_t* BB = (const bf16_t*)(WS + OFF_S5BB);
  const bf16_t* CT = (const bf16_t*)(WS + OFF_S5CT);
  float* ENDS = (float*)(WS + OFF_ENDS);
  bf16_t* YS = (bf16_t*)(WS + OFF_YS5);
  constexpr int XLD = 136;
  bf16_t* img = (bf16_t*)smem + (size_t)wave * 64 * XLD;
  const int tokA = 32 * ((r >> 2) & 1) + (r & 3) + 4 * (r >> 3);
  for (int gi = 0; gi < 8; ++gi) {
    const int g = wave * 8 + gi;
    bf16x8 af[2];
#pragma unroll
    for (int m = 0; m < 2; ++m) af[m] = *(const bf16x8*)(Z + (size_t)(t0 + tokA + 16 * m) * ZW + Z_US5 + g * 16 + 8 * h);
    if (PASS2) __syncthreads();
#pragma unroll 1
    for (int sb = 0; sb < 2; ++sb) {
      const int st = sb * 32 + r;
      const float4 abv = *(const float4*)(AB + (size_t)(g * 64 + st) * 4);
      const float ar = abv.x, ai = abv.y;
      bf16x8 bfr = *(const bf16x8*)(BB + ((size_t)g * 128 + st) * 16 + 8 * h);
      bf16x8 bfi = *(const bf16x8*)(BB + ((size_t)g * 128 + 64 + st) * 16 + 8 * h);
      f32x16 zr;
#pragma unroll
      for (int i = 0; i < 16; ++i) zr[i] = 0.f;
      f32x16 bur0 = MFMA32(af[0], bfr, zr), bur1 = MFMA32(af[1], bfr, zr);
      f32x16 bui0 = MFMA32(af[0], bfi, zr), bui1 = MFMA32(af[1], bfi, zr);
      float cr = 0.f, ci = 0.f;
      if (PASS2) {
        const float a64r = abv.z, a64i = abv.w;
        const float* e0 = ENDS + (((size_t)(b * 32) * 32 + g) * 128) + st;
        int c2 = 0;
        for (; c2 + 2 <= ck; c2 += 2) {
          float er[2], ei[2];
#pragma unroll
          for (int q = 0; q < 2; ++q) { er[q] = e0[(size_t)(c2 + q) * 4096]; ei[q] = e0[(size_t)(c2 + q) * 4096 + 64]; }
#pragma unroll
          for (int q = 0; q < 2; ++q) {
            float nr = a64r * cr - a64i * ci + er[q], ni = a64r * ci + a64i * cr + ei[q];
            cr = nr; ci = ni;
          }
        }
        for (; c2 < ck; ++c2) {
          float er = e0[(size_t)c2 * 4096], ei = e0[(size_t)c2 * 4096 + 64];
          float nr = a64r * cr - a64i * ci + er, ni = a64r * ci + a64i * cr + ei;
          cr = nr; ci = ni;
        }
      }
      float xr = cr, xi = ci;
#pragma unroll
      for (int i = 0; i < 16; ++i) { float nr = ar * xr - ai * xi + bur0[i], ni = ar * xi + ai * xr + bui0[i]; xr = nr; xi = ni; }
#pragma unroll
      for (int i = 0; i < 16; ++i) { float nr = ar * xr - ai * xi + bur1[i], ni = ar * xi + ai * xr + bui1[i]; xr = nr; xi = ni; }
      float er0 = xshfl(xr, r), ei0 = xshfl(xi, r);
      xr = h ? er0 : cr; xi = h ? ei0 : ci;
#pragma unroll
      for (int i = 0; i < 16; ++i) {
        float nr = ar * xr - ai * xi + bur0[i], ni = ar * xi + ai * xr + bui0[i]; xr = nr; xi = ni;
        if (PASS2) { int tk = 32 * h + i; img[tk * XLD + st] = f2bf(xr); img[tk * XLD + 64 + st] = f2bf(xi); }
      }
#pragma unroll
      for (int i = 0; i < 16; ++i) {
        float nr = ar * xr - ai * xi + bur1[i], ni = ar * xi + ai * xr + bui1[i]; xr = nr; xi = ni;
        if (PASS2) { int tk = 32 * h + 16 + i; img[tk * XLD + st] = f2bf(xr); img[tk * XLD + 64 + st] = f2bf(xi); }
      }
      if (!PASS2) {
        if (h) { float* e = ENDS + (((size_t)(b * 32 + ck) * 32 + g) * 128); e[st] = xr; e[64 + st] = xi; }
      }
    }
    if (PASS2) {
      __syncthreads();
      f32x16 y0, y1;
#pragma unroll
      for (int i = 0; i < 16; ++i) { y0[i] = 0.f; y1[i] = 0.f; }
#pragma unroll
      for (int s = 0; s < 8; ++s) {
        bf16x8 cf;
        if (r < 16) cf = *(const bf16x8*)(CT + ((size_t)g * 16 + r) * 128 + 16 * s + 8 * h);
        else {
#pragma unroll
          for (int j = 0; j < 8; ++j) cf[j] = 0;
        }
        bf16x8 a0 = *(const bf16x8*)(img + (r)*XLD + 16 * s + 8 * h);
        bf16x8 a1 = *(const bf16x8*)(img + (32 + r) * XLD + 16 * s + 8 * h);
        y0 = MFMA32(a0, cf, y0); y1 = MFMA32(a1, cf, y1);
      }
      if (r < 16) {
        const int ch = g * 16 + r;
        const float dd = p.s5_d[l * 512 + ch];
#pragma unroll
        for (int i = 0; i < 16; ++i) {
          int tk = crow(i, h);
          float u0 = bf2f(Z[(size_t)(t0 + tk) * ZW + Z_US5 + ch]);
          float u1 = bf2f(Z[(size_t)(t0 + 32 + tk) * ZW + Z_US5 + ch]);
          YS[(size_t)(t0 + tk) * 512 + ch] = f2bf(gelu_tanh(y0[i] + dd * u0));
          YS[(size_t)(t0 + 32 + tk) * 512 + ch] = f2bf(gelu_tanh(y1[i] + dd * u1));
        }
      }
    }
  }
}

DI void dsa_prep_qk(const Params& p, char* WS, int l, int bitem) {
  const int idx = bitem * NTHREADS + get_tid();
  if (idx >= T * 9) return;
  const int t = idx / 9, role = idx % 9;
  bf16_t* Z = (bf16_t*)(WS + OFF_HZ);
  const float* rope = (const float*)(WS + OFF_ROPE) + (size_t)t * 56;
  bf16_t* src = Z + (size_t)t * ZW + (role < 8 ? Z_QDSA + role * 64 : Z_KDSA);
  bf16_t* dst = (role < 8) ? src : (bf16_t*)(WS + OFF_KD) + (size_t)t * 64;
  const float* gain = p.dsa_qk_gain + (l * 2 + (role < 8 ? 0 : 1)) * 64;
  float v[64];
#pragma unroll
  for (int q = 0; q < 8; ++q) unpack8(*(const u32x4*)(src + q * 8), v + q * 8);
  float ss = 0.f;
#pragma unroll
  for (int j = 0; j < 64; ++j) ss += v[j] * v[j];
  const float rs = rsqrtf(ss * (1.f / 64.f) + 1e-6f);
#pragma unroll
  for (int j = 0; j < 64; ++j) v[j] = v[j] * rs * gain[j];
#pragma unroll
  for (int i = 0; i < 8; ++i) {
    float c = rope[32 + i], s = rope[40 + i];
    float x1 = v[i], x2 = v[8 + i];
    v[i] = x1 * c - x2 * s; v[8 + i] = x2 * c + x1 * s;
  }
#pragma unroll
  for (int q = 0; q < 8; ++q) *(u32x4*)(dst + q * 8) = pack8(v + q * 8);
}
DI void dsa_prep_idx(const Params& p, char* WS, int bitem) {
  const int idx = bitem * NTHREADS + get_tid();
  if (idx >= T * 9) return;
  const int t = idx / 9, role = idx % 9;
  bf16_t* Z = (bf16_t*)(WS + OFF_HZ);
  const float* rope = (const float*)(WS + OFF_ROPE) + (size_t)t * 56;
  bf16_t* src = Z + (size_t)t * ZW + (role < 8 ? Z_QIDX + role * 32 : Z_KIDX);
  bf16_t* dst = (role < 8) ? src : (bf16_t*)(WS + OFF_KI) + (size_t)t * 32;
  float v[32];
#pragma unroll
  for (int q = 0; q < 4; ++q) unpack8(*(const u32x4*)(src + q * 8), v + q * 8);
#pragma unroll
  for (int i = 0; i < 4; ++i) {
    float c = rope[48 + i], s = rope[52 + i];
    float x1 = v[i], x2 = v[4 + i];
    v[i] = x1 * c - x2 * s; v[4 + i] = x2 * c + x1 * s;
  }
#pragma unroll
  for (int q = 0; q < 4; ++q) *(u32x4*)(dst + q * 8) = pack8(v + q * 8);
}
DI void dsa_prep_vt(const Params& p, char* WS, int item, char* smem) {
  const int tid = get_tid();
  const int b = item >> 5, ck = item & 31;
  const bf16_t* Z = (const bf16_t*)(WS + OFF_HZ);
  bf16_t* VTD = (bf16_t*)(WS + OFF_VTD);
  bf16_t* tile = (bf16_t*)smem;
  __syncthreads();
  {
    const int tt = tid >> 2, dq = (tid & 3) * 16;
    const bf16_t* s = Z + (size_t)(b * SEQ + ck * 64 + tt) * ZW + Z_VDSA + dq;
    u32x4 a = *(const u32x4*)s, c = *(const u32x4*)(s + 8);
    uint32_t w[8] = {a.x, a.y, a.z, a.w, c.x, c.y, c.z, c.w};
#pragma unroll
    for (int e = 0; e < 8; ++e) *(uint32_t*)(tile + tt * 66 + dq + 2 * e) = w[e];
  }
  __syncthreads();
  {
    const int d = tid >> 2, tq = (tid & 3) * 16;
    uint32_t w[8];
#pragma unroll
    for (int e = 0; e < 8; ++e) w[e] = (uint32_t)tile[(tq + 2 * e) * 66 + d] | ((uint32_t)tile[(tq + 2 * e + 1) * 66 + d] << 16);
    bf16_t* o = VTD + ((size_t)b * 64 + d) * SEQ + ck * 64 + tq;
    *(u32x4*)o = u32x4{w[0], w[1], w[2], w[3]};
    *(u32x4*)(o + 8) = u32x4{w[4], w[5], w[6], w[7]};
  }
}

DI void rg_conv(const Params& p, char* WS, int l, int bitem) {
  const int idx = bitem * NTHREADS + get_tid();
  const int t = idx >> 6, c0 = (idx & 63) * 8;
  const int tl = t & (SEQ - 1);
  const bf16_t* Z = (const bf16_t*)(WS + OFF_HZ);
  float acc[8];
#pragma unroll
  for (int e = 0; e < 8; ++e) acc[e] = p.conv_b[l * 512 + c0 + e];
#pragma unroll
  for (int w = 0; w < 4; ++w) {
    int dt = w - 3;
    if (tl + dt >= 0) {
      float f[8]; unpack8(*(const u32x4*)(Z + (size_t)(t + dt) * ZW + Z_XRNN + c0), f);
#pragma unroll
      for (int e = 0; e < 8; ++e) acc[e] += f[e] * p.conv_w[(l * 4 + w) * 512 + c0 + e];
    }
  }
  *(u32x4*)((bf16_t*)(WS + OFF_XC) + (size_t)t * 512 + c0) = pack8(acc);
}

DI void mla_up_tile(const Params& p, char* WS, int t, bool kv, char* smem) {
  const int tid = get_tid(), lane = tid & 63, wave = tid >> 6, wm = wave >> 1, wn = wave & 1, r = lane & 31, h = lane >> 5;
  const bf16_t* Z = (const bf16_t*)(WS + OFF_HZ);
  float* rowstat = (float*)(smem + 4 * TILE_ELEMS * 2);
  f32x16 acc[2][2]; zero_acc(acc);
  if (!kv) {
    const int tm = t / 6, tn = t % 6;
    gemm_main<true>(Z + (size_t)tm * 128 * ZW + Z_QLAT, ZW, 64, (const bf16_t*)(WS + OFF_WUQ) + ((size_t)tn * 4 << 13), 64, 8192, 256,
                    (bf16_t*)smem, acc, rowstat);
    bf16_t* Q = (bf16_t*)(WS + OFF_Q);
#pragma unroll
    for (int mi = 0; mi < 2; ++mi)
#pragma unroll
      for (int ni = 0; ni < 2; ++ni)
#pragma unroll
        for (int i = 0; i < 16; ++i) {
          int rl = wm * 64 + mi * 32 + crow(i, h);
          int col = tn * 128 + wn * 64 + ni * 32 + r;
          Q[(size_t)(tm * 128 + rl) * 768 + col] = f2bf(acc[mi][ni][i] * rowstat[rl]);
        }
  } else {
    const int tm = t >> 3, hd = t & 7;
    gemm_main<true>(Z + (size_t)tm * 128 * ZW + Z_KVLAT, ZW, 64, (const bf16_t*)(WS + OFF_WUKV) + ((size_t)hd * 2 << 13), 64, 8192, 128,
                    (bf16_t*)smem, acc, rowstat);
    if (wn == 0) {
      bf16_t* KN = (bf16_t*)(WS + OFF_KNOPE);
#pragma unroll
      for (int mi = 0; mi < 2; ++mi)
#pragma unroll
        for (int ni = 0; ni < 2; ++ni)
#pragma unroll
          for (int i = 0; i < 16; ++i) {
            int rl = wm * 64 + mi * 32 + crow(i, h);
            KN[(size_t)(tm * 128 + rl) * 512 + hd * 64 + ni * 32 + r] = f2bf(acc[mi][ni][i] * rowstat[rl]);
          }
    } else {
      bf16_t* VT = (bf16_t*)(WS + OFF_VT);
      const int b = (tm * 128) >> 11, tl0 = (tm * 128) & (SEQ - 1);
#pragma unroll
      for (int mi = 0; mi < 2; ++mi)
#pragma unroll
        for (int ni = 0; ni < 2; ++ni)
#pragma unroll
          for (int g4 = 0; g4 < 4; ++g4) {
            int rl = wm * 64 + mi * 32 + 8 * g4 + 4 * h;
            u32x2 o;
            o.x = pack2(acc[mi][ni][4 * g4] * rowstat[rl], acc[mi][ni][4 * g4 + 1] * rowstat[rl + 1]);
            o.y = pack2(acc[mi][ni][4 * g4 + 2] * rowstat[rl + 2], acc[mi][ni][4 * g4 + 3] * rowstat[rl + 3]);
            *(u32x2*)(VT + ((size_t)(b * 8 + hd) * 64 + ni * 32 + r) * SEQ + tl0 + rl) = o;
          }
    }
  }
}

DI void mla_elem(const Params& p, char* WS, int l, int bitem) {
  const int idx = bitem * NTHREADS + get_tid();
  const int t = idx >> 4, role = idx & 15;
  const int hd = role & 7; const bool isk = role >= 8;
  bf16_t* Q = (bf16_t*)(WS + OFF_Q);
  const bf16_t* Z = (const bf16_t*)(WS + OFF_HZ);
  const bf16_t* KN = (const bf16_t*)(WS + OFF_KNOPE);
  bf16_t* K = (bf16_t*)(WS + OFF_K);
  const float* rope = (const float*)(WS + OFF_ROPE) + (size_t)t * 56;
  const bf16_t* s0 = isk ? Z + (size_t)t * ZW + Z_KPE : Q + (size_t)t * 768 + hd * 96;
  const bf16_t* s1 = isk ? KN + (size_t)t * 512 + hd * 64 : Q + (size_t)t * 768 + hd * 96 + 32;
  bf16_t* dst = isk ? K + (size_t)t * 768 + hd * 96 : Q + (size_t)t * 768 + hd * 96;
  const float* gain = p.mla_qk_gain + (l * 2 + (isk ? 1 : 0)) * 96;
  float v[96];
#pragma unroll
  for (int q = 0; q < 4; ++q) unpack8(*(const u32x4*)(s0 + q * 8), v + q * 8);
#pragma unroll
  for (int q = 0; q < 8; ++q) unpack8(*(const u32x4*)(s1 + q * 8), v + 32 + q * 8);
  float ss = 0.f;
#pragma unroll
  for (int j = 0; j < 96; ++j) ss += v[j] * v[j];
  const float rs = rsqrtf(ss * (1.f / 96.f) + 1e-6f);
#pragma unroll
  for (int j = 0; j < 96; ++j) v[j] = v[j] * rs * gain[j];
#pragma unroll
  for (int i = 0; i < 16; ++i) {
    float c = rope[i], s = rope[16 + i];
    float x1 = v[i], x2 = v[16 + i];
    v[i] = x1 * c - x2 * s; v[16 + i] = x2 * c + x1 * s;
  }
#pragma unroll
  for (int q = 0; q < 12; ++q) *(u32x4*)(dst + q * 8) = pack8(v + q * 8);
}

DI void rg_gate_tile(const Params& p, char* WS, int l, int t, char* smem) {
  const int tid = get_tid(), lane = tid & 63, wave = tid >> 6, wm = wave >> 1, wn = wave & 1, r = lane & 31, h = lane >> 5;
  const int tm = t >> 3, hd = t & 7;
  const bf16_t* XC = (const bf16_t*)(WS + OFF_XC);
  f32x16 acc[2][2]; zero_acc(acc);
  gemm_main<false>(XC + (size_t)tm * 128 * 512 + hd * 64, 512, 64, (const bf16_t*)(WS + OFF_WRG) + (size_t)hd * 128 * 64, 64, 64, 64,
                   (bf16_t*)smem, acc, nullptr);
  const int ch = hd * 64 + wn * 32 + r;
  const float ba = p.rg_ba[l * 512 + ch], bx = p.rg_bx[l * 512 + ch];
  const float lam = p.rg_lambda[l * 512 + ch];
  const float sp = log1pf(__expf(-lam));
  bf16_t* LOGA = (bf16_t*)(WS + OFF_LOGA);
  bf16_t* INP = (bf16_t*)(WS + OFF_INP);
#pragma unroll
  for (int mi = 0; mi < 2; ++mi)
#pragma unroll
    for (int i = 0; i < 16; ++i) {
      int row = tm * 128 + wm * 64 + mi * 32 + crow(i, h);
      float rg = sigmoidf_(acc[mi][0][i] + ba), ig = sigmoidf_(acc[mi][1][i] + bx);
      float loga = -8.f * rg * sp;
      float mult = sqrtf(fmaxf(1.f - __expf(2.f * loga), 0.f));
      float xc = bf2f(XC[(size_t)row * 512 + ch]);
      LOGA[(size_t)row * 512 + ch] = f2bf(loga);
      INP[(size_t)row * 512 + ch] = f2bf(mult * ig * xc);
    }
}

DI void rg_scan_item(const Params& p, char* WS, int item, char* smem) {
  const int tid = get_tid(), c8 = tid & 7, seg = tid >> 3;
  const int b = item >> 3, hd = item & 7;
  const int ch = hd * 64 + c8 * 8;
  const bf16_t* LOGA = (const bf16_t*)(WS + OFF_LOGA) + (size_t)b * SEQ * 512 + ch;
  const bf16_t* INP = (const bf16_t*)(WS + OFF_INP) + (size_t)b * SEQ * 512 + ch;
  const bf16_t* G = (const bf16_t*)(WS + OFF_HZ) + (size_t)b * SEQ * ZW + Z_GATE + ch;
  bf16_t* YA = (bf16_t*)(WS + OFF_YA) + (size_t)b * SEQ * 512 + ch;
  float* ex = (float*)smem;
  const int ts = seg * 64;
  float P[8], hh[8];
#pragma unroll
  for (int e = 0; e < 8; ++e) { P[e] = 1.f; hh[e] = 0.f; }
#pragma unroll 4
  for (int i = 0; i < 64; ++i) {
    float la[8], in[8];
    unpack8(*(const u32x4*)(LOGA + (size_t)(ts + i) * 512), la);
    unpack8(*(const u32x4*)(INP + (size_t)(ts + i) * 512), in);
#pragma unroll
    for (int e = 0; e < 8; ++e) { float a = __expf(la[e]); hh[e] = a * hh[e] + in[e]; P[e] *= a; }
  }
  __syncthreads();
#pragma unroll
  for (int e = 0; e < 8; ++e) { ex[((seg * 64) + c8 * 8 + e) * 2] = P[e]; ex[((seg * 64) + c8 * 8 + e) * 2 + 1] = hh[e]; }
  __syncthreads();
#pragma unroll
  for (int e = 0; e < 8; ++e) hh[e] = 0.f;
  for (int s2 = 0; s2 < seg; ++s2) {
#pragma unroll
    for (int e = 0; e < 8; ++e) hh[e] = ex[((s2 * 64) + c8 * 8 + e) * 2] * hh[e] + ex[((s2 * 64) + c8 * 8 + e) * 2 + 1];
  }
#pragma unroll 4
  for (int i = 0; i < 64; ++i) {
    float la[8], in[8], gt[8], o[8];
    unpack8(*(const u32x4*)(LOGA + (size_t)(ts + i) * 512), la);
    unpack8(*(const u32x4*)(INP + (size_t)(ts + i) * 512), in);
    unpack8(*(const u32x4*)(G + (size_t)(ts + i) * ZW), gt);
#pragma unroll
    for (int e = 0; e < 8; ++e) { float a = __expf(la[e]); hh[e] = a * hh[e] + in[e]; o[e] = hh[e] * gelu_tanh(gt[e]); }
    *(u32x4*)(YA + (size_t)(ts + i) * 512) = pack8(o);
  }
}

DI void glu_tile(const Params& p, char* WS, int l, int t, char* smem) {
  const int tid = get_tid(), lane = tid & 63, wave = tid >> 6, wm = wave >> 1, wn = wave & 1, r = lane & 31, h = lane >> 5;
  const int tm = t >> 2, tn = t & 3;
  const bf16_t* YS = (const bf16_t*)(WS + OFF_YS5);
  bf16_t* YD = (bf16_t*)(WS + OFF_YD);
  f32x16 acc[2][2]; zero_acc(acc);
  gemm_main<false>(YS + (size_t)tm * 128 * 512, 512, 64, (const bf16_t*)(WS + OFF_WGLU) + ((size_t)tn * 8 << 13), 64, 8192, 512,
                   (bf16_t*)smem, acc, nullptr);
#pragma unroll
  for (int ni = 0; ni < 2; ++ni) {
    const int col = tn * 128 + wn * 64 + ni * 32 + r;
    const float bg = p.s5_bglu[l * 512 + col];
#pragma unroll
    for (int mi = 0; mi < 2; ++mi)
#pragma unroll
      for (int i = 0; i < 16; ++i) {
        int row = tm * 128 + wm * 64 + mi * 32 + crow(i, h);
        float y = bf2f(YS[(size_t)row * 512 + col]);
        YD[(size_t)row * 512 + col] = f2bf(y * sigmoidf_(acc[mi][ni][i] + bg));
      }
  }
}

DI void mla_attn_item(const Params& p, char* WS, int l, int item, char* smem) {
  const int tid = get_tid(), lane = tid & 63, wave = tid >> 6, r = lane & 31, h = lane >> 5;
  const int qt = 15 - (item >> 7); const int bh = item & 127; const int b = bh >> 3, hd = bh & 7;
  const int q0 = qt * 128 + wave * 32;
  constexpr int KLD = 104, VLD = 72;
  bf16_t* Kt = (bf16_t*)smem;
  bf16_t* Vt = Kt + 2 * 64 * KLD;
  const bf16_t* Qp = (const bf16_t*)(WS + OFF_Q) + (size_t)(b * SEQ + q0 + r) * 768 + hd * 96 + h * 8;
  bf16x8 bq[6];
#pragma unroll
  for (int s6 = 0; s6 < 6; ++s6) bq[s6] = *(const bf16x8*)(Qp + s6 * 16);
  const bf16_t* Kb = (const bf16_t*)(WS + OFF_K) + (size_t)b * SEQ * 768 + hd * 96;
  const bf16_t* Vb = (const bf16_t*)(WS + OFF_VT) + (size_t)(b * 8 + hd) * 64 * SEQ;
  const float* g0 = p.mla_qk_gain + (l * 2) * 96; const float* g1 = g0 + 96;
  float m0 = fmaxf(fabsf(g0[lane]), lane < 32 ? fabsf(g0[64 + lane]) : 0.f);
  float m1 = fmaxf(fabsf(g1[lane]), lane < 32 ? fabsf(g1[64 + lane]) : 0.f);
  m0 = wave_max(m0); m1 = wave_max(m1);
  const float LOG2E = 1.4426950408889634f;
  const float sc2 = 0.10206207261596577f * LOG2E;
  const float cc2 = 9.797958971132712f * m0 * m1 * LOG2E;
  int krow[3], kcol[3];
#pragma unroll
  for (int i = 0; i < 3; ++i) { int c = tid + 256 * i; krow[i] = c / 12; kcol[i] = (c % 12) * 8; }
  int vrow[2], vcol[2];
#pragma unroll
  for (int i = 0; i < 2; ++i) { int c = tid + 256 * i; vrow[i] = c >> 3; vcol[i] = (c & 7) * 8; }
  u32x4 rk0[3], rv0[2], rk1[3], rv1[2];
  f32x16 o0, o1;
#pragma unroll
  for (int i = 0; i < 16; ++i) { o0[i] = 0.f; o1[i] = 0.f; }
  float lsum = 0.f;
  const int nkt = qt * 2 + 2;
#define A_LOAD(RK, RV, KT)                                                                                  \
  {                                                                                                         \
    const int kk_ = ((KT) < nkt ? (KT) : nkt - 1) * 64;                                                     \
    _Pragma("unroll") for (int i = 0; i < 3; ++i) RK[i] = *(const u32x4*)(Kb + (size_t)(kk_ + krow[i]) * 768 + kcol[i]); \
    _Pragma("unroll") for (int i = 0; i < 2; ++i) RV[i] = *(const u32x4*)(Vb + (size_t)vrow[i] * SEQ + kk_ + vcol[i]);   \
  }
#define A_STORE(RK, RV, BUF)                                                                                \
  {                                                                                                         \
    _Pragma("unroll") for (int i = 0; i < 3; ++i) *(u32x4*)(Kt + (BUF) * 64 * KLD + krow[i] * KLD + kcol[i]) = RK[i]; \
    _Pragma("unroll") for (int i = 0; i < 2; ++i) *(u32x4*)(Vt + (BUF) * 64 * VLD + vrow[i] * VLD + vcol[i]) = RV[i]; \
  }
#define A_COMPUTE(BUF, KT)                                                                                  \
  {                                                                                                         \
    const int k0 = (KT) * 64;                                                                               \
    const bf16_t* kc = Kt + (BUF) * 64 * KLD;                                                               \
    const bf16_t* vc = Vt + (BUF) * 64 * VLD;                                                               \
    _Pragma("unroll") for (int sub = 0; sub < 2; ++sub) {                                                   \
      const int ks0 = k0 + sub * 32;                                                                        \
      if (ks0 <= q0 + 31) {                                                                                 \
        f32x16 sacc;                                                                                        \
        _Pragma("unroll") for (int i = 0; i < 16; ++i) sacc[i] = 0.f;                                       \
        _Pragma("unroll") for (int s6 = 0; s6 < 6; ++s6) {                                                  \
          bf16x8 ka = *(const bf16x8*)(kc + (sub * 32 + r) * KLD + s6 * 16 + h * 8);                        \
          sacc = MFMA32(ka, bq[s6], sacc);                                                                  \
        }                                                                                                   \
        const bool diag = (ks0 + 31 > q0);                                                                  \
        float pv[16];                                                                                       \
        _Pragma("unroll") for (int i = 0; i < 16; ++i) {                                                    \
          float e = __builtin_amdgcn_exp2f(sacc[i] * sc2 - cc2);                                            \
          if (diag && (ks0 + crow(i, h) > q0 + r)) e = 0.f;                                                 \
          pv[i] = e; lsum += e;                                                                             \
        }                                                                                                   \
        _Pragma("unroll") for (int s2 = 0; s2 < 2; ++s2) {                                                  \
          u32x4 pfu;                                                                                        \
          pfu.x = pack2_mfma(pv[8 * s2 + 0], pv[8 * s2 + 1]); pfu.y = pack2_mfma(pv[8 * s2 + 2], pv[8 * s2 + 3]); \
          pfu.z = pack2_mfma(pv[8 * s2 + 4], pv[8 * s2 + 5]); pfu.w = pack2_mfma(pv[8 * s2 + 6], pv[8 * s2 + 7]); \
          bf16x8 pf = __builtin_bit_cast(bf16x8, pfu);                                                      \
          const bf16_t* vp = vc + r * VLD + sub * 32 + 16 * s2 + 4 * h;                                     \
          bf16x4 l0 = *(const bf16x4*)vp, h0 = *(const bf16x4*)(vp + 8);                                    \
          bf16x4 l1 = *(const bf16x4*)(vp + 32 * VLD), h1 = *(const bf16x4*)(vp + 32 * VLD + 8);            \
          bf16x8 va0 = __builtin_shufflevector(l0, h0, 0, 1, 2, 3, 4, 5, 6, 7);                             \
          bf16x8 va1 = __builtin_shufflevector(l1, h1, 0, 1, 2, 3, 4, 5, 6, 7);                             \
          o0 = MFMA32(va0, pf, o0); o1 = MFMA32(va1, pf, o1);                                               \
        }                                                                                                   \
      }                                                                                                     \
    }                                                                                                       \
  }
  A_LOAD(rk0, rv0, 0);
  A_LOAD(rk1, rv1, 1);
  __syncthreads();
  A_STORE(rk0, rv0, 0);
  __syncthreads();
  for (int kt = 0; kt < nkt; kt += 2) {
    A_LOAD(rk0, rv0, kt + 2);
    __builtin_amdgcn_sched_barrier(0);
    A_COMPUTE(0, kt);
    __builtin_amdgcn_sched_barrier(0);
    A_STORE(rk1, rv1, 1);
    __syncthreads();
    A_LOAD(rk1, rv1, kt + 3);
    __builtin_amdgcn_sched_barrier(0);
    A_COMPUTE(1, kt + 1);
    __builtin_amdgcn_sched_barrier(0);
    A_STORE(rk0, rv0, 0);
    __syncthreads();
  }
#undef A_LOAD
#undef A_STORE
#undef A_COMPUTE
  const float lt = lsum + xshfl_xor(lsum, 32);
  const float inv = 1.f / lt;
  bf16_t* yb = (bf16_t*)(WS + OFF_YB) + (size_t)(b * SEQ + q0 + r) * 512 + hd * 64;
#pragma unroll
  for (int g4 = 0; g4 < 4; ++g4) {
    u32x2 a, c;
    a.x = pack2(o0[4 * g4] * inv, o0[4 * g4 + 1] * inv); a.y = pack2(o0[4 * g4 + 2] * inv, o0[4 * g4 + 3] * inv);
    c.x = pack2(o1[4 * g4] * inv, o1[4 * g4 + 1] * inv); c.y = pack2(o1[4 * g4 + 2] * inv, o1[4 * g4 + 3] * inv);
    *(u32x2*)(yb + 8 * g4 + 4 * h) = a;
    *(u32x2*)(yb + 32 + 8 * g4 + 4 * h) = c;
  }
}

DI uint32_t sortable(float f) { uint32_t u = __float_as_uint(f); return (u & 0x80000000u) ? ~u : (u | 0x80000000u); }
DI float idx_score(const f32x16& a, const uint32_t (&wvp)[8], int jq) {
  float s = 0.f;
#pragma unroll
  for (int hd = 0; hd < 8; ++hd) {
    const uint32_t pw = wvp[4 * jq + (hd >> 1)];
    const float w = __uint_as_float((hd & 1) ? (pw & 0xffff0000u) : (pw << 16));
    s = fmaf(w, fmaxf(a[8 * jq + hd], 0.f), s);
  }
  return s;
}
DI int half_sum(int v) {
#pragma unroll
  for (int o = 16; o > 0; o >>= 1) v += xshfl_xor_i(v, o);
  return v;
}
DI void dsa_scores(const bf16_t* KI, const bf16x8 (&aqi)[2], const uint32_t (&wv)[8], int r, int h, int myq0, int ktmax,
                   uint32_t (&sk)[64], uint32_t* stash) {
  const bf16_t* kp = KI + (size_t)r * 32 + 8 * h;
#pragma unroll
  for (int g4 = 0; g4 < 16; ++g4) {
    if (g4 * 4 <= ktmax) {
      asm volatile("" : "+v"(kp));
#pragma unroll
      for (int e = 0; e < 4; ++e) {
        const int kt = g4 * 4 + e;
        f32x16 a;
#pragma unroll
        for (int i = 0; i < 16; ++i) a[i] = 0.f;
#pragma unroll
        for (int s2 = 0; s2 < 2; ++s2) {
          bf16x8 kb = *(const bf16x8*)(kp + e * 1024 + 16 * s2);
          a = MFMA32(aqi[s2], kb, a);
        }
        const int key = kt * 32 + r;
        const float s0 = idx_score(a, wv, 0), s1 = idx_score(a, wv, 1);
        sk[kt] = (key <= myq0) ? sortable(s0) : 0u;
        stash[kt * 64] = (key <= myq0 + 1) ? sortable(s1) : 0u;
      }
      kp += 4 * 1024;
    } else {
#pragma unroll
      for (int e = 0; e < 4; ++e) { sk[4 * g4 + e] = 0u; stash[(4 * g4 + e) * 64] = 0u; }
    }
  }
}
DI void dsa_unstash(uint32_t (&sk)[64], const uint32_t* stash, int ktmax) {
#pragma unroll
  for (int g8 = 0; g8 < 8; ++g8) {
    if (g8 * 8 <= ktmax) {
#pragma unroll
      for (int e = 0; e < 8; ++e) sk[8 * g8 + e] = stash[(8 * g8 + e) * 64];
    } else {
#pragma unroll
      for (int e = 0; e < 8; ++e) sk[8 * g8 + e] = 0u;
    }
  }
}
DI void dsa_threshold(const uint32_t (&sk)[64], int r, int ktmax, uint32_t& thr_out, int& cut_out) {
  uint32_t prefix = 0u;
#pragma unroll 1
  for (int bit = 31; bit >= 0; --bit) {
    const uint32_t cand = prefix | (1u << bit);
    int cnt = 0;
#pragma unroll
    for (int g8 = 0; g8 < 8; ++g8) {
      if (g8 * 8 <= ktmax) {
#pragma unroll
        for (int e = 0; e < 8; ++e) cnt += (sk[g8 * 8 + e] >= cand) ? 1 : 0;
      }
    }
    cnt = half_sum(cnt);
    if (cnt >= 256) prefix = cand;
  }
  int cgt = 0, ceq = 0;
#pragma unroll
  for (int kt = 0; kt < 64; ++kt) { cgt += (sk[kt] > prefix) ? 1 : 0; ceq += (sk[kt] == prefix) ? 1 : 0; }
  cgt = half_sum(cgt); ceq = half_sum(ceq);
  const int need = 256 - cgt;
  int c = 0x7fffffff;
  const bool excess = (prefix != 0u) && (ceq > need);
  if (__any(excess)) {
    int cc = 0;
#pragma unroll 1
    for (int bit = 10; bit >= 0; --bit) {
      const int test = cc | (1 << bit);
      int cnt = 0;
#pragma unroll
      for (int kt = 0; kt < 64; ++kt) cnt += (sk[kt] == prefix && (kt * 32 + r) < test) ? 1 : 0;
      cnt = half_sum(cnt);
      if (cnt < need) cc = test;
    }
    if (excess) c = cc;
  }
  thr_out = prefix; cut_out = c;
}

DI void dsa_item(const Params& p, char* WS, int l, int item, char* smem) {
  const int tid = get_tid(), lane = tid & 63, wave = tid >> 6, r = lane & 31, h = lane >> 5;
  const int qt = 127 - (item >> 4); const int b = item & 15;
  const int tq0 = qt * 16 + wave * 4;
  const bf16_t* Z = (const bf16_t*)(WS + OFF_HZ);
  const bf16_t* KI = (const bf16_t*)(WS + OFF_KI) + (size_t)b * SEQ * 32;
  const bf16_t* KD = (const bf16_t*)(WS + OFF_KD) + (size_t)b * SEQ * 64;
  const bf16_t* VTD = (const bf16_t*)(WS + OFF_VTD) + (size_t)b * 64 * SEQ;
  const int ai = (r & 3) + 4 * (r >> 3);
  const int aq = 2 * ((r >> 2) & 1) + (ai >> 3), ah = ai & 7;
  bf16x8 aqi[2];
#pragma unroll
  for (int s2 = 0; s2 < 2; ++s2)
    aqi[s2] = *(const bf16x8*)(Z + (size_t)(b * SEQ + tq0 + aq) * ZW + Z_QIDX + ah * 32 + 16 * s2 + 8 * h);
  uint32_t wv[8];
#pragma unroll
  for (int jq = 0; jq < 2; ++jq) {
    u32x4 w8 = *(const u32x4*)(Z + (size_t)(b * SEQ + tq0 + 2 * h + jq) * ZW + Z_WIDX);
    wv[4 * jq] = w8.x; wv[4 * jq + 1] = w8.y; wv[4 * jq + 2] = w8.z; wv[4 * jq + 3] = w8.w;
  }
  const int myq0 = tq0 + 2 * h;
  const int ktmax = (tq0 + 3) >> 5;
  uint32_t thr[2]; int cut[2];
  {
    uint32_t* stash = (uint32_t*)smem + (size_t)wave * 64 * 64 + lane;
    uint32_t sk[64];
    dsa_scores(KI, aqi, wv, r, h, myq0, ktmax, sk, stash);
    asm volatile("" ::: "memory");
    dsa_threshold(sk, r, ktmax, thr[0], cut[0]);
    dsa_unstash(sk, stash, ktmax);
    asm volatile("" ::: "memory");
    dsa_threshold(sk, r, ktmax, thr[1], cut[1]);
  }
  asm volatile("" ::: "memory");
  constexpr int KLD = 72, VLD = 72, ILD = 40;
  bf16_t* Kt = (bf16_t*)smem;
  bf16_t* Vt = Kt + 2 * 64 * KLD;
  bf16_t* It = Vt + 2 * 64 * VLD;
  const int cq = r >> 3, chd = r & 7;
  bf16x8 bq[4];
#pragma unroll
  for (int s4 = 0; s4 < 4; ++s4)
    bq[s4] = *(const bf16x8*)(Z + (size_t)(b * SEQ + tq0 + cq) * ZW + Z_QDSA + chd * 64 + 16 * s4 + 8 * h);
  const float* g0 = p.dsa_qk_gain + (l * 2) * 64; const float* g1 = g0 + 64;
  const float m0 = wave_max(fabsf(g0[lane])), m1 = wave_max(fabsf(g1[lane]));
  const float LOG2E = 1.4426950408889634f;
  const float sc2 = 0.125f * LOG2E;
  const float cc2 = 8.f * m0 * m1 * LOG2E;
  f32x16 o0, o1;
#pragma unroll
  for (int i = 0; i < 16; ++i) { o0[i] = 0.f; o1[i] = 0.f; }
  float lsum = 0.f;
  const int nkt = ((qt * 16 + 15) >> 6) + 1;
  const int srow0 = tid >> 3, scol0 = (tid & 7) * 8;
  const int irow = tid >> 2, icol = (tid & 3) * 8;
  u32x4 rk0[2], rv0[2], ri0, rk1[2], rv1[2], ri1;
#define D_LOAD(RK, RV, RI, KT)                                                                              \
  {                                                                                                         \
    const int kk_ = ((KT) < nkt ? (KT) : nkt - 1) * 64;                                                     \
    _Pragma("unroll") for (int i = 0; i < 2; ++i) {                                                         \
      RK[i] = *(const u32x4*)(KD + (size_t)(kk_ + srow0 + 32 * i) * 64 + scol0);                            \
      RV[i] = *(const u32x4*)(VTD + (size_t)(srow0 + 32 * i) * SEQ + kk_ + scol0);                          \
    }                                                                                                       \
    RI = *(const u32x4*)(KI + (size_t)(kk_ + irow) * 32 + icol);                                            \
  }
#define D_STORE(RK, RV, RI, BUF)                                                                            \
  {                                                                                                         \
    _Pragma("unroll") for (int i = 0; i < 2; ++i) {                                                         \
      *(u32x4*)(Kt + (BUF) * 64 * KLD + (srow0 + 32 * i) * KLD + scol0) = RK[i];                            \
      *(u32x4*)(Vt + (BUF) * 64 * VLD + (srow0 + 32 * i) * VLD + scol0) = RV[i];                            \
    }                                                                                                       \
    *(u32x4*)(It + (BUF) * 64 * ILD + irow * ILD + icol) = RI;                                              \
  }
#define D_COMPUTE(BUF, KT)                                                                                  \
  {                                                                                                         \
    const int k0 = (KT) * 64;                                                                               \
    const bf16_t* kc = Kt + (BUF) * 64 * KLD;                                                               \
    const bf16_t* vc = Vt + (BUF) * 64 * VLD;                                                               \
    const bf16_t* ic = It + (BUF) * 64 * ILD;                                                               \
    _Pragma("unroll") for (int sub = 0; sub < 2; ++sub) {                                                   \
      if ((KT) * 2 + sub <= ktmax) {                                                                        \
        const int ks0 = k0 + sub * 32;                                                                      \
        f32x16 a;                                                                                           \
        _Pragma("unroll") for (int i = 0; i < 16; ++i) a[i] = 0.f;                                          \
        _Pragma("unroll") for (int s2 = 0; s2 < 2; ++s2) {                                                  \
          bf16x8 kb = *(const bf16x8*)(ic + (sub * 32 + r) * ILD + 16 * s2 + 8 * h);                        \
          a = MFMA32(aqi[s2], kb, a);                                                                       \
        }                                                                                                   \
        const int key = ks0 + r;                                                                            \
        const uint32_t u0 = sortable(idx_score(a, wv, 0)), u1 = sortable(idx_score(a, wv, 1));              \
        const bool sel0 = (key <= myq0) && (u0 > thr[0] || (u0 == thr[0] && key <= cut[0]));                \
        const bool sel1 = (key <= myq0 + 1) && (u1 > thr[1] || (u1 == thr[1] && key <= cut[1]));            \
        const unsigned long long bl0 = __ballot(sel0), bl1 = __ballot(sel1);                                \
        const unsigned long long blq = (cq & 1) ? bl1 : bl0;                                                \
        const uint32_t mymask = (uint32_t)(blq >> (32 * (cq >> 1)));                                        \
        f32x16 sacc;                                                                                        \
        _Pragma("unroll") for (int i = 0; i < 16; ++i) sacc[i] = 0.f;                                       \
        _Pragma("unroll") for (int s4 = 0; s4 < 4; ++s4) {                                                  \
          bf16x8 ka = *(const bf16x8*)(kc + (sub * 32 + r) * KLD + 16 * s4 + 8 * h);                        \
          sacc = MFMA32(ka, bq[s4], sacc);                                                                  \
        }                                                                                                   \
        float pv[16];                                                                                       \
        _Pragma("unroll") for (int i = 0; i < 16; ++i) {                                                    \
          float e = __builtin_amdgcn_exp2f(sacc[i] * sc2 - cc2);                                            \
          e = ((mymask >> crow(i, h)) & 1u) ? e : 0.f;                                                      \
          pv[i] = e; lsum += e;                                                                             \
        }                                                                                                   \
        _Pragma("unroll") for (int s2 = 0; s2 < 2; ++s2) {                                                  \
          u32x4 pfu;                                                                                        \
          pfu.x = pack2_mfma(pv[8 * s2 + 0], pv[8 * s2 + 1]); pfu.y = pack2_mfma(pv[8 * s2 + 2], pv[8 * s2 + 3]); \
          pfu.z = pack2_mfma(pv[8 * s2 + 4], pv[8 * s2 + 5]); pfu.w = pack2_mfma(pv[8 * s2 + 6], pv[8 * s2 + 7]); \
          bf16x8 pf = __builtin_bit_cast(bf16x8, pfu);                                                      \
          const bf16_t* vp = vc + r * VLD + sub * 32 + 16 * s2 + 4 * h;                                     \
          bf16x4 l0 = *(const bf16x4*)vp, h0 = *(const bf16x4*)(vp + 8);                                    \
          bf16x4 l1 = *(const bf16x4*)(vp + 32 * VLD), h1 = *(const bf16x4*)(vp + 32 * VLD + 8);            \
          bf16x8 va0 = __builtin_shufflevector(l0, h0, 0, 1, 2, 3, 4, 5, 6, 7);                             \
          bf16x8 va1 = __builtin_shufflevector(l1, h1, 0, 1, 2, 3, 4, 5, 6, 7);                             \
          o0 = MFMA32(va0, pf, o0); o1 = MFMA32(va1, pf, o1);                                               \
        }                                                                                                   \
      }                                                                                                     \
    }                                                                                                       \
  }
  D_LOAD(rk0, rv0, ri0, 0);
  D_LOAD(rk1, rv1, ri1, 1);
  __syncthreads();
  D_STORE(rk0, rv0, ri0, 0);
  __syncthreads();
  for (int kt = 0; kt < nkt; kt += 2) {
    D_LOAD(rk0, rv0, ri0, kt + 2);
    __builtin_amdgcn_sched_barrier(0);
    D_COMPUTE(0, kt);
    __builtin_amdgcn_sched_barrier(0);
    D_STORE(rk1, rv1, ri1, 1);
    __syncthreads();
    D_LOAD(rk1, rv1, ri1, kt + 3);
    __builtin_amdgcn_sched_barrier(0);
    if (kt + 1 < nkt) D_COMPUTE(1, kt + 1);
    __builtin_amdgcn_sched_barrier(0);
    D_STORE(rk0, rv0, ri0, 0);
    __syncthreads();
  }
#undef D_LOAD
#undef D_STORE
#undef D_COMPUTE
  const float lt = lsum + xshfl_xor(lsum, 32);
  const float inv = 1.f / lt;
  bf16_t* yc = (bf16_t*)(WS + OFF_YC) + (size_t)(b * SEQ + tq0 + cq) * 512 + chd * 64;
#pragma unroll
  for (int g4 = 0; g4 < 4; ++g4) {
    u32x2 a2, c2;
    a2.x = pack2(o0[4 * g4] * inv, o0[4 * g4 + 1] * inv); a2.y = pack2(o0[4 * g4 + 2] * inv, o0[4 * g4 + 3] * inv);
    c2.x = pack2(o1[4 * g4] * inv, o1[4 * g4 + 1] * inv); c2.y = pack2(o1[4 * g4 + 2] * inv, o1[4 * g4 + 3] * inv);
    *(u32x2*)(yc + 8 * g4 + 4 * h) = a2;
    *(u32x2*)(yc + 32 + 8 * g4 + 4 * h) = c2;
  }
}

DI void phase_mix1(const Params& p, char* WS, int l, char* smem, int rep) {
  constexpr int N_S5 = 512, N_Q = 1536, N_KV = 2048, N_VT = 512, N_QK = (T * 9 + 255) / 256, N_IDX = N_QK, N_CONV = T * 64 / 256;
  constexpr int E0 = N_S5, E1 = E0 + N_Q, E2 = E1 + N_KV, E3 = E2 + N_VT, E4 = E3 + N_QK, E5 = E4 + N_IDX, E6 = E5 + N_CONV;
  for (int it = get_bid(); it < E6; it += get_nb()) {
    if (it < E0) s5_item<false>(p, WS, l, it, smem);
    else if (it < E1) mla_up_tile(p, WS, it - E0, false, smem);
    else if (it < E2) mla_up_tile(p, WS, it - E1, true, smem);
    else if (it < E3) dsa_prep_vt(p, WS, it - E2, smem);
    else if (it < E4) { if (rep == 0) dsa_prep_qk(p, WS, l, it - E3); }
    else if (it < E5) { if (rep == 0) dsa_prep_idx(p, WS, it - E4); }
    else rg_conv(p, WS, l, it - E5);
  }
}
DI void phase_mix2(const Params& p, char* WS, int l, char* smem, int rep) {
  constexpr int N_DSA = 2048, N_S5 = 512, N_RG = 2048, N_EL = T * 16 / 256;
  constexpr int E0 = N_DSA, E1 = E0 + N_S5, E2 = E1 + N_RG, E3 = E2 + N_EL;
  for (int it = get_bid(); it < E3; it += get_nb()) {
    if (it < E0) dsa_item(p, WS, l, it, smem);
    else if (it < E1) s5_item<true>(p, WS, l, it - E0, smem);
    else if (it < E2) rg_gate_tile(p, WS, l, it - E1, smem);
    else if (rep == 0) mla_elem(p, WS, l, it - E2);
  }
}
DI void phase_mix3(const Params& p, char* WS, int l, char* smem) {
  constexpr int N_RG = 128, N_ATT = 2048, N_GLU = 1024;
  constexpr int E0 = N_RG, E1 = E0 + N_ATT, E2 = E1 + N_GLU;
  for (int it = get_bid(); it < E2; it += get_nb()) {
    if (it < E0) rg_scan_item(p, WS, it, smem);
    else if (it < E1) mla_attn_item(p, WS, l, it - E0, smem);
    else glu_tile(p, WS, l, it - E1, smem);
  }
}

constexpr int NPHASE = 1 + NL * 13;

DI void run_phase(const Params& p, char* WS, int ph, char* smem_blk, int rep) {
  const int l = (ph - 1) / 13, s = (ph - 1) % 13;
  char* smem = smem_blk + get_team() * SMEM_BYTES;
#define MODP ((const float*)(WS + OFF_MOD) + (size_t)l * 16 * 9216)
  switch (s) {
    case 0: phase_convert(p, WS, l, smem); phase_norm(p, WS, l, 0); break;
    case 1: phase_ffn_up(p, WS, 0, smem_blk); break;
    case 2: phase_gemm_resid(p, WS, (const bf16_t*)(WS + OFF_HZ), (const bf16_t*)(WS + OFF_WDN), DFF, MODP + 2 * 1024, 0.5f, smem_blk); break;
    case 3: phase_norm(p, WS, l, 1); break;
    case 4: phase_inproj(p, WS, smem_blk); break;
    case 5: phase_mix1(p, WS, l, smem, rep); break;
    case 6: phase_mix2(p, WS, l, smem, rep); break;
    case 7: phase_mix3(p, WS, l, smem); break;
    case 8: phase_merge(p, WS, smem); break;
    case 9: phase_gemm_resid(p, WS, (const bf16_t*)(WS + OFF_MERGED), (const bf16_t*)(WS + OFF_WOUT), 1024, MODP + 5 * 1024, 1.0f, smem_blk); break;
    case 10: phase_norm(p, WS, l, 2); break;
    case 11: phase_ffn_up(p, WS, 1, smem_blk); break;
    case 12: phase_gemm_resid(p, WS, (const bf16_t*)(WS + OFF_HZ), (const bf16_t*)(WS + OFF_WDN) + (size_t)1024 * DFF, DFF, MODP + 8 * 1024, 0.5f, smem_blk); break;
  }
}

__global__ void __launch_bounds__(NTHREADS_BLK) mega_kernel(Params p, int ph_lo, int ph_hi, int probe) {
  __shared__ __attribute__((aligned(16))) char smem[SMEM_BLK];
  if (ph_lo == 0) {
    phase_init(p, p.ws, smem + get_team() * SMEM_BYTES);
    if (blockIdx.x == 0 && threadIdx.x == 0) {
      Params* tb = (Params*)(p.ws + OFF_TBL);
      tb->x = p.x;
      tb->c = p.c;
      tb->pos = p.pos;
      tb->ada_w = p.ada_w;
      tb->ada_b = p.ada_b;
      tb->norm_g = p.norm_g;
      tb->ffn_w1 = p.ffn_w1;
      tb->ffn_w3 = p.ffn_w3;
      tb->ffn_w2 = p.ffn_w2;
      tb->w_in = p.w_in;
      tb->conv_w = p.conv_w;
      tb->conv_b = p.conv_b;
      tb->rg_wa = p.rg_wa;
      tb->rg_ba = p.rg_ba;
      tb->rg_wx = p.rg_wx;
      tb->rg_bx = p.rg_bx;
      tb->rg_lambda = p.rg_lambda;
      tb->mla_q_norm = p.mla_q_norm;
      tb->mla_w_uq = p.mla_w_uq;
      tb->mla_kv_norm = p.mla_kv_norm;
      tb->mla_w_ukv = p.mla_w_ukv;
      tb->mla_qk_gain = p.mla_qk_gain;
      tb->dsa_qk_gain = p.dsa_qk_gain;
      tb->s5_lre = p.s5_lre;
      tb->s5_lim = p.s5_lim;
      tb->s5_logdt = p.s5_logdt;
      tb->s5_bre = p.s5_bre;
      tb->s5_bim = p.s5_bim;
      tb->s5_cre = p.s5_cre;
      tb->s5_cim = p.s5_cim;
      tb->s5_d = p.s5_d;
      tb->s5_wglu = p.s5_wglu;
      tb->s5_bglu = p.s5_bglu;
      tb->w_branch = p.w_branch;
      tb->w_out = p.w_out;
      tb->xo = p.xo;
      tb->ws = p.ws;
    }
    ph_lo = 1;
    if (ph_lo < ph_hi) cg::this_grid().sync();
  }
  for (int ph = ph_lo; ph < ph_hi; ++ph) {
    char* ws = p.ws;
    asm volatile("" : "+s"(ws));
    const Params& q = *(const Params*)(ws + OFF_TBL);
    const int nrep = (((ph - 1) % 13) == (probe & 255)) ? (probe >> 8) : 1;
    for (int rep = 0; rep < nrep; ++rep) {
      run_phase(q, ws, ph, smem, rep);
      if (rep + 1 < nrep) cg::this_grid().sync();
    }
    if (ph + 1 < ph_hi) cg::this_grid().sync();
  }
}

extern "C" void kernel_launch(void* const* d_in, const int* in_sizes, int n_in, void* d_out, int out_size, void* d_ws,
                              size_t ws_size, hipStream_t stream) {
  Params p{};
  p.x = (const float*)d_in[0]; p.c = (const float*)d_in[1]; p.pos = (const int*)d_in[2];
  p.ada_w = (const float*)d_in[3]; p.ada_b = (const float*)d_in[4]; p.norm_g = (const float*)d_in[5];
  p.ffn_w1 = (const float*)d_in[6]; p.ffn_w3 = (const float*)d_in[7]; p.ffn_w2 = (const float*)d_in[8];
  p.w_in = (const float*)d_in[9]; p.conv_w = (const float*)d_in[10]; p.conv_b = (const float*)d_in[11];
  p.rg_wa = (const float*)d_in[12]; p.rg_ba = (const float*)d_in[13]; p.rg_wx = (const float*)d_in[14];
  p.rg_bx = (const float*)d_in[15]; p.rg_lambda = (const float*)d_in[16]; p.mla_q_norm = (const float*)d_in[17];
  p.mla_w_uq = (const float*)d_in[18]; p.mla_kv_norm = (const float*)d_in[19]; p.mla_w_ukv = (const float*)d_in[20];
  p.mla_qk_gain = (const float*)d_in[21]; p.dsa_qk_gain = (const float*)d_in[22]; p.s5_lre = (const float*)d_in[23];
  p.s5_lim = (const float*)d_in[24]; p.s5_logdt = (const float*)d_in[25]; p.s5_bre = (const float*)d_in[26];
  p.s5_bim = (const float*)d_in[27]; p.s5_cre = (const float*)d_in[28]; p.s5_cim = (const float*)d_in[29];
  p.s5_d = (const float*)d_in[30]; p.s5_wglu = (const float*)d_in[31]; p.s5_bglu = (const float*)d_in[32];
  p.w_branch = (const float*)d_in[33]; p.w_out = (const float*)d_in[34];
  p.xo = (float*)d_out; p.ws = (char*)d_ws;
  if (ws_size < WS_NEED) fprintf(stderr, "workspace too small: %zu < %zu\n", ws_size, (size_t)WS_NEED);
  static int grid_blocks = 0;
  if (!grid_blocks) {
    int dev = 0, cus = 0, per_cu = 0;
    hipGetDevice(&dev);
    hipDeviceGetAttribute(&cus, hipDeviceAttributeMultiprocessorCount, dev);
    hipOccupancyMaxActiveBlocksPerMultiprocessor(&per_cu, mega_kernel, NTHREADS_BLK, 0);
    if (per_cu > 1) per_cu = 1;
    if (per_cu < 1) per_cu = 1;
    grid_blocks = cus * per_cu;
  }
#if MEGA
  int lo = 0, hi = NPHASE, probe = PROBE_CFG;
  void* args[] = {&p, &lo, &hi, &probe};
  hipError_t e = hipLaunchCooperativeKernel((void*)mega_kernel, dim3(grid_blocks), dim3(NTHREADS_BLK), args, 0, stream);
  if (e != hipSuccess) fprintf(stderr, "cooperative launch failed: %s (grid %d)\n", hipGetErrorString(e), grid_blocks);
#else
  for (int ph = 0; ph < NPHASE; ++ph) mega_kernel<<<grid_blocks, NTHREADS_BLK, 0, stream>>>(p, ph, ph + 1, PROBE_CFG);
#endif
}
```

```cpp
#include <hip/hip_runtime.h>
#include <hip/hip_cooperative_groups.h>
#include <stdint.h>
#include <stdio.h>
namespace cg = cooperative_groups;

#ifndef MEGA
#define MEGA 1
#endif
#ifndef PROBE_CFG
#define PROBE_CFG (255 | (1 << 8))
#endif

typedef unsigned short bf16_t;
using bf16x8 = __attribute__((ext_vector_type(8))) short;
using bf16x4 = __attribute__((ext_vector_type(4))) short;
using f32x16 = __attribute__((ext_vector_type(16))) float;
using u32x4 = __attribute__((ext_vector_type(4))) uint32_t;
using u32x2 = __attribute__((ext_vector_type(2))) uint32_t;

#define DI __device__ __forceinline__
#define MFMA32(a, b, c) __builtin_amdgcn_mfma_f32_32x32x16_bf16((a), (b), (c), 0, 0, 0)

constexpr int T = 32768, SEQ = 2048, NB = 16, D = 1024, DFF = 2816, ZW = 2944, DIN = 6984, NL = 4;
constexpr int NTHREADS = 256;
constexpr int NTHREADS_BLK = 512;
constexpr int Z_XRNN = 0, Z_GATE = 512, Z_QLAT = 1024, Z_KVLAT = 1280, Z_KPE = 1408, Z_QDSA = 1440, Z_KDSA = 1952,
              Z_VDSA = 2016, Z_QIDX = 2080, Z_KIDX = 2336, Z_WIDX = 2368, Z_US5 = 2376, Z_GATES = 2888;

constexpr size_t AL(size_t x) { return (x + 255) & ~(size_t)255; }
constexpr size_t OFF_WUP = 0;
constexpr size_t OFF_WDN = OFF_WUP + AL((size_t)2 * 5632 * 1024 * 2);
constexpr size_t OFF_WIN = OFF_WDN + AL((size_t)2 * 1024 * 2816 * 2);
constexpr size_t OFF_WBR = OFF_WIN + AL((size_t)7040 * 1024 * 2);
constexpr size_t OFF_WOUT = OFF_WBR + AL((size_t)4 * 1024 * 512 * 2);
constexpr size_t OFF_WUQ = OFF_WOUT + AL((size_t)1024 * 1024 * 2);
constexpr size_t OFF_WUKV = OFF_WUQ + AL((size_t)768 * 256 * 2);
constexpr size_t OFF_WRG = OFF_WUKV + AL((size_t)1024 * 128 * 2);
constexpr size_t OFF_WGLU = OFF_WRG + AL((size_t)8 * 128 * 64 * 2);
constexpr size_t OFF_S5AB = OFF_WGLU + AL((size_t)512 * 512 * 2);
constexpr size_t OFF_S5BB = OFF_S5AB + AL((size_t)32 * 64 * 4 * 4);
constexpr size_t OFF_S5CT = OFF_S5BB + AL((size_t)32 * 128 * 16 * 2);
constexpr size_t OFF_MOD = OFF_S5CT + AL((size_t)32 * 16 * 128 * 2);
constexpr size_t OFF_ROPE = OFF_MOD + AL((size_t)4 * 16 * 9216 * 4);
constexpr size_t OFF_U = OFF_ROPE + AL((size_t)T * 56 * 4);
constexpr size_t OFF_HZ = OFF_U + AL((size_t)T * 1024 * 2);
constexpr size_t OFF_XC = OFF_HZ + AL((size_t)T * ZW * 2);
constexpr size_t OFF_Q = OFF_XC + AL((size_t)T * 512 * 2);
constexpr size_t OFF_KNOPE = OFF_Q + AL((size_t)T * 768 * 2);
constexpr size_t OFF_VT = OFF_KNOPE + AL((size_t)T * 512 * 2);
constexpr size_t OFF_K = OFF_VT + AL((size_t)T * 512 * 2);
constexpr size_t OFF_KD = OFF_K + AL((size_t)T * 768 * 2);
constexpr size_t OFF_VTD = OFF_KD + AL((size_t)T * 64 * 2);
constexpr size_t OFF_KI = OFF_VTD + AL((size_t)T * 64 * 2);
constexpr size_t OFF_ENDS = OFF_KI + AL((size_t)T * 32 * 2);
constexpr size_t OFF_YS5 = OFF_ENDS + AL((size_t)16 * 32 * 32 * 128 * 4);
constexpr size_t OFF_LOGA = OFF_YS5 + AL((size_t)T * 512 * 2);
constexpr size_t OFF_INP = OFF_LOGA + AL((size_t)T * 512 * 2);
constexpr size_t OFF_YC = OFF_INP + AL((size_t)T * 512 * 2);
constexpr size_t OFF_YD = OFF_YC + AL((size_t)T * 512 * 2);
constexpr size_t OFF_TBL = OFF_YD + AL((size_t)T * 512 * 2);
constexpr size_t WS_NEED = OFF_TBL + 1024;
constexpr size_t OFF_YA = OFF_XC, OFF_YB = OFF_KNOPE, OFF_MERGED = OFF_HZ;

struct Params {
  const float* x; const float* c; const int* pos;
  const float *ada_w, *ada_b, *norm_g, *ffn_w1, *ffn_w3, *ffn_w2, *w_in, *conv_w, *conv_b, *rg_wa, *rg_ba, *rg_wx, *rg_bx,
      *rg_lambda, *mla_q_norm, *mla_w_uq, *mla_kv_norm, *mla_w_ukv, *mla_qk_gain, *dsa_qk_gain, *s5_lre, *s5_lim, *s5_logdt,
      *s5_bre, *s5_bim, *s5_cre, *s5_cim, *s5_d, *s5_wglu, *s5_bglu, *w_branch, *w_out;
  float* xo;
  char* ws;
};

DI int get_tid512() { int t = threadIdx.x; asm volatile("" : "+v"(t)); return t; }
DI int get_tid() { int t = threadIdx.x & 255; asm volatile("" : "+v"(t)); return t; }
DI int get_team() { int t = __builtin_amdgcn_readfirstlane(threadIdx.x >> 8); asm volatile("" : "+s"(t)); return t; }
DI int get_bid() { int b = blockIdx.x * 2 + __builtin_amdgcn_readfirstlane(threadIdx.x >> 8); asm volatile("" : "+s"(b)); return b; }
DI int get_nb() { int b = gridDim.x * 2; asm volatile("" : "+s"(b)); return b; }
DI int get_bid_real() { int b = blockIdx.x; asm volatile("" : "+s"(b)); return b; }
DI int get_nb_real() { int b = gridDim.x; asm volatile("" : "+s"(b)); return b; }
DI float xshfl_xor(float v, int m) { int l = (get_tid() & 63) ^ m; return __int_as_float(__builtin_amdgcn_ds_bpermute(l << 2, __float_as_int(v))); }
DI int xshfl_xor_i(int v, int m) { int l = (get_tid() & 63) ^ m; return __builtin_amdgcn_ds_bpermute(l << 2, v); }
DI float xshfl(float v, int src) { return __int_as_float(__builtin_amdgcn_ds_bpermute(src << 2, __float_as_int(v))); }
DI float bf2f(bf16_t v) { return __uint_as_float(((uint32_t)v) << 16); }
DI uint32_t pack2(float a, float b) { uint32_t r; asm("v_cvt_pk_bf16_f32 %0, %1, %2" : "=v"(r) : "v"(a), "v"(b)); return r; }
DI uint32_t pack2_mfma(float a, float b) { uint32_t r; asm volatile("v_cvt_pk_bf16_f32 %0, %1, %2\n\ts_nop 1" : "=v"(r) : "v"(a), "v"(b)); return r; }
DI bf16_t f2bf(float f) { return (bf16_t)(pack2(f, f) & 0xffffu); }
DI int crow(int i, int h) { return (i & 3) + 8 * (i >> 2) + 4 * h; }
DI float wave_sum(float v) {
#pragma unroll
  for (int o = 32; o > 0; o >>= 1) v += xshfl_xor(v, o);
  return v;
}
DI float wave_max(float v) {
#pragma unroll
  for (int o = 32; o > 0; o >>= 1) v = fmaxf(v, xshfl_xor(v, o));
  return v;
}
DI float sigmoidf_(float x) { return __builtin_amdgcn_rcpf(1.f + __expf(-x)); }
DI float gelu_tanh(float x) {
  float u = 0.7978845608028654f * (x + 0.044715f * x * x * x);
  float t = 1.f - 2.f * __builtin_amdgcn_rcpf(1.f + __expf(2.f * u));
  return 0.5f * x * (1.f + t);
}
DI void unpack8(u32x4 v, float* f) {
  f[0] = __uint_as_float(v.x << 16); f[1] = __uint_as_float(v.x & 0xffff0000u);
  f[2] = __uint_as_float(v.y << 16); f[3] = __uint_as_float(v.y & 0xffff0000u);
  f[4] = __uint_as_float(v.z << 16); f[5] = __uint_as_float(v.z & 0xffff0000u);
  f[6] = __uint_as_float(v.w << 16); f[7] = __uint_as_float(v.w & 0xffff0000u);
}
DI u32x4 pack8(const float* f) {
  u32x4 v; v.x = pack2(f[0], f[1]); v.y = pack2(f[2], f[3]); v.z = pack2(f[4], f[5]); v.w = pack2(f[6], f[7]); return v;
}
DI void sincos_rev(float ang, float* s, float* c) {
  double rev = (double)ang * 0.15915494309189535; rev -= rint(rev);
  float rv = (float)rev;
  *s = __builtin_amdgcn_sinf(rv); *c = __builtin_amdgcn_cosf(rv);
}

constexpr int LDT = 72;
constexpr int TILE_ELEMS = 128 * LDT;
constexpr int SMEM_BYTES = 4 * TILE_ELEMS * 2 + 1024;
constexpr int SMEM_BLK = 2 * SMEM_BYTES;

template <int NI>
struct Stage { u32x4 a[4]; u32x4 b[2 * NI]; };

template <bool SUMSQ, int UNR = 4, int NI = 2>
DI void gemm_main(const bf16_t* __restrict__ A, int lda, int ksa, const bf16_t* __restrict__ Bt, int ldb, int ksb, int K, bf16_t* sm,
                  f32x16 (&acc)[2][NI], float* rowstat) {
  const int tid = get_tid(), lane = tid & 63, wave = tid >> 6;
  const int wm = wave >> 1, wn = wave & 1, r = lane & 31, h = lane >> 5;
  const int lrow = tid >> 3, lkc = (tid & 7) * 8;
  const bf16_t* ga = A + (size_t)lrow * lda + lkc;
  const bf16_t* gb = Bt + (size_t)lrow * ldb + lkc;
  bf16_t* sA = sm;
  bf16_t* sB = sm + 2 * TILE_ELEMS;
  const int nk = K >> 6;
  float ss[4] = {0.f, 0.f, 0.f, 0.f};
  u32x4 r0a[4], r0b[2 * NI], r1a[4], r1b[2 * NI];
#define G_LOAD(RA, RB, KT)                                                                          \
  {                                                                                                 \
    const size_t ka_ = (size_t)(KT) * ksa, kb_ = (size_t)(KT) * ksb;                                \
    _Pragma("unroll") for (int i = 0; i < 4; ++i) RA[i] = *(const u32x4*)(ga + (size_t)(32 * i) * lda + ka_);      \
    _Pragma("unroll") for (int i = 0; i < 2 * NI; ++i) RB[i] = *(const u32x4*)(gb + (size_t)(32 * i) * ldb + kb_); \
  }
#define G_STORE(RA, RB, BUF)                                                                        \
  {                                                                                                 \
    bf16_t* nA_ = sA + (BUF) * TILE_ELEMS; bf16_t* nB_ = sB + (BUF) * TILE_ELEMS;                   \
    _Pragma("unroll") for (int i = 0; i < 4; ++i) {                                                 \
      *(u32x4*)(nA_ + (lrow + 32 * i) * LDT + lkc) = RA[i];                                         \
      if (SUMSQ) { float f_[8]; unpack8(RA[i], f_);                                                 \
        _Pragma("unroll") for (int e = 0; e < 8; ++e) ss[i] += f_[e] * f_[e]; }                     \
    }                                                                                               \
    _Pragma("unroll") for (int i = 0; i < 2 * NI; ++i) *(u32x4*)(nB_ + (lrow + 32 * i) * LDT + lkc) = RB[i]; \
  }
#define G_COMPUTE(BUF)                                                                              \
  {                                                                                                 \
    const bf16_t* cA = sA + (BUF) * TILE_ELEMS + (wm * 64 + r) * LDT + h * 8;                       \
    const bf16_t* cB = sB + (BUF) * TILE_ELEMS + (wn * 32 * NI + r) * LDT + h * 8;                  \
    _Pragma("unroll") for (int ks = 0; ks < 4; ++ks) {                                              \
      bf16x8 a0 = *(const bf16x8*)(cA + ks * 16);                                                   \
      bf16x8 a1 = *(const bf16x8*)(cA + 32 * LDT + ks * 16);                                        \
      _Pragma("unroll") for (int ni = 0; ni < NI; ++ni) {                                           \
        bf16x8 b0 = *(const bf16x8*)(cB + ni * 32 * LDT + ks * 16);                                 \
        acc[0][ni] = MFMA32(a0, b0, acc[0][ni]);                                                    \
        acc[1][ni] = MFMA32(a1, b0, acc[1][ni]);                                                    \
      }                                                                                             \
    }                                                                                               \
  }
  G_LOAD(r0a, r0b, 0);
  G_LOAD(r1a, r1b, (nk > 1 ? 1 : 0));
  __syncthreads();
  G_STORE(r0a, r0b, 0);
  __syncthreads();
  for (int kt = 0; kt < nk; kt += 2) {
    G_LOAD(r0a, r0b, (kt + 2 < nk ? kt + 2 : nk - 1));
    __builtin_amdgcn_sched_barrier(0);
    G_COMPUTE(0);
    __builtin_amdgcn_sched_barrier(0);
    if (kt + 1 < nk) G_STORE(r1a, r1b, 1);
    __syncthreads();
    if (kt + 1 < nk) {
      G_LOAD(r1a, r1b, (kt + 3 < nk ? kt + 3 : nk - 1));
      __builtin_amdgcn_sched_barrier(0);
      G_COMPUTE(1);
      __builtin_amdgcn_sched_barrier(0);
      if (kt + 2 < nk) G_STORE(r0a, r0b, 0);
      __syncthreads();
    }
  }
#undef G_LOAD
#undef G_STORE
#undef G_COMPUTE
  if (SUMSQ) {
#pragma unroll
    for (int i = 0; i < 4; ++i) {
      float v = ss[i];
      v += xshfl_xor(v, 1); v += xshfl_xor(v, 2); v += xshfl_xor(v, 4);
      if ((tid & 7) == 0) rowstat[lrow + 32 * i] = rsqrtf(v / (float)K + 1e-6f);
    }
    __syncthreads();
  }
}

DI size_t tiled_off(int row, int col, int nk) {
  return ((size_t)((row >> 7) * nk + (col >> 6)) << 13) + ((row & 127) << 6) + (col & 63);
}
DI void zero_acc(f32x16 (&acc)[2][2]) {
#pragma unroll
  for (int a = 0; a < 2; ++a)
#pragma unroll
    for (int b = 0; b < 2; ++b)
#pragma unroll
      for (int i = 0; i < 16; ++i) acc[a][b][i] = 0.f;
}
DI void gemm256_main(const bf16_t* __restrict__ A, const bf16_t* __restrict__ Bt, int K, bf16_t* sm, f32x16 (&acc)[4][2]) {
  const int tid = get_tid512(), lane = tid & 63, wave = tid >> 6;
  const int wm = wave >> 2, wn = wave & 3, r = lane & 31, h = lane >> 5;
  const int lrow = tid >> 3, lkc = (tid & 7) * 8;
  const int nk = K >> 6;
  const bf16_t* ga = A + (size_t)lrow * 64 + lkc;
  const bf16_t* gb = Bt + (size_t)lrow * 64 + lkc;
  const size_t rts = (size_t)nk << 13;
  constexpr int TE = 256 * LDT;
  bf16_t* sA = sm;
  bf16_t* sB = sm + 2 * TE;
  u32x4 r0a[4], r0b[4], r1a[4], r1b[4];
#define H_LOAD(RA, RB, KT)                                                                                   \
  {                                                                                                          \
    const size_t ko_ = (size_t)(KT) << 13;                                                                   \
    _Pragma("unroll") for (int i = 0; i < 4; ++i) {                                                          \
      RA[i] = *(const u32x4*)(ga + (i >> 1) * rts + (i & 1) * 4096 + ko_);                                   \
      RB[i] = *(const u32x4*)(gb + (i >> 1) * rts + (i & 1) * 4096 + ko_);                                   \
    }                                                                                                        \
  }
#define H_STORE(RA, RB, BUF)                                                                                 \
  {                                                                                                          \
    _Pragma("unroll") for (int i = 0; i < 4; ++i) {                                                          \
      *(u32x4*)(sA + (BUF) * TE + (lrow + 64 * i) * LDT + lkc) = RA[i];                                      \
      *(u32x4*)(sB + (BUF) * TE + (lrow + 64 * i) * LDT + lkc) = RB[i];                                      \
    }                                                                                                        \
  }
#define H_COMPUTE(BUF, KS0, KS1)                                                                             \
  {                                                                                                          \
    const bf16_t* cA = sA + (BUF) * TE + (wm * 128 + r) * LDT + h * 8;                                       \
    const bf16_t* cB = sB + (BUF) * TE + (wn * 64 + r) * LDT + h * 8;                                        \
    _Pragma("unroll") for (int ks = KS0; ks < KS1; ++ks) {                                                   \
      bf16x8 b0 = *(const bf16x8*)(cB + ks * 16);                                                            \
      bf16x8 b1 = *(const bf16x8*)(cB + 32 * LDT + ks * 16);                                                 \
      _Pragma("unroll") for (int mi = 0; mi < 4; ++mi) {                                                     \
        bf16x8 a0 = *(const bf16x8*)(cA + mi * 32 * LDT + ks * 16);                                          \
        acc[mi][0] = MFMA32(a0, b0, acc[mi][0]);                                                             \
        acc[mi][1] = MFMA32(a0, b1, acc[mi][1]);                                                             \
      }                                                                                                      \
    }                                                                                                        \
  }
  H_LOAD(r0a, r0b, 0);
  H_LOAD(r1a, r1b, (nk > 1 ? 1 : 0));
  __syncthreads();
  H_STORE(r0a, r0b, 0);
  __syncthreads();
  for (int kt = 0; kt < nk; kt += 2) {
    H_LOAD(r0a, r0b, (kt + 2 < nk ? kt + 2 : nk - 1));
    __builtin_amdgcn_sched_barrier(0);
    H_COMPUTE(0, 0, 2);
    __builtin_amdgcn_sched_barrier(0);
    if (kt + 1 < nk) H_STORE(r1a, r1b, 1);
    __builtin_amdgcn_sched_barrier(0);
    H_COMPUTE(0, 2, 4);
    __syncthreads();
    if (kt + 1 < nk) {
      H_LOAD(r1a, r1b, (kt + 3 < nk ? kt + 3 : nk - 1));
      __builtin_amdgcn_sched_barrier(0);
      H_COMPUTE(1, 0, 2);
      __builtin_amdgcn_sched_barrier(0);
      if (kt + 2 < nk) H_STORE(r0a, r0b, 0);
      __builtin_amdgcn_sched_barrier(0);
      H_COMPUTE(1, 2, 4);
      __syncthreads();
    }
  }
#undef H_LOAD
#undef H_STORE
#undef H_COMPUTE
}
DI void zero_acc42(f32x16 (&acc)[4][2]) {
#pragma unroll
  for (int a = 0; a < 4; ++a)
#pragma unroll
    for (int b = 0; b < 2; ++b)
#pragma unroll
      for (int i = 0; i < 16; ++i) acc[a][b][i] = 0.f;
}
struct TileIter256 {
  int x, i, step, ntn, total, tmw_l2, ngm_l2, tnw;
  DI TileIter256(int ntn_, int tnw_l2) {
    const int b = get_bid_real(), nb = get_nb_real();
    x = b & 7; i = b >> 3; step = nb >> 3; ntn = ntn_;
    tnw = 1 << tnw_l2; tmw_l2 = 5 - tnw_l2; ngm_l2 = 4 - tmw_l2;
    total = (32 << ngm_l2) * (ntn_ >> tnw_l2);
  }
  DI bool next(int& tm, int& tn) {
    if (i >= total) return false;
    const int sup = i >> 5, within = i & 31;
    tm = x * 16 + ((sup & ((1 << ngm_l2) - 1)) << tmw_l2) + (within & ((1 << tmw_l2) - 1));
    tn = (sup >> ngm_l2) * tnw + (within >> tmw_l2);
    i += step;
    return true;
  }
};

DI void tile_map(int t, int ntn, int& tm, int& tn) {
  int per = 8 * ntn; int g = t / per; int rem = t - g * per;
  tm = g * 8 + (rem & 7); tn = rem >> 3;
}
struct TileIter {
  int x, i, step, ntn, total;
  DI TileIter(int ntn_) {
    const int b = get_bid(), nb = get_nb();
    x = b & 7; i = b >> 3; step = nb >> 3; ntn = ntn_;
    total = 32 * ((ntn_ + 7) & ~7);
  }
  DI bool next(int& tm, int& tn) {
    while (i < total) {
      const int blk = i >> 6, within = i & 63;
      tm = x * 32 + (blk & 3) * 8 + (within & 7);
      tn = (blk >> 2) * 8 + (within >> 3);
      i += step;
      if (tn < ntn) return true;
    }
    return false;
  }
};

DI void phase_init(const Params& p, char* WS, char* smem) {
  const int tid = get_tid(), lane = tid & 63, wave = tid >> 6;
  const size_t gtid = (size_t)get_bid() * NTHREADS + tid, gsz = (size_t)get_nb() * NTHREADS;
  const float4* src = (const float4*)p.x; float4* dst = (float4*)p.xo;
  for (size_t i = gtid; i < (size_t)T * D / 4; i += gsz) dst[i] = src[i];
  float* rope = (float*)(WS + OFF_ROPE);
  for (size_t i = gtid; i < (size_t)T * 28; i += gsz) {
    int t = (int)(i / 28), j = (int)(i % 28);
    float ex; int co, so;
    if (j < 16) { ex = (float)(2 * j) / 32.f; co = j; so = 16 + j; }
    else if (j < 24) { ex = (float)(2 * (j - 16)) / 16.f; co = 32 + j - 16; so = 40 + j - 16; }
    else { ex = (float)(2 * (j - 24)) / 8.f; co = 48 + j - 24; so = 52 + j - 24; }
    float inv = exp2f(-ex * 18.931568569324174f);
    float ang = (float)p.pos[t] * inv;
    float s, c; sincos_rev(ang, &s, &c);
    rope[(size_t)t * 56 + co] = c; rope[(size_t)t * 56 + so] = s;
  }
  float* cact = (float*)smem;
  float* part = (float*)(smem + 16384);
  float* mod = (float*)(WS + OFF_MOD);
  for (int it = get_bid(); it < NL * 144; it += get_nb()) {
    const int l = it / 144, c0 = (it % 144) * 64;
    float acc[16];
#pragma unroll
    for (int b = 0; b < 16; ++b) acc[b] = 0.f;
    for (int kc = 0; kc < 4; ++kc) {
      __syncthreads();
      for (int e = tid; e < 4096; e += NTHREADS) {
        int kk = e >> 4, b = e & 15; float cv = p.c[b * 1024 + kc * 256 + kk];
        cact[e] = cv / (1.f + __expf(-cv));
      }
      __syncthreads();
      const float* wp = p.ada_w + ((size_t)l * 1024 + kc * 256 + wave * 64) * 9216 + c0 + lane;
#pragma unroll 8
      for (int kk = 0; kk < 64; ++kk) {
        float w = wp[(size_t)kk * 9216];
        const float4* cv = (const float4*)(cact + (wave * 64 + kk) * 16);
        float4 c0v = cv[0], c1v = cv[1], c2v = cv[2], c3v = cv[3];
        acc[0] += c0v.x * w; acc[1] += c0v.y * w; acc[2] += c0v.z * w; acc[3] += c0v.w * w;
        acc[4] += c1v.x * w; acc[5] += c1v.y * w; acc[6] += c1v.z * w; acc[7] += c1v.w * w;
        acc[8] += c2v.x * w; acc[9] += c2v.y * w; acc[10] += c2v.z * w; acc[11] += c2v.w * w;
        acc[12] += c3v.x * w; acc[13] += c3v.y * w; acc[14] += c3v.z * w; acc[15] += c3v.w * w;
      }
    }
    __syncthreads();
#pragma unroll
    for (int b = 0; b < 16; ++b) part[(wave * 16 + b) * 64 + lane] = acc[b];
    __syncthreads();
    for (int e = tid; e < 1024; e += NTHREADS) {
      int b = e >> 6, cl = e & 63;
      float s = part[(0 * 16 + b) * 64 + cl] + part[(1 * 16 + b) * 64 + cl] + part[(2 * 16 + b) * 64 + cl] +
                part[(3 * 16 + b) * 64 + cl] + p.ada_b[l * 9216 + c0 + cl];
      mod[((size_t)l * 16 + b) * 9216 + c0 + cl] = s;
    }
  }
}

DI void conv_tile(const float* __restrict__ src, int lds_, int jmax, bf16_t* __restrict__ dst, int ldd,
                          const float* __restrict__ scale, float* tile) {
  const int tid = get_tid();
  __syncthreads();
  {
    const int j = tid & 31, kb = tid >> 5;
#pragma unroll
    for (int i = 0; i < 8; ++i) {
      int kk = kb + 8 * i;
      float v = (j < jmax) ? src[(size_t)kk * lds_ + j] : 0.f;
      if (scale) v *= scale[kk];
      tile[kk * 33 + j] = v;
    }
  }
  __syncthreads();
  {
    const int j = tid >> 3, kq = (tid & 7) * 8;
    float f[8];
#pragma unroll
    for (int e = 0; e < 8; ++e) f[e] = tile[(kq + e) * 33 + j];
    *(u32x4*)(dst + (size_t)j * ldd + kq) = pack8(f);
  }
}

DI void phase_convert(const Params& p, char* WS, int l, char* smem) {
  float* tile = (float*)smem;
  char* ws = WS;
  constexpr int J0 = 2816, J1 = 2816, J2 = 1408, J3 = 1408, J4 = 3520, J5 = 1024, J6 = 512, J7 = 96, J8 = 64, J9 = 32, J10 = 128, J11 = 8;
  constexpr int E0 = J0, E1 = E0 + J1, E2 = E1 + J2, E3 = E2 + J3, E4 = E3 + J4, E5 = E4 + J5, E6 = E5 + J6, E7 = E6 + J7,
                E8 = E7 + J8, E9 = E8 + J9, E10 = E9 + J10, E11 = E10 + J11;
  for (int it = get_bid(); it < E11; it += get_nb()) {
    if (it < E1) {
      int a = it >= E0; int t = it - (a ? E0 : 0);
      int G = t >> 4, kt = t & 15; int grp = G >> 1, which = G & 1;
      const float* w = (which ? p.ffn_w3 : p.ffn_w1) + ((size_t)(l * 2 + a) * 1024 + kt * 64) * DFF + grp * 32;
      bf16_t* d = (bf16_t*)(ws + OFF_WUP) + (size_t)a * 5632 * 1024 + tiled_off(G * 32, kt * 64, 16);
      conv_tile(w, DFF, 32, d, 64, nullptr, tile);
    } else if (it < E3) {
      int a = it >= E2; int t = it - (a ? E2 : E1);
      int G = t / 44, kt = t % 44;
      const float* w = p.ffn_w2 + ((size_t)(l * 2 + a) * DFF + kt * 64) * 1024 + G * 32;
      bf16_t* d = (bf16_t*)(ws + OFF_WDN) + (size_t)a * 1024 * DFF + tiled_off(G * 32, kt * 64, 44);
      conv_tile(w, 1024, 32, d, 64, nullptr, tile);
    } else if (it < E4) {
      int t = it - E3; int G = t >> 4, kt = t & 15;
      const int scol = (G < 92) ? G * 32 : Z_GATES + (G - 92) * 32;
      const float* w = p.w_in + ((size_t)l * 1024 + kt * 64) * DIN + scol;
      bf16_t* d = (G < 92) ? (bf16_t*)(ws + OFF_WIN) + tiled_off(G * 32, kt * 64, 16)
                           : (bf16_t*)(ws + OFF_WIN) + (size_t)2944 * 1024 + tiled_off((G - 92) * 32, kt * 64, 16);
      conv_tile(w, DIN, 32, d, 64, nullptr, tile);
    } else if (it < E5) {
      int t = it - E4; int n = t >> 8; int rem = t & 255; int G = rem >> 3, kt = rem & 7;
      const float* w = p.w_branch + ((size_t)(l * 4 + n) * 512 + kt * 64) * 1024 + G * 32;
      bf16_t* d = (bf16_t*)(ws + OFF_WBR) + (size_t)n * 1024 * 512 + tiled_off(G * 32, kt * 64, 8);
      conv_tile(w, 1024, 32, d, 64, nullptr, tile);
    } else if (it < E6) {
      int t = it - E5; int G = t >> 4, kt = t & 15;
      const float* w = p.w_out + ((size_t)l * 1024 + kt * 64) * 1024 + G * 32;
      bf16_t* d = (bf16_t*)(ws + OFF_WOUT) + tiled_off(G * 32, kt * 64, 16);
      conv_tile(w, 1024, 32, d, 64, nullptr, tile);
    } else if (it < E7) {
      int t = it - E6; int G = t >> 2, kt = t & 3;
      const float* w = p.mla_w_uq + ((size_t)l * 256 + kt * 64) * 768 + G * 32;
      bf16_t* d = (bf16_t*)(ws + OFF_WUQ) + tiled_off(G * 32, kt * 64, 4);
      conv_tile(w, 768, 32, d, 64, p.mla_q_norm + l * 256 + kt * 64, tile);
    } else if (it < E8) {
      int t = it - E7; int G = t >> 1, kt = t & 1;
      const float* w = p.mla_w_ukv + ((size_t)l * 128 + kt * 64) * 1024 + G * 32;
      bf16_t* d = (bf16_t*)(ws + OFF_WUKV) + tiled_off(G * 32, kt * 64, 2);
      conv_tile(w, 1024, 32, d, 64, p.mla_kv_norm + l * 128 + kt * 64, tile);
    } else if (it < E9) {
      int t = it - E8; int hd = t >> 2, G = t & 3; int half = G >> 1, which = G & 1;
      const float* w = (which ? p.rg_wx : p.rg_wa) + ((size_t)(l * 8 + hd) * 64) * 64 + half * 32;
      bf16_t* d = (bf16_t*)(ws + OFF_WRG) + ((size_t)hd * 128 + G * 32) * 64;
      conv_tile(w, 64, 32, d, 64, nullptr, tile);
    } else if (it < E10) {
      int t = it - E9; int G = t >> 3, kt = t & 7;
      const float* w = p.s5_wglu + ((size_t)l * 512 + kt * 64) * 512 + G * 32;
      bf16_t* d = (bf16_t*)(ws + OFF_WGLU) + tiled_off(G * 32, kt * 64, 8);
      conv_tile(w, 512, 32, d, 64, nullptr, tile);
    } else {
      int idx = (it - E10) * 256 + get_tid();
      int g = idx >> 6, pst = idx & 63;
      float lr = p.s5_lre[(l * 32 + g) * 64 + pst], li = p.s5_lim[(l * 32 + g) * 64 + pst];
      float dt = expf(p.s5_logdt[l * 32 + g]);
      float mag = expf(lr * dt);
      float sn, cs; sincos_rev(li * dt, &sn, &cs);
      float abr = mag * cs, abi = mag * sn;
      float den = lr * lr + li * li;
      float nr = abr - 1.f, ni = abi;
      float fr = (nr * lr + ni * li) / den, fi = (ni * lr - nr * li) / den;
      float pr = abr, pi = abi;
#pragma unroll
      for (int q = 0; q < 6; ++q) { float tr = pr * pr - pi * pi, ti = pr * pi; ti = ti + ti; pr = tr; pi = ti; }
      float* ab = (float*)(ws + OFF_S5AB) + (size_t)idx * 4;
      ab[0] = abr; ab[1] = abi; ab[2] = pr; ab[3] = pi;
      const float* br = p.s5_bre + ((size_t)(l * 32 + g) * 64 + pst) * 16;
      const float* bi = p.s5_bim + ((size_t)(l * 32 + g) * 64 + pst) * 16;
      bf16_t* bb = (bf16_t*)(ws + OFF_S5BB) + (size_t)g * 128 * 16;
#pragma unroll
      for (int j = 0; j < 16; ++j) {
        float r_ = br[j], i_ = bi[j];
        bb[(pst) * 16 + j] = f2bf(fr * r_ - fi * i_);
        bb[(64 + pst) * 16 + j] = f2bf(fr * i_ + fi * r_);
      }
      bf16_t* ct = (bf16_t*)(ws + OFF_S5CT) + (size_t)g * 16 * 128;
#pragma unroll
      for (int j = 0; j < 16; ++j) {
        ct[j * 128 + pst] = f2bf(p.s5_cre[((size_t)(l * 32 + g) * 16 + j) * 64 + pst]);
        ct[j * 128 + 64 + pst] = f2bf(-p.s5_cim[((size_t)(l * 32 + g) * 16 + j) * 64 + pst]);
      }
    }
  }
}

DI void phase_norm(const Params& p, char* WS, int l, int which) {
  const int tid = get_tid(), lane = tid & 63, wave = tid >> 6;
  const float* g = p.norm_g + (l * 3 + which) * 1024;
  const float* mod = (const float*)(WS + OFF_MOD) + (size_t)l * 16 * 9216;
  bf16_t* U = (bf16_t*)(WS + OFF_U);
  const float* xo = p.xo;
  for (int row0 = (get_bid() * 4 + wave) * 4; row0 < T; row0 += get_nb() * 16) {
    float4 v[4][4]; float ss[4];
#pragma unroll
    for (int q = 0; q < 4; ++q) {
      const float4* xr = (const float4*)(xo + (size_t)(row0 + q) * 1024);
#pragma unroll
      for (int i = 0; i < 4; ++i) v[q][i] = xr[lane + 64 * i];
    }
#pragma unroll
    for (int q = 0; q < 4; ++q) {
      float a = 0.f;
#pragma unroll
      for (int i = 0; i < 4; ++i) a += v[q][i].x * v[q][i].x + v[q][i].y * v[q][i].y + v[q][i].z * v[q][i].z + v[q][i].w * v[q][i].w;
      ss[q] = a;
    }
#pragma unroll
    for (int o = 32; o > 0; o >>= 1) {
#pragma unroll
      for (int q = 0; q < 4; ++q) ss[q] += xshfl_xor(ss[q], o);
    }
    const int b = row0 >> 11;
    const float* sh = mod + (size_t)b * 9216 + (3 * which) * 1024;
    const float* sc = sh + 1024;
#pragma unroll
    for (int i = 0; i < 4; ++i) {
      const int c = (lane + 64 * i) * 4;
      float4 gg = *(const float4*)(g + c), s4 = *(const float4*)(sh + c), c4 = *(const float4*)(sc + c);
      const float m0 = gg.x * (1.f + c4.x), m1 = gg.y * (1.f + c4.y), m2 = gg.z * (1.f + c4.z), m3 = gg.w * (1.f + c4.w);
#pragma unroll
      for (int q = 0; q < 4; ++q) {
        const float rstd = rsqrtf(ss[q] * (1.f / 1024.f) + 1e-6f);
        u32x2 o;
        o.x = pack2(v[q][i].x * rstd * m0 + s4.x, v[q][i].y * rstd * m1 + s4.y);
        o.y = pack2(v[q][i].z * rstd * m2 + s4.z, v[q][i].w * rstd * m3 + s4.w);
        *(u32x2*)(U + tiled_off(row0 + q, c, 16)) = o;
      }
    }
  }
}

DI void phase_ffn_up(const Params& p, char* WS, int a, char* smem) {
  const int tid = get_tid512(), lane = tid & 63, wave = tid >> 6, wm = wave >> 2, wn = wave & 3, r = lane & 31, h = lane >> 5;
  const bf16_t* U = (const bf16_t*)(WS + OFF_U);
  const bf16_t* W = (const bf16_t*)(WS + OFF_WUP) + (size_t)a * 5632 * 1024;
  bf16_t* H = (bf16_t*)(WS + OFF_HZ);
  TileIter256 ti(22, 1);
  for (int tm, tn; ti.next(tm, tn);) {
    f32x16 acc[4][2]; zero_acc42(acc);
    gemm256_main(U + ((size_t)tm * 2 * 16 << 13), W + ((size_t)tn * 2 * 16 << 13), 1024, (bf16_t*)smem, acc);
    {
      constexpr int SLD = 128 + 8;
      bf16_t* st = (bf16_t*)smem;
#pragma unroll
      for (int mi = 0; mi < 4; ++mi)
#pragma unroll
        for (int i = 0; i < 16; ++i) {
          float v1 = acc[mi][0][i], v3 = acc[mi][1][i];
          st[(wm * 128 + mi * 32 + crow(i, h)) * SLD + wn * 32 + r] = f2bf(v1 * sigmoidf_(v1) * v3);
        }
      __syncthreads();
#pragma unroll
      for (int q = 0; q < 8; ++q) {
        const int c = get_tid512() + 512 * q;
        const int row = c >> 4, cc = (c & 15) * 8;
        u32x4 v = *(const u32x4*)(st + row * SLD + cc);
        *(u32x4*)(H + tiled_off(tm * 256 + row, tn * 128 + cc, 44)) = v;
      }
    }
  }
}

DI void phase_gemm_resid(const Params& p, char* WS, const bf16_t* A, const bf16_t* Bt, int K, const float* gmod,
                         float coef, char* smem) {
  const int tid = get_tid512(), lane = tid & 63, wave = tid >> 6, wm = wave >> 2, wn = wave & 3, r = lane & 31, h = lane >> 5;
  float* xo = p.xo;
  TileIter256 ti(4, 2);
  for (int tm, tn; ti.next(tm, tn);) {
    f32x16 acc[4][2]; zero_acc42(acc);
    gemm256_main(A + ((size_t)tm * 2 * (K >> 6) << 13), Bt + ((size_t)tn * 2 * (K >> 6) << 13), K, (bf16_t*)smem, acc);
    const int b = (tm * 256) >> 11;
#pragma unroll
    for (int ni = 0; ni < 2; ++ni) {
      const int col = tn * 256 + wn * 64 + ni * 32 + r;
      const float gs = coef * (1.f + gmod[(size_t)b * 9216 + col]);
#pragma unroll
      for (int mi = 0; mi < 4; ++mi)
#pragma unroll
        for (int i = 0; i < 16; ++i) {
          int row = tm * 256 + wm * 128 + mi * 32 + crow(i, h);
          float* xp = xo + (size_t)row * 1024 + col;
          *xp = *xp + gs * acc[mi][ni][i];
        }
    }
  }
}

DI void phase_inproj(const Params& p, char* WS, char* smem) {
  const int tid = get_tid512(), lane = tid & 63, wave = tid >> 6, wm = wave >> 2, wn = wave & 3, r = lane & 31, h = lane >> 5;
  const bf16_t* U = (const bf16_t*)(WS + OFF_U);
  const bf16_t* W = (const bf16_t*)(WS + OFF_WIN);
  bf16_t* Z = (bf16_t*)(WS + OFF_HZ);
  TileIter256 ti(12, 2);
  for (int tm, tn; ti.next(tm, tn);) {
    f32x16 acc[4][2]; zero_acc42(acc);
    gemm256_main(U + ((size_t)tm * 2 * 16 << 13), W + ((size_t)tn * 2 * 16 << 13), 1024, (bf16_t*)smem, acc);
    {
      constexpr int SLD = 256 + 8;
      bf16_t* st = (bf16_t*)smem;
#pragma unroll
      for (int ni = 0; ni < 2; ++ni)
#pragma unroll
        for (int mi = 0; mi < 4; ++mi)
#pragma unroll
          for (int i = 0; i < 16; ++i)
            st[(wm * 128 + mi * 32 + crow(i, h)) * SLD + wn * 64 + ni * 32 + r] = f2bf(acc[mi][ni][i]);
      __syncthreads();
#pragma unroll
      for (int q = 0; q < 16; ++q) {
        const int c = get_tid512() + 512 * q;
        const int row = c >> 5, cc = (c & 31) * 8;
        if (tn * 256 + cc < ZW) {
          u32x4 v = *(const u32x4*)(st + row * SLD + cc);
          *(u32x4*)(Z + (size_t)(tm * 256 + row) * ZW + tn * 256 + cc) = v;
        }
      }
    }
  }
}

DI void phase_merge(const Params& p, char* WS, char* smem) {
  const int tid = get_tid(), lane = tid & 63, wave = tid >> 6, wm = wave >> 1, wn = wave & 1, r = lane & 31, h = lane >> 5;
  const bf16_t* U = (const bf16_t*)(WS + OFF_U);
  const bf16_t* WG = (const bf16_t*)(WS + OFF_WIN) + (size_t)2944 * 1024;
  const bf16_t* WB = (const bf16_t*)(WS + OFF_WBR);
  bf16_t* M = (bf16_t*)(WS + OFF_MERGED);
  TileIter ti(16);
  for (int tm, tn; ti.next(tm, tn);) {
    f32x16 am[2][1];
#pragma unroll
    for (int i = 0; i < 16; ++i) { am[0][0][i] = 0.f; am[1][0][i] = 0.f; }
#pragma unroll 1
    for (int n = 0; n < 4; ++n) {
      const size_t yoff = (n == 0) ? OFF_YA : (n == 1) ? OFF_YB : (n == 2) ? OFF_YC : OFF_YD;
      const bf16_t* Y = (const bf16_t*)(WS + yoff);
      f32x16 ag[2][1], ab[2][1];
#pragma unroll
      for (int i = 0; i < 16; ++i) { ag[0][0][i] = 0.f; ag[1][0][i] = 0.f; ab[0][0][i] = 0.f; ab[1][0][i] = 0.f; }
      gemm_main<false, 4, 1>(U + ((size_t)tm * 16 << 13), 64, 8192,
                             WG + ((size_t)((n * 1024 + tn * 64) >> 7) * 16 << 13) + (tn & 1) * 64 * 64, 64, 8192, 1024,
                             (bf16_t*)smem, ag, nullptr);
      gemm_main<false, 4, 1>(Y + (size_t)tm * 128 * 512, 512, 64, WB + (size_t)n * 1024 * 512 + ((size_t)(tn >> 1) * 8 << 13) + (tn & 1) * 64 * 64, 64, 8192, 512, (bf16_t*)smem, ab, nullptr);
#pragma unroll
      for (int x = 0; x < 2; ++x)
#pragma unroll
        for (int i = 0; i < 16; ++i) am[x][0][i] += sigmoidf_(ag[x][0][i]) * ab[x][0][i];
    }
    {
      constexpr int SLD = 64 + 8;
      bf16_t* st = (bf16_t*)smem;
#pragma unroll
      for (int mi = 0; mi < 2; ++mi)
#pragma unroll
        for (int i = 0; i < 16; ++i) st[(wm * 64 + mi * 32 + crow(i, h)) * SLD + wn * 32 + r] = f2bf(am[mi][0][i]);
      __syncthreads();
#pragma unroll
      for (int q = 0; q < 4; ++q) {
        const int c = get_tid() + 256 * q;
        const int row = c >> 3, cc = (c & 7) * 8;
        u32x4 v = *(const u32x4*)(st + row * SLD + cc);
        *(u32x4*)(M + tiled_off(tm * 128 + row, tn * 64 + cc, 16)) = v;
      }
    }
  }
}

template <bool PASS2>
DI void s5_item(const Params& p, char* WS, int l, int item, char* smem) {
  const int tid = get_tid(), lane = tid & 63, wave = tid >> 6, r = lane & 31, h = lane >> 5;
  const int b = item >> 5, ck = item & 31;
  const int t0 = b * SEQ + ck * 64;
  const bf16_t* Z = (const bf16_t*)(WS + OFF_HZ);
  const float* AB = (const float*)(WS + OFF_S5AB);
  const bf16_t* BB = (const bf16_t*)(WS + OFF_S5BB);
  const bf16_t* CT = (const bf16_t*)(WS + OFF_S5CT);
  float* ENDS = (float*)(WS + OFF_ENDS);
  bf16_t* YS = (bf16_t*)(WS + OFF_YS5);
  constexpr int XLD = 136;
  bf16_t* img = (bf16_t*)smem + (size_t)wave * 64 * XLD;
  const int tokA = 32 * ((r >> 2) & 1) + (r & 3) + 4 * (r >> 3);
  for (int gi = 0; gi < 8; ++gi) {
    const int g = wave * 8 + gi;
    bf16x8 af[2];
#pragma unroll
    for (int m = 0; m < 2; ++m) af[m] = *(const bf16x8*)(Z + (size_t)(t0 + tokA + 16 * m) * ZW + Z_US5 + g * 16 + 8 * h);
    if (PASS2) __syncthreads();
#pragma unroll 1
    for (int sb = 0; sb < 2; ++sb) {
      const int st = sb * 32 + r;
      const float4 abv = *(const float4*)(AB + (size_t)(g * 64 + st) * 4);
      const float ar = abv.x, ai = abv.y;
      bf16x8 bfr = *(const bf16x8*)(BB + ((size_t)g * 128 + st) * 16 + 8 * h);
      bf16x8 bfi = *(const bf16x8*)(BB + ((size_t)g * 128 + 64 + st) * 16 + 8 * h);
      f32x16 zr;
#pragma unroll
      for (int i = 0; i < 16; ++i) zr[i] = 0.f;
      f32x16 bur0 = MFMA32(af[0], bfr, zr), bur1 = MFMA32(af[1], bfr, zr);
      f32x16 bui0 = MFMA32(af[0], bfi, zr), bui1 = MFMA32(af[1], bfi, zr);
      float cr = 0.f, ci = 0.f;
      if (PASS2) {
        const float a64r = abv.z, a64i = abv.w;
        const float* e0 = ENDS + (((size_t)(b * 32) * 32 + g) * 128) + st;
        int c2 = 0;
        for (; c2 + 2 <= ck; c2 += 2) {
          float er[2], ei[2];
#pragma unroll
          for (int q = 0; q < 2; ++q) { er[q] = e0[(size_t)(c2 + q) * 4096]; ei[q] = e0[(size_t)(c2 + q) * 4096 + 64]; }
#pragma unroll
          for (int q = 0; q < 2; ++q) {
            float nr = a64r * cr - a64i * ci + er[q], ni = a64r * ci + a64i * cr + ei[q];
            cr = nr; ci = ni;
          }
        }
        for (; c2 < ck; ++c2) {
          float er = e0[(size_t)c2 * 4096], ei = e0[(size_t)c2 * 4096 + 64];
          float nr = a64r * cr - a64i * ci + er, ni = a64r * ci + a64i * cr + ei;
          cr = nr; ci = ni;
        }
      }
      float xr = cr, xi = ci;
#pragma unroll
      for (int i = 0; i < 16; ++i) { float nr = ar * xr - ai * xi + bur0[i], ni = ar * xi + ai * xr + bui0[i]; xr = nr; xi = ni; }
#pragma unroll
      for (int i = 0; i < 16; ++i) { float nr = ar * xr - ai * xi + bur1[i], ni = ar * xi + ai * xr + bui1[i]; xr = nr; xi = ni; }
      float er0 = xshfl(xr, r), ei0 = xshfl(xi, r);
      xr = h ? er0 : cr; xi = h ? ei0 : ci;
#pragma unroll
      for (int i = 0; i < 16; ++i) {
        float nr = ar * xr - ai * xi + bur0[i], ni = ar * xi + ai * xr + bui0[i]; xr = nr; xi = ni;
        if (PASS2) { int tk = 32 * h + i; img[tk * XLD + st] = f2bf(xr); img[tk * XLD + 64 + st] = f2bf(xi); }
      }
#pragma unroll
      for (int i = 0; i < 16; ++i) {
        float nr = ar * xr - ai * xi + bur1[i], ni = ar * xi + ai * xr + bui1[i]; xr = nr; xi = ni;
        if (PASS2) { int tk = 32 * h + 16 + i; img[tk * XLD + st] = f2bf(xr); img[tk * XLD + 64 + st] = f2bf(xi); }
      }
      if (!PASS2) {
        if (h) { float* e = ENDS + (((size_t)(b * 32 + ck) * 32 + g) * 128); e[st] = xr; e[64 + st] = xi; }
      }
    }
    if (PASS2) {
      __syncthreads();
      f32x16 y0, y1;
#pragma unroll
      for (int i = 0; i < 16; ++i) { y0[i] = 0.f; y1[i] = 0.f; }
#pragma unroll
      for (int s = 0; s < 8; ++s) {
        bf16x8 cf;
        if (r < 16) cf = *(const bf16x8*)(CT + ((size_t)g * 16 + r) * 128 + 16 * s + 8 * h);
        else {
#pragma unroll
          for (int j = 0; j < 8; ++j) cf[j] = 0;
        }
        bf16x8 a0 = *(const bf16x8*)(img + (r)*XLD + 16 * s + 8 * h);
        bf16x8 a1 = *(const bf16x8*)(img + (32 + r) * XLD + 16 * s + 8 * h);
        y0 = MFMA32(a0, cf, y0); y1 = MFMA32(a1, cf, y1);
      }
      if (r < 16) {
        const int ch = g * 16 + r;
        const float dd = p.s5_d[l * 512 + ch];
#pragma unroll
        for (int i = 0; i < 16; ++i) {
          int tk = crow(i, h);
          float u0 = bf2f(Z[(size_t)(t0 + tk) * ZW + Z_US5 + ch]);
          float u1 = bf2f(Z[(size_t)(t0 + 32 + tk) * ZW + Z_US5 + ch]);
          YS[(size_t)(t0 + tk) * 512 + ch] = f2bf(gelu_tanh(y0[i] + dd * u0));
          YS[(size_t)(t0 + 32 + tk) * 512 + ch] = f2bf(gelu_tanh(y1[i] + dd * u1));
        }
      }
    }
  }
}

DI void dsa_prep_qk(const Params& p, char* WS, int l, int bitem) {
  const int idx = bitem * NTHREADS + get_tid();
  if (idx >= T * 9) return;
  const int t = idx / 9, role = idx % 9;
  bf16_t* Z = (bf16_t*)(WS + OFF_HZ);
  const float* rope = (const float*)(WS + OFF_ROPE) + (size_t)t * 56;
  bf16_t* src = Z + (size_t)t * ZW + (role < 8 ? Z_QDSA + role * 64 : Z_KDSA);
  bf16_t* dst = (role < 8) ? src : (bf16_t*)(WS + OFF_KD) + (size_t)t * 64;
  const float* gain = p.dsa_qk_gain + (l * 2 + (role < 8 ? 0 : 1)) * 64;
  float v[64];
#pragma unroll
  for (int q = 0; q < 8; ++q) unpack8(*(const u32x4*)(src + q * 8), v + q * 8);
  float ss = 0.f;
#pragma unroll
  for (int j = 0; j < 64; ++j) ss += v[j] * v[j];
  const float rs = rsqrtf(ss * (1.f / 64.f) + 1e-6f);
#pragma unroll
  for (int j = 0; j < 64; ++j) v[j] = v[j] * rs * gain[j];
#pragma unroll
  for (int i = 0; i < 8; ++i) {
    float c = rope[32 + i], s = rope[40 + i];
    float x1 = v[i], x2 = v[8 + i];
    v[i] = x1 * c - x2 * s; v[8 + i] = x2 * c + x1 * s;
  }
#pragma unroll
  for (int q = 0; q < 8; ++q) *(u32x4*)(dst + q * 8) = pack8(v + q * 8);
}
DI void dsa_prep_idx(const Params& p, char* WS, int bitem) {
  const int idx = bitem * NTHREADS + get_tid();
  if (idx >= T * 9) return;
  const int t = idx / 9, role = idx % 9;
  bf16_t* Z = (bf16_t*)(WS + OFF_HZ);
  const float* rope = (const float*)(WS + OFF_ROPE) + (size_t)t * 56;
  bf16_t* src = Z + (size_t)t * ZW + (role < 8 ? Z_QIDX + role * 32 : Z_KIDX);
  bf16_t* dst = (role < 8) ? src : (bf16_t*)(WS + OFF_KI) + (size_t)t * 32;
  float v[32];
#pragma unroll
  for (int q = 0; q < 4; ++q) unpack8(*(const u32x4*)(src + q * 8), v + q * 8);
#pragma unroll
  for (int i = 0; i < 4; ++i) {
    float c = rope[48 + i], s = rope[52 + i];
    float x1 = v[i], x2 = v[4 + i];
    v[i] = x1 * c - x2 * s; v[4 + i] = x2 * c + x1 * s;
  }
#pragma unroll
  for (int q = 0; q < 4; ++q) *(u32x4*)(dst + q * 8) = pack8(v + q * 8);
}
DI void dsa_prep_vt(const Params& p, char* WS, int item, char* smem) {
  const int tid = get_tid();
  const int b = item >> 5, ck = item & 31;
  const bf16_t* Z = (const bf16_t*)(WS + OFF_HZ);
  bf16_t* VTD = (bf16_t*)(WS + OFF_VTD);
  bf16_t* tile = (bf16_t*)smem;
  __syncthreads();
  {
    const int tt = tid >> 2, dq = (tid & 3) * 16;
    const bf16_t* s = Z + (size_t)(b * SEQ + ck * 64 + tt) * ZW + Z_VDSA + dq;
    u32x4 a = *(const u32x4*)s, c = *(const u32x4*)(s + 8);
    uint32_t w[8] = {a.x, a.y, a.z, a.w, c.x, c.y, c.z, c.w};
#pragma unroll
    for (int e = 0; e < 8; ++e) *(uint32_t*)(tile + tt * 66 + dq + 2 * e) = w[e];
  }
  __syncthreads();
  {
    const int d = tid >> 2, tq = (tid & 3) * 16;
    uint32_t w[8];
#pragma unroll
    for (int e = 0; e < 8; ++e) w[e] = (uint32_t)tile[(tq + 2 * e) * 66 + d] | ((uint32_t)tile[(tq + 2 * e + 1) * 66 + d] << 16);
    bf16_t* o = VTD + ((size_t)b * 64 + d) * SEQ + ck * 64 + tq;
    *(u32x4*)o = u32x4{w[0], w[1], w[2], w[3]};
    *(u32x4*)(o + 8) = u32x4{w[4], w[5], w[6], w[7]};
  }
}

DI void rg_conv(const Params& p, char* WS, int l, int bitem) {
  const int idx = bitem * NTHREADS + get_tid();
  const int t = idx >> 6, c0 = (idx & 63) * 8;
  const int tl = t & (SEQ - 1);
  const bf16_t* Z = (const bf16_t*)(WS + OFF_HZ);
  float acc[8];
#pragma unroll
  for (int e = 0; e < 8; ++e) acc[e] = p.conv_b[l * 512 + c0 + e];
#pragma unroll
  for (int w = 0; w < 4; ++w) {
    int dt = w - 3;
    if (tl + dt >= 0) {
      float f[8]; unpack8(*(const u32x4*)(Z + (size_t)(t + dt) * ZW + Z_XRNN + c0), f);
#pragma unroll
      for (int e = 0; e < 8; ++e) acc[e] += f[e] * p.conv_w[(l * 4 + w) * 512 + c0 + e];
    }
  }
  *(u32x4*)((bf16_t*)(WS + OFF_XC) + (size_t)t * 512 + c0) = pack8(acc);
}

DI void mla_up_tile(const Params& p, char* WS, int t, bool kv, char* smem) {
  const int tid = get_tid(), lane = tid & 63, wave = tid >> 6, wm = wave >> 1, wn = wave & 1, r = lane & 31, h = lane >> 5;
  const bf16_t* Z = (const bf16_t*)(WS + OFF_HZ);
  float* rowstat = (float*)(smem + 4 * TILE_ELEMS * 2);
  f32x16 acc[2][2]; zero_acc(acc);
  if (!kv) {
    const int tm = t / 6, tn = t % 6;
    gemm_main<true>(Z + (size_t)tm * 128 * ZW + Z_QLAT, ZW, 64, (const bf16_t*)(WS + OFF_WUQ) + ((size_t)tn * 4 << 13), 64, 8192, 256,
                    (bf16_t*)smem, acc, rowstat);
    bf16_t* Q = (bf16_t*)(WS + OFF_Q);
#pragma unroll
    for (int mi = 0; mi < 2; ++mi)
#pragma unroll
      for (int ni = 0; ni < 2; ++ni)
#pragma unroll
        for (int i = 0; i < 16; ++i) {
          int rl = wm * 64 + mi * 32 + crow(i, h);
          int col = tn * 128 + wn * 64 + ni * 32 + r;
          Q[(size_t)(tm * 128 + rl) * 768 + col] = f2bf(acc[mi][ni][i] * rowstat[rl]);
        }
  } else {
    const int tm = t >> 3, hd = t & 7;
    gemm_main<true>(Z + (size_t)tm * 128 * ZW + Z_KVLAT, ZW, 64, (const bf16_t*)(WS + OFF_WUKV) + ((size_t)hd * 2 << 13), 64, 8192, 128,
                    (bf16_t*)smem, acc, rowstat);
    if (wn == 0) {
      bf16_t* KN = (bf16_t*)(WS + OFF_KNOPE);
#pragma unroll
      for (int mi = 0; mi < 2; ++mi)
#pragma unroll
        for (int ni = 0; ni < 2; ++ni)
#pragma unroll
          for (int i = 0; i < 16; ++i) {
            int rl = wm * 64 + mi * 32 + crow(i, h);
            KN[(size_t)(tm * 128 + rl) * 512 + hd * 64 + ni * 32 + r] = f2bf(acc[mi][ni][i] * rowstat[rl]);
          }
    } else {
      bf16_t* VT = (bf16_t*)(WS + OFF_VT);
      const int b = (tm * 128) >> 11, tl0 = (tm * 128) & (SEQ - 1);
#pragma unroll
      for (int mi = 0; mi < 2; ++mi)
#pragma unroll
        for (int ni = 0; ni < 2; ++ni)
#pragma unroll
          for (int g4 = 0; g4 < 4; ++g4) {
            int rl = wm * 64 + mi * 32 + 8 * g4 + 4 * h;
            u32x2 o;
            o.x = pack2(acc[mi][ni][4 * g4] * rowstat[rl], acc[mi][ni][4 * g4 + 1] * rowstat[rl + 1]);
            o.y = pack2(acc[mi][ni][4 * g4 + 2] * rowstat[rl + 2], acc[mi][ni][4 * g4 + 3] * rowstat[rl + 3]);
            *(u32x2*)(VT + ((size_t)(b * 8 + hd) * 64 + ni * 32 + r) * SEQ + tl0 + rl) = o;
          }
    }
  }
}

DI void mla_elem(const Params& p, char* WS, int l, int bitem) {
  const int idx = bitem * NTHREADS + get_tid();
  const int t = idx >> 4, role = idx & 15;
  const int hd = role & 7; const bool isk = role >= 8;
  bf16_t* Q = (bf16_t*)(WS + OFF_Q);
  const bf16_t* Z = (const bf16_t*)(WS + OFF_HZ);
  const bf16_t* KN = (const bf16_t*)(WS + OFF_KNOPE);
  bf16_t* K = (bf16_t*)(WS + OFF_K);
  const float* rope = (const float*)(WS + OFF_ROPE) + (size_t)t * 56;
  const bf16_t* s0 = isk ? Z + (size_t)t * ZW + Z_KPE : Q + (size_t)t * 768 + hd * 96;
  const bf16_t* s1 = isk ? KN + (size_t)t * 512 + hd * 64 : Q + (size_t)t * 768 + hd * 96 + 32;
  bf16_t* dst = isk ? K + (size_t)t * 768 + hd * 96 : Q + (size_t)t * 768 + hd * 96;
  const float* gain = p.mla_qk_gain + (l * 2 + (isk ? 1 : 0)) * 96;
  float v[96];
#pragma unroll
  for (int q = 0; q < 4; ++q) unpack8(*(const u32x4*)(s0 + q * 8), v + q * 8);
#pragma unroll
  for (int q = 0; q < 8; ++q) unpack8(*(const u32x4*)(s1 + q * 8), v + 32 + q * 8);
  float ss = 0.f;
#pragma unroll
  for (int j = 0; j < 96; ++j) ss += v[j] * v[j];
  const float rs = rsqrtf(ss * (1.f / 96.f) + 1e-6f);
#pragma unroll
  for (int j = 0; j < 96; ++j) v[j] = v[j] * rs * gain[j];
#pragma unroll
  for (int i = 0; i < 16; ++i) {
    float c = rope[i], s = rope[16 + i];
    float x1 = v[i], x2 = v[16 + i];
    v[i] = x1 * c - x2 * s; v[16 + i] = x2 * c + x1 * s;
  }
#pragma unroll
  for (int q = 0; q < 12; ++q) *(u32x4*)(dst + q * 8) = pack8(v + q * 8);
}

DI void rg_gate_tile(const Params& p, char* WS, int l, int t, char* smem) {
  const int tid = get_tid(), lane = tid & 63, wave = tid >> 6, wm = wave >> 1, wn = wave & 1, r = lane & 31, h = lane >> 5;
  const int tm = t >> 3, hd = t & 7;
  const bf16_t* XC = (const bf16_t*)(WS + OFF_XC);
  f32x16 acc[2][2]; zero_acc(acc);
  gemm_main<false>(XC + (size_t)tm * 128 * 512 + hd * 64, 512, 64, (const bf16_t*)(WS + OFF_WRG) + (size_t)hd * 128 * 64, 64, 64, 64,
                   (bf16_t*)smem, acc, nullptr);
  const int ch = hd * 64 + wn * 32 + r;
  const float ba = p.rg_ba[l * 512 + ch], bx = p.rg_bx[l * 512 + ch];
  const float lam = p.rg_lambda[l * 512 + ch];
  const float sp = log1pf(__expf(-lam));
  bf16_t* LOGA = (bf16_t*)(WS + OFF_LOGA);
  bf16_t* INP = (bf16_t*)(WS + OFF_INP);
#pragma unroll
  for (int mi = 0; mi < 2; ++mi)
#pragma unroll
    for (int i = 0; i < 16; ++i) {
      int row = tm * 128 + wm * 64 + mi * 32 + crow(i, h);
      float rg = sigmoidf_(acc[mi][0][i] + ba), ig = sigmoidf_(acc[mi][1][i] + bx);
      float loga = -8.f * rg * sp;
      float mult = sqrtf(fmaxf(1.f - __expf(2.f * loga), 0.f));
      float xc = bf2f(XC[(size_t)row * 512 + ch]);
      LOGA[(size_t)row * 512 + ch] = f2bf(loga);
      INP[(size_t)row * 512 + ch] = f2bf(mult * ig * xc);
    }
}

DI void rg_scan_item(const Params& p, char* WS, int item, char* smem) {
  const int tid = get_tid(), c8 = tid & 7, seg = tid >> 3;
  const int b = item >> 3, hd = item & 7;
  const int ch = hd * 64 + c8 * 8;
  const bf16_t* LOGA = (const bf16_t*)(WS + OFF_LOGA) + (size_t)b * SEQ * 512 + ch;
  const bf16_t* INP = (const bf16_t*)(WS + OFF_INP) + (size_t)b * SEQ * 512 + ch;
  const bf16_t* G = (const bf16_t*)(WS + OFF_HZ) + (size_t)b * SEQ * ZW + Z_GATE + ch;
  bf16_t* YA = (bf16_t*)(WS + OFF_YA) + (size_t)b * SEQ * 512 + ch;
  float* ex = (float*)smem;
  const int ts = seg * 64;
  float P[8], hh[8];
#pragma unroll
  for (int e = 0; e < 8; ++e) { P[e] = 1.f; hh[e] = 0.f; }
#pragma unroll 4
  for (int i = 0; i < 64; ++i) {
    float la[8], in[8];
    unpack8(*(const u32x4*)(LOGA + (size_t)(ts + i) * 512), la);
    unpack8(*(const u32x4*)(INP + (size_t)(ts + i) * 512), in);
#pragma unroll
    for (int e = 0; e < 8; ++e) { float a = __expf(la[e]); hh[e] = a * hh[e] + in[e]; P[e] *= a; }
  }
  __syncthreads();
#pragma unroll
  for (int e = 0; e < 8; ++e) { ex[((seg * 64) + c8 * 8 + e) * 2] = P[e]; ex[((seg * 64) + c8 * 8 + e) * 2 + 1] = hh[e]; }
  __syncthreads();
#pragma unroll
  for (int e = 0; e < 8; ++e) hh[e] = 0.f;
  for (int s2 = 0; s2 < seg; ++s2) {
#pragma unroll
    for (int e = 0; e < 8; ++e) hh[e] = ex[((s2 * 64) + c8 * 8 + e) * 2] * hh[e] + ex[((s2 * 64) + c8 * 8 + e) * 2 + 1];
  }
#pragma unroll 4
  for (int i = 0; i < 64; ++i) {
    float la[8], in[8], gt[8], o[8];
    unpack8(*(const u32x4*)(LOGA + (size_t)(ts + i) * 512), la);
    unpack8(*(const u32x4*)(INP + (size_t)(ts + i) * 512), in);
    unpack8(*(const u32x4*)(G + (size_t)(ts + i) * ZW), gt);
#pragma unroll
    for (int e = 0; e < 8; ++e) { float a = __expf(la[e]); hh[e] = a * hh[e] + in[e]; o[e] = hh[e] * gelu_tanh(gt[e]); }
    *(u32x4*)(YA + (size_t)(ts + i) * 512) = pack8(o);
  }
}

DI void glu_tile(const Params& p, char* WS, int l, int t, char* smem) {
  const int tid = get_tid(), lane = tid & 63, wave = tid >> 6, wm = wave >> 1, wn = wave & 1, r = lane & 31, h = lane >> 5;
  const int tm = t >> 2, tn = t & 3;
  const bf16_t* YS = (const bf16_t*)(WS + OFF_YS5);
  bf16_t* YD = (bf16_t*)(WS + OFF_YD);
  f32x16 acc[2][2]; zero_acc(acc);
  gemm_main<false>(YS + (size_t)tm * 128 * 512, 512, 64, (const bf16_t*)(WS + OFF_WGLU) + ((size_t)tn * 8 << 13), 64, 8192, 512,
                   (bf16_t*)smem, acc, nullptr);
#pragma unroll
  for (int ni = 0; ni < 2; ++ni) {
    const int col = tn * 128 + wn * 64 + ni * 32 + r;
    const float bg = p.s5_bglu[l * 512 + col];
#pragma unroll
    for (int mi = 0; mi < 2; ++mi)
#pragma unroll
      for (int i = 0; i < 16; ++i) {
        int row = tm * 128 + wm * 64 + mi * 32 + crow(i, h);
        float y = bf2f(YS[(size_t)row * 512 + col]);
        YD[(size_t)row * 512 + col] = f2bf(y * sigmoidf_(acc[mi][ni][i] + bg));
      }
  }
}

DI void mla_attn_item(const Params& p, char* WS, int l, int item, char* smem) {
  const int tid = get_tid(), lane = tid & 63, wave = tid >> 6, r = lane & 31, h = lane >> 5;
  const int qt = 15 - (item >> 7); const int bh = item & 127; const int b = bh >> 3, hd = bh & 7;
  const int q0 = qt * 128 + wave * 32;
  constexpr int KLD = 104, VLD = 72;
  bf16_t* Kt = (bf16_t*)smem;
  bf16_t* Vt = Kt + 2 * 64 * KLD;
  const bf16_t* Qp = (const bf16_t*)(WS + OFF_Q) + (size_t)(b * SEQ + q0 + r) * 768 + hd * 96 + h * 8;
  bf16x8 bq[6];
#pragma unroll
  for (int s6 = 0; s6 < 6; ++s6) bq[s6] = *(const bf16x8*)(Qp + s6 * 16);
  const bf16_t* Kb = (const bf16_t*)(WS + OFF_K) + (size_t)b * SEQ * 768 + hd * 96;
  const bf16_t* Vb = (const bf16_t*)(WS + OFF_VT) + (size_t)(b * 8 + hd) * 64 * SEQ;
  const float* g0 = p.mla_qk_gain + (l * 2) * 96; const float* g1 = g0 + 96;
  float m0 = fmaxf(fabsf(g0[lane]), lane < 32 ? fabsf(g0[64 + lane]) : 0.f);
  float m1 = fmaxf(fabsf(g1[lane]), lane < 32 ? fabsf(g1[64 + lane]) : 0.f);
  m0 = wave_max(m0); m1 = wave_max(m1);
  const float LOG2E = 1.4426950408889634f;
  const float sc2 = 0.10206207261596577f * LOG2E;
  const float cc2 = 9.797958971132712f * m0 * m1 * LOG2E;
  int krow[3], kcol[3];
#pragma unroll
  for (int i = 0; i < 3; ++i) { int c = tid + 256 * i; krow[i] = c / 12; kcol[i] = (c % 12) * 8; }
  int vrow[2], vcol[2];
#pragma unroll
  for (int i = 0; i < 2; ++i) { int c = tid + 256 * i; vrow[i] = c >> 3; vcol[i] = (c & 7) * 8; }
  u32x4 rk0[3], rv0[2], rk1[3], rv1[2];
  f32x16 o0, o1;
#pragma unroll
  for (int i = 0; i < 16; ++i) { o0[i] = 0.f; o1[i] = 0.f; }
  float lsum = 0.f;
  const int nkt = qt * 2 + 2;
#define A_LOAD(RK, RV, KT)                                                                                  \
  {                                                                                                         \
    const int kk_ = ((KT) < nkt ? (KT) : nkt - 1) * 64;                                                     \
    _Pragma("unroll") for (int i = 0; i < 3; ++i) RK[i] = *(const u32x4*)(Kb + (size_t)(kk_ + krow[i]) * 768 + kcol[i]); \
    _Pragma("unroll") for (int i = 0; i < 2; ++i) RV[i] = *(const u32x4*)(Vb + (size_t)vrow[i] * SEQ + kk_ + vcol[i]);   \
  }
#define A_STORE(RK, RV, BUF)                                                                                \
  {                                                                                                         \
    _Pragma("unroll") for (int i = 0; i < 3; ++i) *(u32x4*)(Kt + (BUF) * 64 * KLD + krow[i] * KLD + kcol[i]) = RK[i]; \
    _Pragma("unroll") for (int i = 0; i < 2; ++i) *(u32x4*)(Vt + (BUF) * 64 * VLD + vrow[i] * VLD + vcol[i]) = RV[i]; \
  }
#define A_COMPUTE(BUF, KT)                                                                                  \
  {                                                                                                         \
    const int k0 = (KT) * 64;                                                                               \
    const bf16_t* kc = Kt + (BUF) * 64 * KLD;                                                               \
    const bf16_t* vc = Vt + (BUF) * 64 * VLD;                                                               \
    _Pragma("unroll") for (int sub = 0; sub < 2; ++sub) {                                                   \
      const int ks0 = k0 + sub * 32;                                                                        \
      if (ks0 <= q0 + 31) {                                                                                 \
        f32x16 sacc;                                                                                        \
        _Pragma("unroll") for (int i = 0; i < 16; ++i) sacc[i] = 0.f;                                       \
        _Pragma("unroll") for (int s6 = 0; s6 < 6; ++s6) {                                                  \
          bf16x8 ka = *(const bf16x8*)(kc + (sub * 32 + r) * KLD + s6 * 16 + h * 8);                        \
          sacc = MFMA32(ka, bq[s6], sacc);                                                                  \
        }                                                                                                   \
        const bool diag = (ks0 + 31 > q0);                                                                  \
        float pv[16];                                                                                       \
        _Pragma("unroll") for (int i = 0; i < 16; ++i) {                                                    \
          float e = __builtin_amdgcn_exp2f(sacc[i] * sc2 - cc2);                                            \
          if (diag && (ks0 + crow(i, h) > q0 + r)) e = 0.f;                                                 \
          pv[i] = e; lsum += e;                                                                             \
        }                                                                                                   \
        _Pragma("unroll") for (int s2 = 0; s2 < 2; ++s2) {                                                  \
          u32x4 pfu;                                                                                        \
          pfu.x = pack2_mfma(pv[8 * s2 + 0], pv[8 * s2 + 1]); pfu.y = pack2_mfma(pv[8 * s2 + 2], pv[8 * s2 + 3]); \
          pfu.z = pack2_mfma(pv[8 * s2 + 4], pv[8 * s2 + 5]); pfu.w = pack2_mfma(pv[8 * s2 + 6], pv[8 * s2 + 7]); \
          bf16x8 pf = __builtin_bit_cast(bf16x8, pfu);                                                      \
          const bf16_t* vp = vc + r * VLD + sub * 32 + 16 * s2 + 4 * h;                                     \
          bf16x4 l0 = *(const bf16x4*)vp, h0 = *(const bf16x4*)(vp + 8);                                    \
          bf16x4 l1 = *(const bf16x4*)(vp + 32 * VLD), h1 = *(const bf16x4*)(vp + 32 * VLD + 8);            \
          bf16x8 va0 = __builtin_shufflevector(l0, h0, 0, 1, 2, 3, 4, 5, 6, 7);                             \
          bf16x8 va1 = __builtin_shufflevector(l1, h1, 0, 1, 2, 3, 4, 5, 6, 7);                             \
          o0 = MFMA32(va0, pf, o0); o1 = MFMA32(va1, pf, o1);                                               \
        }                                                                                                   \
      }                                                                                                     \
    }                                                                                                       \
  }
  A_LOAD(rk0, rv0, 0);
  A_LOAD(rk1, rv1, 1);
  __syncthreads();
  A_STORE(rk0, rv0, 0);
  __syncthreads();
  for (int kt = 0; kt < nkt; kt += 2) {
    A_LOAD(rk0, rv0, kt + 2);
    __builtin_amdgcn_sched_barrier(0);
    A_COMPUTE(0, kt);
    __builtin_amdgcn_sched_barrier(0);
    A_STORE(rk1, rv1, 1);
    __syncthreads();
    A_LOAD(rk1, rv1, kt + 3);
    __builtin_amdgcn_sched_barrier(0);
    A_COMPUTE(1, kt + 1);
    __builtin_amdgcn_sched_barrier(0);
    A_STORE(rk0, rv0, 0);
    __syncthreads();
  }
#undef A_LOAD
#undef A_STORE
#undef A_COMPUTE
  const float lt = lsum + xshfl_xor(lsum, 32);
  const float inv = 1.f / lt;
  bf16_t* yb = (bf16_t*)(WS + OFF_YB) + (size_t)(b * SEQ + q0 + r) * 512 + hd * 64;
#pragma unroll
  for (int g4 = 0; g4 < 4; ++g4) {
    u32x2 a, c;
    a.x = pack2(o0[4 * g4] * inv, o0[4 * g4 + 1] * inv); a.y = pack2(o0[4 * g4 + 2] * inv, o0[4 * g4 + 3] * inv);
    c.x = pack2(o1[4 * g4] * inv, o1[4 * g4 + 1] * inv); c.y = pack2(o1[4 * g4 + 2] * inv, o1[4 * g4 + 3] * inv);
    *(u32x2*)(yb + 8 * g4 + 4 * h) = a;
    *(u32x2*)(yb + 32 + 8 * g4 + 4 * h) = c;
  }
}

DI uint32_t sortable(float f) { uint32_t u = __float_as_uint(f); return (u & 0x80000000u) ? ~u : (u | 0x80000000u); }
DI float idx_score(const f32x16& a, const uint32_t (&wvp)[8], int jq) {
  float s = 0.f;
#pragma unroll
  for (int hd = 0; hd < 8; ++hd) {
    const uint32_t pw = wvp[4 * jq + (hd >> 1)];
    const float w = __uint_as_float((hd & 1) ? (pw & 0xffff0000u) : (pw << 16));
    s = fmaf(w, fmaxf(a[8 * jq + hd], 0.f), s);
  }
  return s;
}
DI int half_sum(int v) {
#pragma unroll
  for (int o = 16; o > 0; o >>= 1) v += xshfl_xor_i(v, o);
  return v;
}
DI void dsa_scores(const bf16_t* KI, const bf16x8 (&aqi)[2], const uint32_t (&wv)[8], int r, int h, int myq0, int ktmax,
                   uint32_t (&sk)[64], uint32_t* stash) {
  const bf16_t* kp = KI + (size_t)r * 32 + 8 * h;
#pragma unroll
  for (int g4 = 0; g4 < 16; ++g4) {
    if (g4 * 4 <= ktmax) {
      asm volatile("" : "+v"(kp));
#pragma unroll
      for (int e = 0; e < 4; ++e) {
        const int kt = g4 * 4 + e;
        f32x16 a;
#pragma unroll
        for (int i = 0; i < 16; ++i) a[i] = 0.f;
#pragma unroll
        for (int s2 = 0; s2 < 2; ++s2) {
          bf16x8 kb = *(const bf16x8*)(kp + e * 1024 + 16 * s2);
          a = MFMA32(aqi[s2], kb, a);
        }
        const int key = kt * 32 + r;
        const float s0 = idx_score(a, wv, 0), s1 = idx_score(a, wv, 1);
        sk[kt] = (key <= myq0) ? sortable(s0) : 0u;
        stash[kt * 64] = (key <= myq0 + 1) ? sortable(s1) : 0u;
      }
      kp += 4 * 1024;
    } else {
#pragma unroll
      for (int e = 0; e < 4; ++e) { sk[4 * g4 + e] = 0u; stash[(4 * g4 + e) * 64] = 0u; }
    }
  }
}
DI void dsa_unstash(uint32_t (&sk)[64], const uint32_t* stash, int ktmax) {
#pragma unroll
  for (int g8 = 0; g8 < 8; ++g8) {
    if (g8 * 8 <= ktmax) {
#pragma unroll
      for (int e = 0; e < 8; ++e) sk[8 * g8 + e] = stash[(8 * g8 + e) * 64];
    } else {
#pragma unroll
      for (int e = 0; e < 8; ++e) sk[8 * g8 + e] = 0u;
    }
  }
}
DI void dsa_threshold(const uint32_t (&sk)[64], int r, int ktmax, uint32_t& thr_out, int& cut_out) {
  uint32_t prefix = 0u;
#pragma unroll 1
  for (int bit = 31; bit >= 0; --bit) {
    const uint32_t cand = prefix | (1u << bit);
    int cnt = 0;
#pragma unroll
    for (int g8 = 0; g8 < 8; ++g8) {
      if (g8 * 8 <= ktmax) {
#pragma unroll
        for (int e = 0; e < 8; ++e) cnt += (sk[g8 * 8 + e] >= cand) ? 1 : 0;
      }
    }
    cnt = half_sum(cnt);
    if (cnt >= 256) prefix = cand;
  }
  int cgt = 0, ceq = 0;
#pragma unroll
  for (int kt = 0; kt < 64; ++kt) { cgt += (sk[kt] > prefix) ? 1 : 0; ceq += (sk[kt] == prefix) ? 1 : 0; }
  cgt = half_sum(cgt); ceq = half_sum(ceq);
  const int need = 256 - cgt;
  int c = 0x7fffffff;
  const bool excess = (prefix != 0u) && (ceq > need);
  if (__any(excess)) {
    int cc = 0;
#pragma unroll 1
    for (int bit = 10; bit >= 0; --bit) {
      const int test = cc | (1 << bit);
      int cnt = 0;
#pragma unroll
      for (int kt = 0; kt < 64; ++kt) cnt += (sk[kt] == prefix && (kt * 32 + r) < test) ? 1 : 0;
      cnt = half_sum(cnt);
      if (cnt < need) cc = test;
    }
    if (excess) c = cc;
  }
  thr_out = prefix; cut_out = c;
}

DI void dsa_item(const Params& p, char* WS, int l, int item, char* smem) {
  const int tid = get_tid(), lane = tid & 63, wave = tid >> 6, r = lane & 31, h = lane >> 5;
  const int qt = 127 - (item >> 4); const int b = item & 15;
  const int tq0 = qt * 16 + wave * 4;
  const bf16_t* Z = (const bf16_t*)(WS + OFF_HZ);
  const bf16_t* KI = (const bf16_t*)(WS + OFF_KI) + (size_t)b * SEQ * 32;
  const bf16_t* KD = (const bf16_t*)(WS + OFF_KD) + (size_t)b * SEQ * 64;
  const bf16_t* VTD = (const bf16_t*)(WS + OFF_VTD) + (size_t)b * 64 * SEQ;
  const int ai = (r & 3) + 4 * (r >> 3);
  const int aq = 2 * ((r >> 2) & 1) + (ai >> 3), ah = ai & 7;
  bf16x8 aqi[2];
#pragma unroll
  for (int s2 = 0; s2 < 2; ++s2)
    aqi[s2] = *(const bf16x8*)(Z + (size_t)(b * SEQ + tq0 + aq) * ZW + Z_QIDX + ah * 32 + 16 * s2 + 8 * h);
  uint32_t wv[8];
#pragma unroll
  for (int jq = 0; jq < 2; ++jq) {
    u32x4 w8 = *(const u32x4*)(Z + (size_t)(b * SEQ + tq0 + 2 * h + jq) * ZW + Z_WIDX);
    wv[4 * jq] = w8.x; wv[4 * jq + 1] = w8.y; wv[4 * jq + 2] = w8.z; wv[4 * jq + 3] = w8.w;
  }
  const int myq0 = tq0 + 2 * h;
  const int ktmax = (tq0 + 3) >> 5;
  uint32_t thr[2]; int cut[2];
  {
    uint32_t* stash = (uint32_t*)smem + (size_t)wave * 64 * 64 + lane;
    uint32_t sk[64];
    dsa_scores(KI, aqi, wv, r, h, myq0, ktmax, sk, stash);
    asm volatile("" ::: "memory");
    dsa_threshold(sk, r, ktmax, thr[0], cut[0]);
    dsa_unstash(sk, stash, ktmax);
    asm volatile("" ::: "memory");
    dsa_threshold(sk, r, ktmax, thr[1], cut[1]);
  }
  asm volatile("" ::: "memory");
  constexpr int KLD = 72, VLD = 72, ILD = 40;
  bf16_t* Kt = (bf16_t*)smem;
  bf16_t* Vt = Kt + 2 * 64 * KLD;
  bf16_t* It = Vt + 2 * 64 * VLD;
  const int cq = r >> 3, chd = r & 7;
  bf16x8 bq[4];
#pragma unroll
  for (int s4 = 0; s4 < 4; ++s4)
    bq[s4] = *(const bf16x8*)(Z + (size_t)(b * SEQ + tq0 + cq) * ZW + Z_QDSA + chd * 64 + 16 * s4 + 8 * h);
  const float* g0 = p.dsa_qk_gain + (l * 2) * 64; const float* g1 = g0 + 64;
  const float m0 = wave_max(fabsf(g0[lane])), m1 = wave_max(fabsf(g1[lane]));
  const float LOG2E = 1.4426950408889634f;
  const float sc2 = 0.125f * LOG2E;
  const float cc2 = 8.f * m0 * m1 * LOG2E;
  f32x16 o0, o1;
#pragma unroll
  for (int i = 0; i < 16; ++i) { o0[i] = 0.f; o1[i] = 0.f; }
  float lsum = 0.f;
  const int nkt = ((qt * 16 + 15) >> 6) + 1;
  const int srow0 = tid >> 3, scol0 = (tid & 7) * 8;
  const int irow = tid >> 2, icol = (tid & 3) * 8;
  u32x4 rk0[2], rv0[2], ri0, rk1[2], rv1[2], ri1;
#define D_LOAD(RK, RV, RI, KT)                                                                              \
  {                                                                                                         \
    const int kk_ = ((KT) < nkt ? (KT) : nkt - 1) * 64;                                                     \
    _Pragma("unroll") for (int i = 0; i < 2; ++i) {                                                         \
      RK[i] = *(const u32x4*)(KD + (size_t)(kk_ + srow0 + 32 * i) * 64 + scol0);                            \
      RV[i] = *(const u32x4*)(VTD + (size_t)(srow0 + 32 * i) * SEQ + kk_ + scol0);                          \
    }                                                                                                       \
    RI = *(const u32x4*)(KI + (size_t)(kk_ + irow) * 32 + icol);                                            \
  }
#define D_STORE(RK, RV, RI, BUF)                                                                            \
  {                                                                                                         \
    _Pragma("unroll") for (int i = 0; i < 2; ++i) {                                                         \
      *(u32x4*)(Kt + (BUF) * 64 * KLD + (srow0 + 32 * i) * KLD + scol0) = RK[i];                            \
      *(u32x4*)(Vt + (BUF) * 64 * VLD + (srow0 + 32 * i) * VLD + scol0) = RV[i];                            \
    }                                                                                                       \
    *(u32x4*)(It + (BUF) * 64 * ILD + irow * ILD + icol) = RI;                                              \
  }
#define D_COMPUTE(BUF, KT)                                                                                  \
  {                                                                                                         \
    const int k0 = (KT) * 64;                                                                               \
    const bf16_t* kc = Kt + (BUF) * 64 * KLD;                                                               \
    const bf16_t* vc = Vt + (BUF) * 64 * VLD;                                                               \
    const bf16_t* ic = It + (BUF) * 64 * ILD;                                                               \
    _Pragma("unroll") for (int sub = 0; sub < 2; ++sub) {                                                   \
      if ((KT) * 2 + sub <= ktmax) {                                                                        \
        const int ks0 = k0 + sub * 32;                                                                      \
        f32x16 a;                                                                                           \
        _Pragma("unroll") for (int i = 0; i < 16; ++i) a[i] = 0.f;                                          \
        _Pragma("unroll") for (int s2 = 0; s2 < 2; ++s2) {                                                  \
          bf16x8 kb = *(const bf16x8*)(ic + (sub * 32 + r) * ILD + 16 * s2 + 8 * h);                        \
          a = MFMA32(aqi[s2], kb, a);                                                                       \
        }                                                                                                   \
        const int key = ks0 + r;                                                                            \
        const uint32_t u0 = sortable(idx_score(a, wv, 0)), u1 = sortable(idx_score(a, wv, 1));              \
        const bool sel0 = (key <= myq0) && (u0 > thr[0] || (u0 == thr[0] && key <= cut[0]));                \
        const bool sel1 = (key <= myq0 + 1) && (u1 > thr[1] || (u1 == thr[1] && key <= cut[1]));            \
        const unsigned long long bl0 = __ballot(sel0), bl1 = __ballot(sel1);                                \
        const unsigned long long blq = (cq & 1) ? bl1 : bl0;                                                \
        const uint32_t mymask = (uint32_t)(blq >> (32 * (cq >> 1)));                                        \
        f32x16 sacc;                                                                                        \
        _Pragma("unroll") for (int i = 0; i < 16; ++i) sacc[i] = 0.f;                                       \
        _Pragma("unroll") for (int s4 = 0; s4 < 4; ++s4) {                                                  \
          bf16x8 ka = *(const bf16x8*)(kc + (sub * 32 + r) * KLD + 16 * s4 + 8 * h);                        \
          sacc = MFMA32(ka, bq[s4], sacc);                                                                  \
        }                                                                                                   \
        float pv[16];                                                                                       \
        _Pragma("unroll") for (int i = 0; i < 16; ++i) {                                                    \
          float e = __builtin_amdgcn_exp2f(sacc[i] * sc2 - cc2);                                            \
          e = ((mymask >> crow(i, h)) & 1u) ? e : 0.f;                                                      \
          pv[i] = e; lsum += e;                                                                             \
        }                                                                                                   \
        _Pragma("unroll") for (int s2 = 0; s2 < 2; ++s2) {                                                  \
          u32x4 pfu;                                                                                        \
          pfu.x = pack2_mfma(pv[8 * s2 + 0], pv[8 * s2 + 1]); pfu.y = pack2_mfma(pv[8 * s2 + 2], pv[8 * s2 + 3]); \
          pfu.z = pack2_mfma(pv[8 * s2 + 4], pv[8 * s2 + 5]); pfu.w = pack2_mfma(pv[8 * s2 + 6], pv[8 * s2 + 7]); \
          bf16x8 pf = __builtin_bit_cast(bf16x8, pfu);                                                      \
          const bf16_t* vp = vc + r * VLD + sub * 32 + 16 * s2 + 4 * h;                                     \
          bf16x4 l0 = *(const bf16x4*)vp, h0 = *(const bf16x4*)(vp + 8);                                    \
          bf16x4 l1 = *(const bf16x4*)(vp + 32 * VLD), h1 = *(const bf16x4*)(vp + 32 * VLD + 8);            \
          bf16x8 va0 = __builtin_shufflevector(l0, h0, 0, 1, 2, 3, 4, 5, 6, 7);                             \
          bf16x8 va1 = __builtin_shufflevector(l1, h1, 0, 1, 2, 3, 4, 5, 6, 7);                             \
          o0 = MFMA32(va0, pf, o0); o1 = MFMA32(va1, pf, o1);                                               \
        }                                                                                                   \
      }                                                                                                     \
    }                                                                                                       \
  }
  D_LOAD(rk0, rv0, ri0, 0);
  D_LOAD(rk1, rv1, ri1, 1);
  __syncthreads();
  D_STORE(rk0, rv0, ri0, 0);
  __syncthreads();
  for (int kt = 0; kt < nkt; kt += 2) {
    D_LOAD(rk0, rv0, ri0, kt + 2);
    __builtin_amdgcn_sched_barrier(0);
    D_COMPUTE(0, kt);
    __builtin_amdgcn_sched_barrier(0);
    D_STORE(rk1, rv1, ri1, 1);
    __syncthreads();
    D_LOAD(rk1, rv1, ri1, kt + 3);
    __builtin_amdgcn_sched_barrier(0);
    if (kt + 1 < nkt) D_COMPUTE(1, kt + 1);
    __builtin_amdgcn_sched_barrier(0);
    D_STORE(rk0, rv0, ri0, 0);
    __syncthreads();
  }
#undef D_LOAD
#undef D_STORE
#undef D_COMPUTE
  const float lt = lsum + xshfl_xor(lsum, 32);
  const float inv = 1.f / lt;
  bf16_t* yc = (bf16_t*)(WS + OFF_YC) + (size_t)(b * SEQ + tq0 + cq) * 512 + chd * 64;
#pragma unroll
  for (int g4 = 0; g4 < 4; ++g4) {
    u32x2 a2, c2;
    a2.x = pack2(o0[4 * g4] * inv, o0[4 * g4 + 1] * inv); a2.y = pack2(o0[4 * g4 + 2] * inv, o0[4 * g4 + 3] * inv);
    c2.x = pack2(o1[4 * g4] * inv, o1[4 * g4 + 1] * inv); c2.y = pack2(o1[4 * g4 + 2] * inv, o1[4 * g4 + 3] * inv);
    *(u32x2*)(yc + 8 * g4 + 4 * h) = a2;
    *(u32x2*)(yc + 32 + 8 * g4 + 4 * h) = c2;
  }
}

DI int snake512(int j) {
  const int round = j >> 9, u = j & 511;
  return (round & 1) ? (round << 9) + (511 - u) : j;
}

DI void phase_mix1(const Params& p, char* WS, int l, char* smem, int rep) {
  constexpr int N_S5 = 512, N_Q = 1536, N_KV = 2048, N_VT = 512, N_QK = (T * 9 + 255) / 256, N_IDX = N_QK, N_CONV = T * 64 / 256;
  constexpr int E0 = N_S5, E1 = E0 + N_Q, E2 = E1 + N_KV, E3 = E2 + N_VT, E4 = E3 + N_QK, E5 = E4 + N_IDX, E6 = E5 + N_CONV;
  for (int it = get_bid(); it < E6; it += get_nb()) {
    if (it < E0) s5_item<false>(p, WS, l, it, smem);
    else if (it < E1) mla_up_tile(p, WS, it - E0, false, smem);
    else if (it < E2) mla_up_tile(p, WS, it - E1, true, smem);
    else if (it < E3) dsa_prep_vt(p, WS, it - E2, smem);
    else if (it < E4) { if (rep == 0) dsa_prep_qk(p, WS, l, it - E3); }
    else if (it < E5) { if (rep == 0) dsa_prep_idx(p, WS, it - E4); }
    else rg_conv(p, WS, l, it - E5);
  }
}
DI void phase_mix2(const Params& p, char* WS, int l, char* smem, int rep) {
  constexpr int N_DSA = 2048, N_S5 = 512, N_RG = 2048, N_EL = T * 16 / 256;
  constexpr int E0 = N_DSA, E1 = E0 + N_S5, E2 = E1 + N_RG, E3 = E2 + N_EL;
  for (int it = get_bid(); it < E3; it += get_nb()) {
    if (it < E0) dsa_item(p, WS, l, snake512(it), smem);
    else if (it < E1) s5_item<true>(p, WS, l, it - E0, smem);
    else if (it < E2) rg_gate_tile(p, WS, l, it - E1, smem);
    else if (rep == 0) mla_elem(p, WS, l, it - E2);
  }
}
DI void phase_mix3(const Params& p, char* WS, int l, char* smem) {
  constexpr int N_RG = 128, N_ATT = 2048, N_GLU = 1024;
  constexpr int E0 = N_RG, E1 = E0 + N_ATT, E2 = E1 + N_GLU;
  for (int it = get_bid(); it < E2; it += get_nb()) {
    if (it < E0) rg_scan_item(p, WS, it, smem);
    else if (it < E1) mla_attn_item(p, WS, l, snake512(it - E0), smem);
    else glu_tile(p, WS, l, it - E1, smem);
  }
}

constexpr int NPHASE = 1 + NL * 13;

DI void run_phase(const Params& p, char* WS, int ph, char* smem_blk, int rep) {
  const int l = (ph - 1) / 13, s = (ph - 1) % 13;
  char* smem = smem_blk + get_team() * SMEM_BYTES;
#define MODP ((const float*)(WS + OFF_MOD) + (size_t)l * 16 * 9216)
  switch (s) {
    case 0: phase_convert(p, WS, l, smem); phase_norm(p, WS, l, 0); break;
    case 1: phase_ffn_up(p, WS, 0, smem_blk); break;
    case 2: phase_gemm_resid(p, WS, (const bf16_t*)(WS + OFF_HZ), (const bf16_t*)(WS + OFF_WDN), DFF, MODP + 2 * 1024, 0.5f, smem_blk); break;
    case 3: phase_norm(p, WS, l, 1); break;
    case 4: phase_inproj(p, WS, smem_blk); break;
    case 5: phase_mix1(p, WS, l, smem, rep); break;
    case 6: phase_mix2(p, WS, l, smem, rep); break;
    case 7: phase_mix3(p, WS, l, smem); break;
    case 8: phase_merge(p, WS, smem); break;
    case 9: phase_gemm_resid(p, WS, (const bf16_t*)(WS + OFF_MERGED), (const bf16_t*)(WS + OFF_WOUT), 1024, MODP + 5 * 1024, 1.0f, smem_blk); break;
    case 10: phase_norm(p, WS, l, 2); break;
    case 11: phase_ffn_up(p, WS, 1, smem_blk); break;
    case 12: phase_gemm_resid(p, WS, (const bf16_t*)(WS + OFF_HZ), (const bf16_t*)(WS + OFF_WDN) + (size_t)1024 * DFF, DFF, MODP + 8 * 1024, 0.5f, smem_blk); break;
  }
}

__global__ void __launch_bounds__(NTHREADS_BLK) mega_kernel(Params p, int ph_lo, int ph_hi, int probe) {
  __shared__ __attribute__((aligned(16))) char smem[SMEM_BLK];
  if (ph_lo == 0) {
    phase_init(p, p.ws, smem + get_team() * SMEM_BYTES);
    if (blockIdx.x == 0 && threadIdx.x == 0) {
      Params* tb = (Params*)(p.ws + OFF_TBL);
      tb->x = p.x;
      tb->c = p.c;
      tb->pos = p.pos;
      tb->ada_w = p.ada_w;
      tb->ada_b = p.ada_b;
      tb->norm_g = p.norm_g;
      tb->ffn_w1 = p.ffn_w1;
      tb->ffn_w3 = p.ffn_w3;
      tb->ffn_w2 = p.ffn_w2;
      tb->w_in = p.w_in;
      tb->conv_w = p.conv_w;
      tb->conv_b = p.conv_b;
      tb->rg_wa = p.rg_wa;
      tb->rg_ba = p.rg_ba;
      tb->rg_wx = p.rg_wx;
      tb->rg_bx = p.rg_bx;
      tb->rg_lambda = p.rg_lambda;
      tb->mla_q_norm = p.mla_q_norm;
      tb->mla_w_uq = p.mla_w_uq;
      tb->mla_kv_norm = p.mla_kv_norm;
      tb->mla_w_ukv = p.mla_w_ukv;
      tb->mla_qk_gain = p.mla_qk_gain;
      tb->dsa_qk_gain = p.dsa_qk_gain;
      tb->s5_lre = p.s5_lre;
      tb->s5_lim = p.s5_lim;
      tb->s5_logdt = p.s5_logdt;
      tb->s5_bre = p.s5_bre;
      tb->s5_bim = p.s5_bim;
      tb->s5_cre = p.s5_cre;
      tb->s5_cim = p.s5_cim;
      tb->s5_d = p.s5_d;
      tb->s5_wglu = p.s5_wglu;
      tb->s5_bglu = p.s5_bglu;
      tb->w_branch = p.w_branch;
      tb->w_out = p.w_out;
      tb->xo = p.xo;
      tb->ws = p.ws;
    }
    ph_lo = 1;
    if (ph_lo < ph_hi) cg::this_grid().sync();
  }
  for (int ph = ph_lo; ph < ph_hi; ++ph) {
    char* ws = p.ws;
    asm volatile("" : "+s"(ws));
    const Params& q = *(const Params*)(ws + OFF_TBL);
    const int nrep = (((ph - 1) % 13) == (probe & 255)) ? (probe >> 8) : 1;
    for (int rep = 0; rep < nrep; ++rep) {
      run_phase(q, ws, ph, smem, rep);
      if (rep + 1 < nrep) cg::this_grid().sync();
    }
    if (ph + 1 < ph_hi) cg::this_grid().sync();
  }
}

extern "C" void kernel_launch(void* const* d_in, const int* in_sizes, int n_in, void* d_out, int out_size, void* d_ws,
                              size_t ws_size, hipStream_t stream) {
  Params p{};
  p.x = (const float*)d_in[0]; p.c = (const float*)d_in[1]; p.pos = (const int*)d_in[2];
  p.ada_w = (const float*)d_in[3]; p.ada_b = (const float*)d_in[4]; p.norm_g = (const float*)d_in[5];
  p.ffn_w1 = (const float*)d_in[6]; p.ffn_w3 = (const float*)d_in[7]; p.ffn_w2 = (const float*)d_in[8];
  p.w_in = (const float*)d_in[9]; p.conv_w = (const float*)d_in[10]; p.conv_b = (const float*)d_in[11];
  p.rg_wa = (const float*)d_in[12]; p.rg_ba = (const float*)d_in[13]; p.rg_wx = (const float*)d_in[14];
  p.rg_bx = (const float*)d_in[15]; p.rg_lambda = (const float*)d_in[16]; p.mla_q_norm = (const float*)d_in[17];
  p.mla_w_uq = (const float*)d_in[18]; p.mla_kv_norm = (const float*)d_in[19]; p.mla_w_ukv = (const float*)d_in[20];
  p.mla_qk_gain = (const float*)d_in[21]; p.dsa_qk_gain = (const float*)d_in[22]; p.s5_lre = (const float*)d_in[23];
  p.s5_lim = (const float*)d_in[24]; p.s5_logdt = (const float*)d_in[25]; p.s5_bre = (const float*)d_in[26];
  p.s5_bim = (const float*)d_in[27]; p.s5_cre = (const float*)d_in[28]; p.s5_cim = (const float*)d_in[29];
  p.s5_d = (const float*)d_in[30]; p.s5_wglu = (const float*)d_in[31]; p.s5_bglu = (const float*)d_in[32];
  p.w_branch = (const float*)d_in[33]; p.w_out = (const float*)d_in[34];
  p.xo = (float*)d_out; p.ws = (char*)d_ws;
  if (ws_size < WS_NEED) fprintf(stderr, "workspace too small: %zu < %zu\n", ws_size, (size_t)WS_NEED);
  static int grid_blocks = 0;
  if (!grid_blocks) {
    int dev = 0, cus = 0, per_cu = 0;
    hipGetDevice(&dev);
    hipDeviceGetAttribute(&cus, hipDeviceAttributeMultiprocessorCount, dev);
    hipOccupancyMaxActiveBlocksPerMultiprocessor(&per_cu, mega_kernel, NTHREADS_BLK, 0);
    if (per_cu > 1) per_cu = 1;
    if (per_cu < 1) per_cu = 1;
    grid_blocks = cus * per_cu;
  }
#if MEGA
  int lo = 0, hi = NPHASE, probe = PROBE_CFG;
  void* args[] = {&p, &lo, &hi, &probe};
  hipError_t e = hipLaunchCooperativeKernel((void*)mega_kernel, dim3(grid_blocks), dim3(NTHREADS_BLK), args, 0, stream);
  if (e != hipSuccess) fprintf(stderr, "cooperative launch failed: %s (grid %d)\n", hipGetErrorString(e), grid_blocks);
#else
  for (int ph = 0; ph < NPHASE; ++ph) mega_kernel<<<grid_blocks, NTHREADS_BLK, 0, stream>>>(p, ph, ph + 1, PROBE_CFG);
#endif
}
```

```cpp
#include <hip/hip_runtime.h>
#include <hip/hip_cooperative_groups.h>
#include <stdint.h>
#include <stdio.h>
namespace cg = cooperative_groups;

#ifndef MEGA
#define MEGA 1
#endif
#ifndef PROBE_CFG
#define PROBE_CFG (255 | (1 << 8))
#endif

typedef unsigned short bf16_t;
using bf16x8 = __attribute__((ext_vector_type(8))) short;
using bf16x4 = __attribute__((ext_vector_type(4))) short;
using f32x16 = __attribute__((ext_vector_type(16))) float;
using u32x4 = __attribute__((ext_vector_type(4))) uint32_t;
using u32x2 = __attribute__((ext_vector_type(2))) uint32_t;

#define DI __device__ __forceinline__
#define MFMA32(a, b, c) __builtin_amdgcn_mfma_f32_32x32x16_bf16((a), (b), (c), 0, 0, 0)

constexpr int T = 32768, SEQ = 2048, NB = 16, D = 1024, DFF = 2816, ZW = 2944, DIN = 6984, NL = 4;
constexpr int NTHREADS = 256;
constexpr int NTHREADS_BLK = 512;
constexpr int Z_XRNN = 0, Z_GATE = 512, Z_QLAT = 1024, Z_KVLAT = 1280, Z_KPE = 1408, Z_QDSA = 1440, Z_KDSA = 1952,
              Z_VDSA = 2016, Z_QIDX = 2080, Z_KIDX = 2336, Z_WIDX = 2368, Z_US5 = 2376, Z_GATES = 2888;

constexpr size_t AL(size_t x) { return (x + 255) & ~(size_t)255; }
constexpr size_t OFF_WUP = 0;
constexpr size_t OFF_WDN = OFF_WUP + AL((size_t)2 * 5632 * 1024 * 2);
constexpr size_t OFF_WIN = OFF_WDN + AL((size_t)2 * 1024 * 2816 * 2);
constexpr size_t OFF_WBR = OFF_WIN + AL((size_t)7040 * 1024 * 2);
constexpr size_t OFF_WOUT = OFF_WBR + AL((size_t)4 * 1024 * 512 * 2);
constexpr size_t OFF_WUQ = OFF_WOUT + AL((size_t)1024 * 1024 * 2);
constexpr size_t OFF_WUKV = OFF_WUQ + AL((size_t)768 * 256 * 2);
constexpr size_t OFF_WRG = OFF_WUKV + AL((size_t)1024 * 128 * 2);
constexpr size_t OFF_WGLU = OFF_WRG + AL((size_t)8 * 128 * 64 * 2);
constexpr size_t OFF_S5AB = OFF_WGLU + AL((size_t)512 * 512 * 2);
constexpr size_t OFF_S5BB = OFF_S5AB + AL((size_t)32 * 64 * 4 * 4);
constexpr size_t OFF_S5CT = OFF_S5BB + AL((size_t)32 * 128 * 16 * 2);
constexpr size_t OFF_MOD = OFF_S5CT + AL((size_t)32 * 16 * 128 * 2);
constexpr size_t OFF_ROPE = OFF_MOD + AL((size_t)4 * 16 * 9216 * 4);
constexpr size_t OFF_U = OFF_ROPE + AL((size_t)T * 56 * 4);
constexpr size_t OFF_HZ = OFF_U + AL((size_t)T * 1024 * 2);
constexpr size_t OFF_XC = OFF_HZ + AL((size_t)T * ZW * 2);
constexpr size_t OFF_Q = OFF_XC + AL((size_t)T * 512 * 2);
constexpr size_t OFF_KNOPE = OFF_Q + AL((size_t)T * 768 * 2);
constexpr size_t OFF_VT = OFF_KNOPE + AL((size_t)T * 512 * 2);
constexpr size_t OFF_K = OFF_VT + AL((size_t)T * 512 * 2);
constexpr size_t OFF_KD = OFF_K + AL((size_t)T * 768 * 2);
constexpr size_t OFF_VTD = OFF_KD + AL((size_t)T * 64 * 2);
constexpr size_t OFF_KI = OFF_VTD + AL((size_t)T * 64 * 2);
constexpr size_t OFF_ENDS = OFF_KI + AL((size_t)T * 32 * 2);
constexpr size_t OFF_YS5 = OFF_ENDS + AL((size_t)16 * 32 * 32 * 128 * 4);
constexpr size_t OFF_LOGA = OFF_YS5 + AL((size_t)T * 512 * 2);
constexpr size_t OFF_INP = OFF_LOGA + AL((size_t)T * 512 * 2);
constexpr size_t OFF_YC = OFF_INP + AL((size_t)T * 512 * 2);
constexpr size_t OFF_YD = OFF_YC + AL((size_t)T * 512 * 2);
constexpr size_t OFF_TBL = OFF_YD + AL((size_t)T * 512 * 2);
constexpr size_t WS_NEED = OFF_TBL + 1024;
constexpr size_t OFF_YA = OFF_XC, OFF_YB = OFF_KNOPE, OFF_MERGED = OFF_HZ;

struct Params {
  const float* x; const float* c; const int* pos;
  const float *ada_w, *ada_b, *norm_g, *ffn_w1, *ffn_w3, *ffn_w2, *w_in, *conv_w, *conv_b, *rg_wa, *rg_ba, *rg_wx, *rg_bx,
      *rg_lambda, *mla_q_norm, *mla_w_uq, *mla_kv_norm, *mla_w_ukv, *mla_qk_gain, *dsa_qk_gain, *s5_lre, *s5_lim, *s5_logdt,
      *s5_bre, *s5_bim, *s5_cre, *s5_cim, *s5_d, *s5_wglu, *s5_bglu, *w_branch, *w_out;
  float* xo;
  char* ws;
};

DI int get_tid512() { int t = threadIdx.x; asm volatile("" : "+v"(t)); return t; }
DI int get_tid() { int t = threadIdx.x & 255; asm volatile("" : "+v"(t)); return t; }
DI int get_team() { int t = __builtin_amdgcn_readfirstlane(threadIdx.x >> 8); asm volatile("" : "+s"(t)); return t; }
DI int get_bid() { int b = blockIdx.x * 2 + __builtin_amdgcn_readfirstlane(threadIdx.x >> 8); asm volatile("" : "+s"(b)); return b; }
DI int get_nb() { int b = gridDim.x * 2; asm volatile("" : "+s"(b)); return b; }
DI int get_bid_real() { int b = blockIdx.x; asm volatile("" : "+s"(b)); return b; }
DI int get_nb_real() { int b = gridDim.x; asm volatile("" : "+s"(b)); return b; }
DI float xshfl_xor(float v, int m) { int l = (get_tid() & 63) ^ m; return __int_as_float(__builtin_amdgcn_ds_bpermute(l << 2, __float_as_int(v))); }
DI int xshfl_xor_i(int v, int m) { int l = (get_tid() & 63) ^ m; return __builtin_amdgcn_ds_bpermute(l << 2, v); }
DI float xshfl(float v, int src) { return __int_as_float(__builtin_amdgcn_ds_bpermute(src << 2, __float_as_int(v))); }
DI float bf2f(bf16_t v) { return __uint_as_float(((uint32_t)v) << 16); }
DI uint32_t pack2(float a, float b) { uint32_t r; asm("v_cvt_pk_bf16_f32 %0, %1, %2" : "=v"(r) : "v"(a), "v"(b)); return r; }
DI uint32_t pack2_mfma(float a, float b) { uint32_t r; asm volatile("v_cvt_pk_bf16_f32 %0, %1, %2\n\ts_nop 1" : "=v"(r) : "v"(a), "v"(b)); return r; }
DI bf16_t f2bf(float f) { return (bf16_t)(pack2(f, f) & 0xffffu); }
DI int crow(int i, int h) { return (i & 3) + 8 * (i >> 2) + 4 * h; }
DI float wave_sum(float v) {
#pragma unroll
  for (int o = 32; o > 0; o >>= 1) v += xshfl_xor(v, o);
  return v;
}
DI float wave_max(float v) {
#pragma unroll
  for (int o = 32; o > 0; o >>= 1) v = fmaxf(v, xshfl_xor(v, o));
  return v;
}
DI float sigmoidf_(float x) { return __builtin_amdgcn_rcpf(1.f + __expf(-x)); }
DI float gelu_tanh(float x) {
  float u = 0.7978845608028654f * (x + 0.044715f * x * x * x);
  float t = 1.f - 2.f * __builtin_amdgcn_rcpf(1.f + __expf(2.f * u));
  return 0.5f * x * (1.f + t);
}
DI void unpack8(u32x4 v, float* f) {
  f[0] = __uint_as_float(v.x << 16); f[1] = __uint_as_float(v.x & 0xffff0000u);
  f[2] = __uint_as_float(v.y << 16); f[3] = __uint_as_float(v.y & 0xffff0000u);
  f[4] = __uint_as_float(v.z << 16); f[5] = __uint_as_float(v.z & 0xffff0000u);
  f[6] = __uint_as_float(v.w << 16); f[7] = __uint_as_float(v.w & 0xffff0000u);
}
DI u32x4 pack8(const float* f) {
  u32x4 v; v.x = pack2(f[0], f[1]); v.y = pack2(f[2], f[3]); v.z = pack2(f[4], f[5]); v.w = pack2(f[6], f[7]); return v;
}
DI void sincos_rev(float ang, float* s, float* c) {
  double rev = (double)ang * 0.15915494309189535; rev -= rint(rev);
  float rv = (float)rev;
  *s = __builtin_amdgcn_sinf(rv); *c = __builtin_amdgcn_cosf(rv);
}

constexpr int LDT = 72;
constexpr int TILE_ELEMS = 128 * LDT;
constexpr int SMEM_BYTES = 4 * TILE_ELEMS * 2 + 1024;
constexpr int SMEM_BLK = 2 * SMEM_BYTES;

template <int NI>
struct Stage { u32x4 a[4]; u32x4 b[2 * NI]; };

template <bool SUMSQ, int UNR = 4, int NI = 2>
DI void gemm_main(const bf16_t* __restrict__ A, int lda, int ksa, const bf16_t* __restrict__ Bt, int ldb, int ksb, int K, bf16_t* sm,
                  f32x16 (&acc)[2][NI], float* rowstat) {
  const int tid = get_tid(), lane = tid & 63, wave = tid >> 6;
  const int wm = wave >> 1, wn = wave & 1, r = lane & 31, h = lane >> 5;
  const int lrow = tid >> 3, lkc = (tid & 7) * 8;
  const bf16_t* ga = A + (size_t)lrow * lda + lkc;
  const bf16_t* gb = Bt + (size_t)lrow * ldb + lkc;
  bf16_t* sA = sm;
  bf16_t* sB = sm + 2 * TILE_ELEMS;
  const int nk = K >> 6;
  float ss[4] = {0.f, 0.f, 0.f, 0.f};
  u32x4 r0a[4], r0b[2 * NI], r1a[4], r1b[2 * NI];
#define G_LOAD(RA, RB, KT)                                                                          \
  {                                                                                                 \
    const size_t ka_ = (size_t)(KT) * ksa, kb_ = (size_t)(KT) * ksb;                                \
    _Pragma("unroll") for (int i = 0; i < 4; ++i) RA[i] = *(const u32x4*)(ga + (size_t)(32 * i) * lda + ka_);      \
    _Pragma("unroll") for (int i = 0; i < 2 * NI; ++i) RB[i] = *(const u32x4*)(gb + (size_t)(32 * i) * ldb + kb_); \
  }
#define G_STORE(RA, RB, BUF)                                                                        \
  {                                                                                                 \
    bf16_t* nA_ = sA + (BUF) * TILE_ELEMS; bf16_t* nB_ = sB + (BUF) * TILE_ELEMS;                   \
    _Pragma("unroll") for (int i = 0; i < 4; ++i) {                                                 \
      *(u32x4*)(nA_ + (lrow + 32 * i) * LDT + lkc) = RA[i];                                         \
      if (SUMSQ) { float f_[8]; unpack8(RA[i], f_);                                                 \
        _Pragma("unroll") for (int e = 0; e < 8; ++e) ss[i] += f_[e] * f_[e]; }                     \
    }                                                                                               \
    _Pragma("unroll") for (int i = 0; i < 2 * NI; ++i) *(u32x4*)(nB_ + (lrow + 32 * i) * LDT + lkc) = RB[i]; \
  }
#define G_COMPUTE(BUF)                                                                              \
  {                                                                                                 \
    const bf16_t* cA = sA + (BUF) * TILE_ELEMS + (wm * 64 + r) * LDT + h * 8;                       \
    const bf16_t* cB = sB + (BUF) * TILE_ELEMS + (wn * 32 * NI + r) * LDT + h * 8;                  \
    _Pragma("unroll") for (int ks = 0; ks < 4; ++ks) {                                              \
      bf16x8 a0 = *(const bf16x8*)(cA + ks * 16);                                                   \
      bf16x8 a1 = *(const bf16x8*)(cA + 32 * LDT + ks * 16);                                        \
      _Pragma("unroll") for (int ni = 0; ni < NI; ++ni) {                                           \
        bf16x8 b0 = *(const bf16x8*)(cB + ni * 32 * LDT + ks * 16);                                 \
        acc[0][ni] = MFMA32(a0, b0, acc[0][ni]);                                                    \
        acc[1][ni] = MFMA32(a1, b0, acc[1][ni]);                                                    \
      }                                                                                             \
    }                                                                                               \
  }
  G_LOAD(r0a, r0b, 0);
  G_LOAD(r1a, r1b, (nk > 1 ? 1 : 0));
  __syncthreads();
  G_STORE(r0a, r0b, 0);
  __syncthreads();
  for (int kt = 0; kt < nk; kt += 2) {
    G_LOAD(r0a, r0b, (kt + 2 < nk ? kt + 2 : nk - 1));
    __builtin_amdgcn_sched_barrier(0);
    G_COMPUTE(0);
    __builtin_amdgcn_sched_barrier(0);
    if (kt + 1 < nk) G_STORE(r1a, r1b, 1);
    __syncthreads();
    if (kt + 1 < nk) {
      G_LOAD(r1a, r1b, (kt + 3 < nk ? kt + 3 : nk - 1));
      __builtin_amdgcn_sched_barrier(0);
      G_COMPUTE(1);
      __builtin_amdgcn_sched_barrier(0);
      if (kt + 2 < nk) G_STORE(r0a, r0b, 0);
      __syncthreads();
    }
  }
#undef G_LOAD
#undef G_STORE
#undef G_COMPUTE
  if (SUMSQ) {
#pragma unroll
    for (int i = 0; i < 4; ++i) {
      float v = ss[i];
      v += xshfl_xor(v, 1); v += xshfl_xor(v, 2); v += xshfl_xor(v, 4);
      if ((tid & 7) == 0) rowstat[lrow + 32 * i] = rsqrtf(v / (float)K + 1e-6f);
    }
    __syncthreads();
  }
}

DI size_t tiled_off(int row, int col, int nk) {
  return ((size_t)((row >> 7) * nk + (col >> 6)) << 13) + ((row & 127) << 6) + (col & 63);
}
DI void zero_acc(f32x16 (&acc)[2][2]) {
#pragma unroll
  for (int a = 0; a < 2; ++a)
#pragma unroll
    for (int b = 0; b < 2; ++b)
#pragma unroll
      for (int i = 0; i < 16; ++i) acc[a][b][i] = 0.f;
}
DI void gemm256_main(const bf16_t* __restrict__ A, const bf16_t* __restrict__ Bt, int K, bf16_t* sm, f32x16 (&acc)[4][2]) {
  const int tid = get_tid512(), lane = tid & 63, wave = tid >> 6;
  const int wm = wave >> 2, wn = wave & 3, r = lane & 31, h = lane >> 5;
  const int lrow = tid >> 3, lkc = (tid & 7) * 8;
  const int nk = K >> 6;
  const bf16_t* ga = A + (size_t)lrow * 64 + lkc;
  const bf16_t* gb = Bt + (size_t)lrow * 64 + lkc;
  const size_t rts = (size_t)nk << 13;
  constexpr int TE = 256 * LDT;
  bf16_t* sA = sm;
  bf16_t* sB = sm + 2 * TE;
  u32x4 r0a[4], r0b[4], r1a[4], r1b[4];
#define H_LOAD(RA, RB, KT)                                                                                   \
  {                                                                                                          \
    const size_t ko_ = (size_t)(KT) << 13;                                                                   \
    _Pragma("unroll") for (int i = 0; i < 4; ++i) {                                                          \
      RA[i] = *(const u32x4*)(ga + (i >> 1) * rts + (i & 1) * 4096 + ko_);                                   \
      RB[i] = *(const u32x4*)(gb + (i >> 1) * rts + (i & 1) * 4096 + ko_);                                   \
    }                                                                                                        \
  }
#define H_STORE(RA, RB, BUF)                                                                                 \
  {                                                                                                          \
    _Pragma("unroll") for (int i = 0; i < 4; ++i) {                                                          \
      *(u32x4*)(sA + (BUF) * TE + (lrow + 64 * i) * LDT + lkc) = RA[i];                                      \
      *(u32x4*)(sB + (BUF) * TE + (lrow + 64 * i) * LDT + lkc) = RB[i];                                      \
    }                                                                                                        \
  }
#define H_COMPUTE(BUF, KS0, KS1)                                                                             \
  {                                                                                                          \
    const bf16_t* cA = sA + (BUF) * TE + (wm * 128 + r) * LDT + h * 8;                                       \
    const bf16_t* cB = sB + (BUF) * TE + (wn * 64 + r) * LDT + h * 8;                                        \
    _Pragma("unroll") for (int ks = KS0; ks < KS1; ++ks) {                                                   \
      bf16x8 b0 = *(const bf16x8*)(cB + ks * 16);                                                            \
      bf16x8 b1 = *(const bf16x8*)(cB + 32 * LDT + ks * 16);                                                 \
      _Pragma("unroll") for (int mi = 0; mi < 4; ++mi) {                                                     \
        bf16x8 a0 = *(const bf16x8*)(cA + mi * 32 * LDT + ks * 16);                                          \
        acc[mi][0] = MFMA32(a0, b0, acc[mi][0]);                                                             \
        acc[mi][1] = MFMA32(a0, b1, acc[mi][1]);                                                             \
      }                                                                                                      \
    }                                                                                                        \
  }
  H_LOAD(r0a, r0b, 0);
  H_LOAD(r1a, r1b, (nk > 1 ? 1 : 0));
  __syncthreads();
  H_STORE(r0a, r0b, 0);
  __syncthreads();
  for (int kt = 0; kt < nk; kt += 2) {
    H_LOAD(r0a, r0b, (kt + 2 < nk ? kt + 2 : nk - 1));
    __builtin_amdgcn_sched_barrier(0);
    H_COMPUTE(0, 0, 2);
    __builtin_amdgcn_sched_barrier(0);
    if (kt + 1 < nk) H_STORE(r1a, r1b, 1);
    __builtin_amdgcn_sched_barrier(0);
    H_COMPUTE(0, 2, 4);
    __syncthreads();
    if (kt + 1 < nk) {
      H_LOAD(r1a, r1b, (kt + 3 < nk ? kt + 3 : nk - 1));
      __builtin_amdgcn_sched_barrier(0);
      H_COMPUTE(1, 0, 2);
      __builtin_amdgcn_sched_barrier(0);
      if (kt + 2 < nk) H_STORE(r0a, r0b, 0);
      __builtin_amdgcn_sched_barrier(0);
      H_COMPUTE(1, 2, 4);
      __syncthreads();
    }
  }
#undef H_LOAD
#undef H_STORE
#undef H_COMPUTE
}
DI void zero_acc42(f32x16 (&acc)[4][2]) {
#pragma unroll
  for (int a = 0; a < 4; ++a)
#pragma unroll
    for (int b = 0; b < 2; ++b)
#pragma unroll
      for (int i = 0; i < 16; ++i) acc[a][b][i] = 0.f;
}
struct TileIter256 {
  int x, i, step, ntn, total, tmw_l2, ngm_l2, tnw;
  DI TileIter256(int ntn_, int tnw_l2) {
    const int b = get_bid_real(), nb = get_nb_real();
    x = b & 7; i = b >> 3; step = nb >> 3; ntn = ntn_;
    tnw = 1 << tnw_l2; tmw_l2 = 5 - tnw_l2; ngm_l2 = 4 - tmw_l2;
    total = (32 << ngm_l2) * (ntn_ >> tnw_l2);
  }
  DI bool next(int& tm, int& tn) {
    if (i >= total) return false;
    const int sup = i >> 5, within = i & 31;
    tm = x * 16 + ((sup & ((1 << ngm_l2) - 1)) << tmw_l2) + (within & ((1 << tmw_l2) - 1));
    tn = (sup >> ngm_l2) * tnw + (within >> tmw_l2);
    i += step;
    return true;
  }
};

DI void tile_map(int t, int ntn, int& tm, int& tn) {
  int per = 8 * ntn; int g = t / per; int rem = t - g * per;
  tm = g * 8 + (rem & 7); tn = rem >> 3;
}
struct TileIter {
  int x, i, step, ntn, total;
  DI TileIter(int ntn_) {
    const int b = get_bid(), nb = get_nb();
    x = b & 7; i = b >> 3; step = nb >> 3; ntn = ntn_;
    total = 32 * ((ntn_ + 7) & ~7);
  }
  DI bool next(int& tm, int& tn) {
    while (i < total) {
      const int blk = i >> 6, within = i & 63;
      tm = x * 32 + (blk & 3) * 8 + (within & 7);
      tn = (blk >> 2) * 8 + (within >> 3);
      i += step;
      if (tn < ntn) return true;
    }
    return false;
  }
};

DI void phase_init(const Params& p, char* WS, char* smem) {
  const int tid = get_tid(), lane = tid & 63, wave = tid >> 6;
  const size_t gtid = (size_t)get_bid() * NTHREADS + tid, gsz = (size_t)get_nb() * NTHREADS;
  const float4* src = (const float4*)p.x; float4* dst = (float4*)p.xo;
  for (size_t i = gtid; i < (size_t)T * D / 4; i += gsz) dst[i] = src[i];
  float* rope = (float*)(WS + OFF_ROPE);
  for (size_t i = gtid; i < (size_t)T * 28; i += gsz) {
    int t = (int)(i / 28), j = (int)(i % 28);
    float ex; int co, so;
    if (j < 16) { ex = (float)(2 * j) / 32.f; co = j; so = 16 + j; }
    else if (j < 24) { ex = (float)(2 * (j - 16)) / 16.f; co = 32 + j - 16; so = 40 + j - 16; }
    else { ex = (float)(2 * (j - 24)) / 8.f; co = 48 + j - 24; so = 52 + j - 24; }
    float inv = exp2f(-ex * 18.931568569324174f);
    float ang = (float)p.pos[t] * inv;
    float s, c; sincos_rev(ang, &s, &c);
    rope[(size_t)t * 56 + co] = c; rope[(size_t)t * 56 + so] = s;
  }
  float* cact = (float*)smem;
  float* part = (float*)(smem + 16384);
  float* mod = (float*)(WS + OFF_MOD);
  for (int it = get_bid(); it < NL * 144; it += get_nb()) {
    const int l = it / 144, c0 = (it % 144) * 64;
    float acc[16];
#pragma unroll
    for (int b = 0; b < 16; ++b) acc[b] = 0.f;
    for (int kc = 0; kc < 4; ++kc) {
      __syncthreads();
      for (int e = tid; e < 4096; e += NTHREADS) {
        int kk = e >> 4, b = e & 15; float cv = p.c[b * 1024 + kc * 256 + kk];
        cact[e] = cv / (1.f + __expf(-cv));
      }
      __syncthreads();
      const float* wp = p.ada_w + ((size_t)l * 1024 + kc * 256 + wave * 64) * 9216 + c0 + lane;
#pragma unroll 8
      for (int kk = 0; kk < 64; ++kk) {
        float w = wp[(size_t)kk * 9216];
        const float4* cv = (const float4*)(cact + (wave * 64 + kk) * 16);
        float4 c0v = cv[0], c1v = cv[1], c2v = cv[2], c3v = cv[3];
        acc[0] += c0v.x * w; acc[1] += c0v.y * w; acc[2] += c0v.z * w; acc[3] += c0v.w * w;
        acc[4] += c1v.x * w; acc[5] += c1v.y * w; acc[6] += c1v.z * w; acc[7] += c1v.w * w;
        acc[8] += c2v.x * w; acc[9] += c2v.y * w; acc[10] += c2v.z * w; acc[11] += c2v.w * w;
        acc[12] += c3v.x * w; acc[13] += c3v.y * w; acc[14] += c3v.z * w; acc[15] += c3v.w * w;
      }
    }
    __syncthreads();
#pragma unroll
    for (int b = 0; b < 16; ++b) part[(wave * 16 + b) * 64 + lane] = acc[b];
    __syncthreads();
    for (int e = tid; e < 1024; e += NTHREADS) {
      int b = e >> 6, cl = e & 63;
      float s = part[(0 * 16 + b) * 64 + cl] + part[(1 * 16 + b) * 64 + cl] + part[(2 * 16 + b) * 64 + cl] +
                part[(3 * 16 + b) * 64 + cl] + p.ada_b[l * 9216 + c0 + cl];
      mod[((size_t)l * 16 + b) * 9216 + c0 + cl] = s;
    }
  }
}

DI void conv_tile(const float* __restrict__ src, int lds_, int jmax, bf16_t* __restrict__ dst, int ldd,
                          const float* __restrict__ scale, float* tile) {
  const int tid = get_tid();
  __syncthreads();
  {
    const int j = tid & 31, kb = tid >> 5;
#pragma unroll
    for (int i = 0; i < 8; ++i) {
      int kk = kb + 8 * i;
      float v = (j < jmax) ? src[(size_t)kk * lds_ + j] : 0.f;
      if (scale) v *= scale[kk];
      tile[kk * 33 + j] = v;
    }
  }
  __syncthreads();
  {
    const int j = tid >> 3, kq = (tid & 7) * 8;
    float f[8];
#pragma unroll
    for (int e = 0; e < 8; ++e) f[e] = tile[(kq + e) * 33 + j];
    *(u32x4*)(dst + (size_t)j * ldd + kq) = pack8(f);
  }
}

DI void phase_convert(const Params& p, char* WS, int l, char* smem) {
  float* tile = (float*)smem;
  char* ws = WS;
  constexpr int J0 = 2816, J1 = 2816, J2 = 1408, J3 = 1408, J4 = 3520, J5 = 1024, J6 = 512, J7 = 96, J8 = 64, J9 = 32, J10 = 128, J11 = 8;
  constexpr int E0 = J0, E1 = E0 + J1, E2 = E1 + J2, E3 = E2 + J3, E4 = E3 + J4, E5 = E4 + J5, E6 = E5 + J6, E7 = E6 + J7,
                E8 = E7 + J8, E9 = E8 + J9, E10 = E9 + J10, E11 = E10 + J11;
  for (int it = get_bid(); it < E11; it += get_nb()) {
    if (it < E1) {
      int a = it >= E0; int t = it - (a ? E0 : 0);
      int G = t >> 4, kt = t & 15; int grp = G >> 1, which = G & 1;
      const float* w = (which ? p.ffn_w3 : p.ffn_w1) + ((size_t)(l * 2 + a) * 1024 + kt * 64) * DFF + grp * 32;
      bf16_t* d = (bf16_t*)(ws + OFF_WUP) + (size_t)a * 5632 * 1024 + tiled_off(G * 32, kt * 64, 16);
      conv_tile(w, DFF, 32, d, 64, nullptr, tile);
    } else if (it < E3) {
      int a = it >= E2; int t = it - (a ? E2 : E1);
      int G = t / 44, kt = t % 44;
      const float* w = p.ffn_w2 + ((size_t)(l * 2 + a) * DFF + kt * 64) * 1024 + G * 32;
      bf16_t* d = (bf16_t*)(ws + OFF_WDN) + (size_t)a * 1024 * DFF + tiled_off(G * 32, kt * 64, 44);
      conv_tile(w, 1024, 32, d, 64, nullptr, tile);
    } else if (it < E4) {
      int t = it - E3; int G = t >> 4, kt = t & 15;
      const int scol = (G < 92) ? G * 32 : Z_GATES + (G - 92) * 32;
      const float* w = p.w_in + ((size_t)l * 1024 + kt * 64) * DIN + scol;
      bf16_t* d = (G < 92) ? (bf16_t*)(ws + OFF_WIN) + tiled_off(G * 32, kt * 64, 16)
                           : (bf16_t*)(ws + OFF_WIN) + (size_t)2944 * 1024 + tiled_off((G - 92) * 32, kt * 64, 16);
      conv_tile(w, DIN, 32, d, 64, nullptr, tile);
    } else if (it < E5) {
      int t = it - E4; int n = t >> 8; int rem = t & 255; int G = rem >> 3, kt = rem & 7;
      const float* w = p.w_branch + ((size_t)(l * 4 + n) * 512 + kt * 64) * 1024 + G * 32;
      bf16_t* d = (bf16_t*)(ws + OFF_WBR) + (size_t)n * 1024 * 512 + tiled_off(G * 32, kt * 64, 8);
      conv_tile(w, 1024, 32, d, 64, nullptr, tile);
    } else if (it < E6) {
      int t = it - E5; int G = t >> 4, kt = t & 15;
      const float* w = p.w_out + ((size_t)l * 1024 + kt * 64) * 1024 + G * 32;
      bf16_t* d = (bf16_t*)(ws + OFF_WOUT) + tiled_off(G * 32, kt * 64, 16);
      conv_tile(w, 1024, 32, d, 64, nullptr, tile);
    } else if (it < E7) {
      int t = it - E6; int G = t >> 2, kt = t & 3;
      const float* w = p.mla_w_uq + ((size_t)l * 256 + kt * 64) * 768 + G * 32;
      bf16_t* d = (bf16_t*)(ws + OFF_WUQ) + tiled_off(G * 32, kt * 64, 4);
      conv_tile(w, 768, 32, d, 64, p.mla_q_norm + l * 256 + kt * 64, tile);
    } else if (it < E8) {
      int t = it - E7; int G = t >> 1, kt = t & 1;
      const float* w = p.mla_w_ukv + ((size_t)l * 128 + kt * 64) * 1024 + G * 32;
      bf16_t* d = (bf16_t*)(ws + OFF_WUKV) + tiled_off(G * 32, kt * 64, 2);
      conv_tile(w, 1024, 32, d, 64, p.mla_kv_norm + l * 128 + kt * 64, tile);
    } else if (it < E9) {
      int t = it - E8; int hd = t >> 2, G = t & 3; int half = G >> 1, which = G & 1;
      const float* w = (which ? p.rg_wx : p.rg_wa) + ((size_t)(l * 8 + hd) * 64) * 64 + half * 32;
      bf16_t* d = (bf16_t*)(ws + OFF_WRG) + ((size_t)hd * 128 + G * 32) * 64;
      conv_tile(w, 64, 32, d, 64, nullptr, tile);
    } else if (it < E10) {
      int t = it - E9; int G = t >> 3, kt = t & 7;
      const float* w = p.s5_wglu + ((size_t)l * 512 + kt * 64) * 512 + G * 32;
      bf16_t* d = (bf16_t*)(ws + OFF_WGLU) + tiled_off(G * 32, kt * 64, 8);
      conv_tile(w, 512, 32, d, 64, nullptr, tile);
    } else {
      int idx = (it - E10) * 256 + get_tid();
      int g = idx >> 6, pst = idx & 63;
      float lr = p.s5_lre[(l * 32 + g) * 64 + pst], li = p.s5_lim[(l * 32 + g) * 64 + pst];
      float dt = expf(p.s5_logdt[l * 32 + g]);
      float mag = expf(lr * dt);
      float sn, cs; sincos_rev(li * dt, &sn, &cs);
      float abr = mag * cs, abi = mag * sn;
      float den = lr * lr + li * li;
      float nr = abr - 1.f, ni = abi;
      float fr = (nr * lr + ni * li) / den, fi = (ni * lr - nr * li) / den;
      float pr = abr, pi = abi;
#pragma unroll
      for (int q = 0; q < 6; ++q) { float tr = pr * pr - pi * pi, ti = pr * pi; ti = ti + ti; pr = tr; pi = ti; }
      float* ab = (float*)(ws + OFF_S5AB) + (size_t)idx * 4;
      ab[0] = abr; ab[1] = abi; ab[2] = pr; ab[3] = pi;
      const float* br = p.s5_bre + ((size_t)(l * 32 + g) * 64 + pst) * 16;
      const float* bi = p.s5_bim + ((size_t)(l * 32 + g) * 64 + pst) * 16;
      bf16_t* bb = (bf16_t*)(ws + OFF_S5BB) + (size_t)g * 128 * 16;
#pragma unroll
      for (int j = 0; j < 16; ++j) {
        float r_ = br[j], i_ = bi[j];
        bb[(pst) * 16 + j] = f2bf(fr * r_ - fi * i_);
        bb[(64 + pst) * 16 + j] = f2bf(fr * i_ + fi * r_);
      }
      bf16_t* ct = (bf16_t*)(ws + OFF_S5CT) + (size_t)g * 16 * 128;
#pragma unroll
      for (int j = 0; j < 16; ++j) {
        ct[j * 128 + pst] = f2bf(p.s5_cre[((size_t)(l * 32 + g) * 16 + j) * 64 + pst]);
        ct[j * 128 + 64 + pst] = f2bf(-p.s5_cim[((size_t)(l * 32 + g) * 16 + j) * 64 + pst]);
      }
    }
  }
}

DI void phase_norm(const Params& p, char* WS, int l, int which) {
  const int tid = get_tid(), lane = tid & 63, wave = tid >> 6;
  const float* g = p.norm_g + (l * 3 + which) * 1024;
  const float* mod = (const float*)(WS + OFF_MOD) + (size_t)l * 16 * 9216;
  bf16_t* U = (bf16_t*)(WS + OFF_U);
  const float* xo = p.xo;
  for (int row0 = (get_bid() * 4 + wave) * 4; row0 < T; row0 += get_nb() * 16) {
    float4 v[4][4]; float ss[4];
#pragma unroll
    for (int q = 0; q < 4; ++q) {
      const float4* xr = (const float4*)(xo + (size_t)(row0 + q) * 1024);
#pragma unroll
      for (int i = 0; i < 4; ++i) v[q][i] = xr[lane + 64 * i];
    }
#pragma unroll
    for (int q = 0; q < 4; ++q) {
      float a = 0.f;
#pragma unroll
      for (int i = 0; i < 4; ++i) a += v[q][i].x * v[q][i].x + v[q][i].y * v[q][i].y + v[q][i].z * v[q][i].z + v[q][i].w * v[q][i].w;
      ss[q] = a;
    }
#pragma unroll
    for (int o = 32; o > 0; o >>= 1) {
#pragma unroll
      for (int q = 0; q < 4; ++q) ss[q] += xshfl_xor(ss[q], o);
    }
    const int b = row0 >> 11;
    const float* sh = mod + (size_t)b * 9216 + (3 * which) * 1024;
    const float* sc = sh + 1024;
#pragma unroll
    for (int i = 0; i < 4; ++i) {
      const int c = (lane + 64 * i) * 4;
      float4 gg = *(const float4*)(g + c), s4 = *(const float4*)(sh + c), c4 = *(const float4*)(sc + c);
      const float m0 = gg.x * (1.f + c4.x), m1 = gg.y * (1.f + c4.y), m2 = gg.z * (1.f + c4.z), m3 = gg.w * (1.f + c4.w);
#pragma unroll
      for (int q = 0; q < 4; ++q) {
        const float rstd = rsqrtf(ss[q] * (1.f / 1024.f) + 1e-6f);
        u32x2 o;
        o.x = pack2(v[q][i].x * rstd * m0 + s4.x, v[q][i].y * rstd * m1 + s4.y);
        o.y = pack2(v[q][i].z * rstd * m2 + s4.z, v[q][i].w * rstd * m3 + s4.w);
        *(u32x2*)(U + tiled_off(row0 + q, c, 16)) = o;
      }
    }
  }
}

DI void phase_ffn_up(const Params& p, char* WS, int a, char* smem) {
  const int tid = get_tid512(), lane = tid & 63, wave = tid >> 6, wm = wave >> 2, wn = wave & 3, r = lane & 31, h = lane >> 5;
  const bf16_t* U = (const bf16_t*)(WS + OFF_U);
  const bf16_t* W = (const bf16_t*)(WS + OFF_WUP) + (size_t)a * 5632 * 1024;
  bf16_t* H = (bf16_t*)(WS + OFF_HZ);
  TileIter256 ti(22, 1);
  for (int tm, tn; ti.next(tm, tn);) {
    f32x16 acc[4][2]; zero_acc42(acc);
    gemm256_main(U + ((size_t)tm * 2 * 16 << 13), W + ((size_t)tn * 2 * 16 << 13), 1024, (bf16_t*)smem, acc);
    {
      constexpr int SLD = 128 + 8;
      bf16_t* st = (bf16_t*)smem;
#pragma unroll
      for (int mi = 0; mi < 4; ++mi)
#pragma unroll
        for (int i = 0; i < 16; ++i) {
          float v1 = acc[mi][0][i], v3 = acc[mi][1][i];
          st[(wm * 128 + mi * 32 + crow(i, h)) * SLD + wn * 32 + r] = f2bf(v1 * sigmoidf_(v1) * v3);
        }
      __syncthreads();
#pragma unroll
      for (int q = 0; q < 8; ++q) {
        const int c = get_tid512() + 512 * q;
        const int row = c >> 4, cc = (c & 15) * 8;
        u32x4 v = *(const u32x4*)(st + row * SLD + cc);
        *(u32x4*)(H + tiled_off(tm * 256 + row, tn * 128 + cc, 44)) = v;
      }
    }
  }
}

DI void phase_gemm_resid(const Params& p, char* WS, const bf16_t* A, const bf16_t* Bt, int K, const float* gmod,
                         float coef, char* smem) {
  const int tid = get_tid512(), lane = tid & 63, wave = tid >> 6, wm = wave >> 2, wn = wave & 3, r = lane & 31, h = lane >> 5;
  float* xo = p.xo;
  TileIter256 ti(4, 2);
  for (int tm, tn; ti.next(tm, tn);) {
    f32x16 acc[4][2]; zero_acc42(acc);
    gemm256_main(A + ((size_t)tm * 2 * (K >> 6) << 13), Bt + ((size_t)tn * 2 * (K >> 6) << 13), K, (bf16_t*)smem, acc);
    const int b = (tm * 256) >> 11;
    {
      constexpr int SLD = 128 + 4;
      float* st = (float*)smem;
#pragma unroll
      for (int ni = 0; ni < 2; ++ni) {
        const int col = tn * 256 + wn * 64 + ni * 32 + r;
        const float gs = coef * (1.f + gmod[(size_t)b * 9216 + col]);
#pragma unroll
        for (int mi = 0; mi < 4; ++mi)
#pragma unroll
          for (int i = 0; i < 16; ++i) st[(wm * 128 + mi * 32 + crow(i, h)) * SLD + wn * 32 + r] = gs * acc[mi][ni][i];
        __syncthreads();
#pragma unroll 4
        for (int q = 0; q < 16; ++q) {
          const int c = get_tid512() + 512 * q;
          const int row = c >> 5, c4 = (c & 31) * 4;
          const int gcol = tn * 256 + (c4 >> 5) * 64 + ni * 32 + (c4 & 31);
          const float4 v = *(const float4*)(st + row * SLD + c4);
          float4* xp = (float4*)(xo + (size_t)(tm * 256 + row) * 1024 + gcol);
          float4 xv = *xp;
          xv.x += v.x; xv.y += v.y; xv.z += v.z; xv.w += v.w;
          *xp = xv;
        }
        __syncthreads();
      }
    }
  }
}

DI void phase_inproj(const Params& p, char* WS, char* smem) {
  const int tid = get_tid512(), lane = tid & 63, wave = tid >> 6, wm = wave >> 2, wn = wave & 3, r = lane & 31, h = lane >> 5;
  const bf16_t* U = (const bf16_t*)(WS + OFF_U);
  const bf16_t* W = (const bf16_t*)(WS + OFF_WIN);
  bf16_t* Z = (bf16_t*)(WS + OFF_HZ);
  TileIter256 ti(12, 2);
  for (int tm, tn; ti.next(tm, tn);) {
    f32x16 acc[4][2]; zero_acc42(acc);
    gemm256_main(U + ((size_t)tm * 2 * 16 << 13), W + ((size_t)tn * 2 * 16 << 13), 1024, (bf16_t*)smem, acc);
    {
      constexpr int SLD = 256 + 8;
      bf16_t* st = (bf16_t*)smem;
#pragma unroll
      for (int ni = 0; ni < 2; ++ni)
#pragma unroll
        for (int mi = 0; mi < 4; ++mi)
#pragma unroll
          for (int i = 0; i < 16; ++i)
            st[(wm * 128 + mi * 32 + crow(i, h)) * SLD + wn * 64 + ni * 32 + r] = f2bf(acc[mi][ni][i]);
      __syncthreads();
#pragma unroll
      for (int q = 0; q < 16; ++q) {
        const int c = get_tid512() + 512 * q;
        const int row = c >> 5, cc = (c & 31) * 8;
        if (tn * 256 + cc < ZW) {
          u32x4 v = *(const u32x4*)(st + row * SLD + cc);
          *(u32x4*)(Z + (size_t)(tm * 256 + row) * ZW + tn * 256 + cc) = v;
        }
      }
    }
  }
}

DI void phase_merge(const Params& p, char* WS, char* smem) {
  const int tid = get_tid(), lane = tid & 63, wave = tid >> 6, wm = wave >> 1, wn = wave & 1, r = lane & 31, h = lane >> 5;
  const bf16_t* U = (const bf16_t*)(WS + OFF_U);
  const bf16_t* WG = (const bf16_t*)(WS + OFF_WIN) + (size_t)2944 * 1024;
  const bf16_t* WB = (const bf16_t*)(WS + OFF_WBR);
  bf16_t* M = (bf16_t*)(WS + OFF_MERGED);
  TileIter ti(16);
  for (int tm, tn; ti.next(tm, tn);) {
    f32x16 am[2][1];
#pragma unroll
    for (int i = 0; i < 16; ++i) { am[0][0][i] = 0.f; am[1][0][i] = 0.f; }
#pragma unroll 1
    for (int n = 0; n < 4; ++n) {
      const size_t yoff = (n == 0) ? OFF_YA : (n == 1) ? OFF_YB : (n == 2) ? OFF_YC : OFF_YD;
      const bf16_t* Y = (const bf16_t*)(WS + yoff);
      f32x16 ag[2][1], ab[2][1];
#pragma unroll
      for (int i = 0; i < 16; ++i) { ag[0][0][i] = 0.f; ag[1][0][i] = 0.f; ab[0][0][i] = 0.f; ab[1][0][i] = 0.f; }
      gemm_main<false, 4, 1>(U + ((size_t)tm * 16 << 13), 64, 8192,
                             WG + ((size_t)((n * 1024 + tn * 64) >> 7) * 16 << 13) + (tn & 1) * 64 * 64, 64, 8192, 1024,
                             (bf16_t*)smem, ag, nullptr);
      gemm_main<false, 4, 1>(Y + (size_t)tm * 128 * 512, 512, 64, WB + (size_t)n * 1024 * 512 + ((size_t)(tn >> 1) * 8 << 13) + (tn & 1) * 64 * 64, 64, 8192, 512, (bf16_t*)smem, ab, nullptr);
#pragma unroll
      for (int x = 0; x < 2; ++x)
#pragma unroll
        for (int i = 0; i < 16; ++i) am[x][0][i] += sigmoidf_(ag[x][0][i]) * ab[x][0][i];
    }
    {
      constexpr int SLD = 64 + 8;
      bf16_t* st = (bf16_t*)smem;
#pragma unroll
      for (int mi = 0; mi < 2; ++mi)
#pragma unroll
        for (int i = 0; i < 16; ++i) st[(wm * 64 + mi * 32 + crow(i, h)) * SLD + wn * 32 + r] = f2bf(am[mi][0][i]);
      __syncthreads();
#pragma unroll
      for (int q = 0; q < 4; ++q) {
        const int c = get_tid() + 256 * q;
        const int row = c >> 3, cc = (c & 7) * 8;
        u32x4 v = *(const u32x4*)(st + row * SLD + cc);
        *(u32x4*)(M + tiled_off(tm * 128 + row, tn * 64 + cc, 16)) = v;
      }
    }
  }
}

template <bool PASS2>
DI void s5_item(const Params& p, char* WS, int l, int item, char* smem) {
  const int tid = get_tid(), lane = tid & 63, wave = tid >> 6, r = lane & 31, h = lane >> 5;
  const int b = item >> 5, ck = item & 31;
  const int t0 = b * SEQ + ck * 64;
  const bf16_t* Z = (const bf16_t*)(WS + OFF_HZ);
  const float* AB = (const float*)(WS + OFF_S5AB);
  const bf16_t* BB = (const bf16_t*)(WS + OFF_S5BB);
  const bf16_t* CT = (const bf16_t*)(WS + OFF_S5CT);
  float* ENDS = (float*)(WS + OFF_ENDS);
  bf16_t* YS = (bf16_t*)(WS + OFF_YS5);
  constexpr int XLD = 136;
  bf16_t* img = (bf16_t*)smem + (size_t)wave * 64 * XLD;
  const int tokA = 32 * ((r >> 2) & 1) + (r & 3) + 4 * (r >> 3);
  for (int gi = 0; gi < 8; ++gi) {
    const int g = wave * 8 + gi;
    bf16x8 af[2];
#pragma unroll
    for (int m = 0; m < 2; ++m) af[m] = *(const bf16x8*)(Z + (size_t)(t0 + tokA + 16 * m) * ZW + Z_US5 + g * 16 + 8 * h);
    if (PASS2) __syncthreads();
#pragma unroll 1
    for (int sb = 0; sb < 2; ++sb) {
      const int st = sb * 32 + r;
      const float4 abv = *(const float4*)(AB + (size_t)(g * 64 + st) * 4);
      const float ar = abv.x, ai = abv.y;
      bf16x8 bfr = *(const bf16x8*)(BB + ((size_t)g * 128 + st) * 16 + 8 * h);
      bf16x8 bfi = *(const bf16x8*)(BB + ((size_t)g * 128 + 64 + st) * 16 + 8 * h);
      f32x16 zr;
#pragma unroll
      for (int i = 0; i < 16; ++i) zr[i] = 0.f;
      f32x16 bur0 = MFMA32(af[0], bfr, zr), bur1 = MFMA32(af[1], bfr, zr);
      f32x16 bui0 = MFMA32(af[0], bfi, zr), bui1 = MFMA32(af[1], bfi, zr);
      float cr = 0.f, ci = 0.f;
      if (PASS2) {
        const float a64r = abv.z, a64i = abv.w;
        const float* e0 = ENDS + (((size_t)(b * 32) * 32 + g) * 128) + st;
        int c2 = 0;
        for (; c2 + 2 <= ck; c2 += 2) {
          float er[2], ei[2];
#pragma unroll
          for (int q = 0; q < 2; ++q) { er[q] = e0[(size_t)(c2 + q) * 4096]; ei[q] = e0[(size_t)(c2 + q) * 4096 + 64]; }
#pragma unroll
          for (int q = 0; q < 2; ++q) {
            float nr = a64r * cr - a64i * ci + er[q], ni = a64r * ci + a64i * cr + ei[q];
            cr = nr; ci = ni;
          }
        }
        for (; c2 < ck; ++c2) {
          float er = e0[(size_t)c2 * 4096], ei = e0[(size_t)c2 * 4096 + 64];
          float nr = a64r * cr - a64i * ci + er, ni = a64r * ci + a64i * cr + ei;
          cr = nr; ci = ni;
        }
      }
      float xr = cr, xi = ci;
#pragma unroll
      for (int i = 0; i < 16; ++i) { float nr = ar * xr - ai * xi + bur0[i], ni = ar * xi + ai * xr + bui0[i]; xr = nr; xi = ni; }
#pragma unroll
      for (int i = 0; i < 16; ++i) { float nr = ar * xr - ai * xi + bur1[i], ni = ar * xi + ai * xr + bui1[i]; xr = nr; xi = ni; }
      float er0 = xshfl(xr, r), ei0 = xshfl(xi, r);
      xr = h ? er0 : cr; xi = h ? ei0 : ci;
#pragma unroll
      for (int i = 0; i < 16; ++i) {
        float nr = ar * xr - ai * xi + bur0[i], ni = ar * xi + ai * xr + bui0[i]; xr = nr; xi = ni;
        if (PASS2) { int tk = 32 * h + i; img[tk * XLD + st] = f2bf(xr); img[tk * XLD + 64 + st] = f2bf(xi); }
      }
#pragma unroll
      for (int i = 0; i < 16; ++i) {
        float nr = ar * xr - ai * xi + bur1[i], ni = ar * xi + ai * xr + bui1[i]; xr = nr; xi = ni;
        if (PASS2) { int tk = 32 * h + 16 + i; img[tk * XLD + st] = f2bf(xr); img[tk * XLD + 64 + st] = f2bf(xi); }
      }
      if (!PASS2) {
        if (h) { float* e = ENDS + (((size_t)(b * 32 + ck) * 32 + g) * 128); e[st] = xr; e[64 + st] = xi; }
      }
    }
    if (PASS2) {
      __syncthreads();
      f32x16 y0, y1;
#pragma unroll
      for (int i = 0; i < 16; ++i) { y0[i] = 0.f; y1[i] = 0.f; }
#pragma unroll
      for (int s = 0; s < 8; ++s) {
        bf16x8 cf;
        if (r < 16) cf = *(const bf16x8*)(CT + ((size_t)g * 16 + r) * 128 + 16 * s + 8 * h);
        else {
#pragma unroll
          for (int j = 0; j < 8; ++j) cf[j] = 0;
        }
        bf16x8 a0 = *(const bf16x8*)(img + (r)*XLD + 16 * s + 8 * h);
        bf16x8 a1 = *(const bf16x8*)(img + (32 + r) * XLD + 16 * s + 8 * h);
        y0 = MFMA32(a0, cf, y0); y1 = MFMA32(a1, cf, y1);
      }
      if (r < 16) {
        const int ch = g * 16 + r;
        const float dd = p.s5_d[l * 512 + ch];
#pragma unroll
        for (int i = 0; i < 16; ++i) {
          int tk = crow(i, h);
          float u0 = bf2f(Z[(size_t)(t0 + tk) * ZW + Z_US5 + ch]);
          float u1 = bf2f(Z[(size_t)(t0 + 32 + tk) * ZW + Z_US5 + ch]);
          YS[(size_t)(t0 + tk) * 512 + ch] = f2bf(gelu_tanh(y0[i] + dd * u0));
          YS[(size_t)(t0 + 32 + tk) * 512 + ch] = f2bf(gelu_tanh(y1[i] + dd * u1));
        }
      }
    }
  }
}

DI void dsa_prep_qk(const Params& p, char* WS, int l, int bitem) {
  const int idx = bitem * NTHREADS + get_tid();
  if (idx >= T * 9) return;
  const int t = idx / 9, role = idx % 9;
  bf16_t* Z = (bf16_t*)(WS + OFF_HZ);
  const float* rope = (const float*)(WS + OFF_ROPE) + (size_t)t * 56;
  bf16_t* src = Z + (size_t)t * ZW + (role < 8 ? Z_QDSA + role * 64 : Z_KDSA);
  bf16_t* dst = (role < 8) ? src : (bf16_t*)(WS + OFF_KD) + (size_t)t * 64;
  const float* gain = p.dsa_qk_gain + (l * 2 + (role < 8 ? 0 : 1)) * 64;
  float v[64];
#pragma unroll
  for (int q = 0; q < 8; ++q) unpack8(*(const u32x4*)(src + q * 8), v + q * 8);
  float ss = 0.f;
#pragma unroll
  for (int j = 0; j < 64; ++j) ss += v[j] * v[j];
  const float rs = rsqrtf(ss * (1.f / 64.f) + 1e-6f);
#pragma unroll
  for (int j = 0; j < 64; ++j) v[j] = v[j] * rs * gain[j];
#pragma unroll
  for (int i = 0; i < 8; ++i) {
    float c = rope[32 + i], s = rope[40 + i];
    float x1 = v[i], x2 = v[8 + i];
    v[i] = x1 * c - x2 * s; v[8 + i] = x2 * c + x1 * s;
  }
#pragma unroll
  for (int q = 0; q < 8; ++q) *(u32x4*)(dst + q * 8) = pack8(v + q * 8);
}
DI void dsa_prep_idx(const Params& p, char* WS, int bitem) {
  const int idx = bitem * NTHREADS + get_tid();
  if (idx >= T * 9) return;
  const int t = idx / 9, role = idx % 9;
  bf16_t* Z = (bf16_t*)(WS + OFF_HZ);
  const float* rope = (const float*)(WS + OFF_ROPE) + (size_t)t * 56;
  bf16_t* src = Z + (size_t)t * ZW + (role < 8 ? Z_QIDX + role * 32 : Z_KIDX);
  bf16_t* dst = (role < 8) ? src : (bf16_t*)(WS + OFF_KI) + (size_t)t * 32;
  float v[32];
#pragma unroll
  for (int q = 0; q < 4; ++q) unpack8(*(const u32x4*)(src + q * 8), v + q * 8);
#pragma unroll
  for (int i = 0; i < 4; ++i) {
    float c = rope[48 + i], s = rope[52 + i];
    float x1 = v[i], x2 = v[4 + i];
    v[i] = x1 * c - x2 * s; v[4 + i] = x2 * c + x1 * s;
  }
#pragma unroll
  for (int q = 0; q < 4; ++q) *(u32x4*)(dst + q * 8) = pack8(v + q * 8);
}
DI void dsa_prep_vt(const Params& p, char* WS, int item, char* smem) {
  const int tid = get_tid();
  const int b = item >> 5, ck = item & 31;
  const bf16_t* Z = (const bf16_t*)(WS + OFF_HZ);
  bf16_t* VTD = (bf16_t*)(WS + OFF_VTD);
  bf16_t* tile = (bf16_t*)smem;
  __syncthreads();
  {
    const int tt = tid >> 2, dq = (tid & 3) * 16;
    const bf16_t* s = Z + (size_t)(b * SEQ + ck * 64 + tt) * ZW + Z_VDSA + dq;
    u32x4 a = *(const u32x4*)s, c = *(const u32x4*)(s + 8);
    uint32_t w[8] = {a.x, a.y, a.z, a.w, c.x, c.y, c.z, c.w};
#pragma unroll
    for (int e = 0; e < 8; ++e) *(uint32_t*)(tile + tt * 66 + dq + 2 * e) = w[e];
  }
  __syncthreads();
  {
    const int d = tid >> 2, tq = (tid & 3) * 16;
    uint32_t w[8];
#pragma unroll
    for (int e = 0; e < 8; ++e) w[e] = (uint32_t)tile[(tq + 2 * e) * 66 + d] | ((uint32_t)tile[(tq + 2 * e + 1) * 66 + d] << 16);
    bf16_t* o = VTD + ((size_t)b * 64 + d) * SEQ + ck * 64 + tq;
    *(u32x4*)o = u32x4{w[0], w[1], w[2], w[3]};
    *(u32x4*)(o + 8) = u32x4{w[4], w[5], w[6], w[7]};
  }
}

DI void rg_conv(const Params& p, char* WS, int l, int bitem) {
  const int idx = bitem * NTHREADS + get_tid();
  const int t = idx >> 6, c0 = (idx & 63) * 8;
  const int tl = t & (SEQ - 1);
  const bf16_t* Z = (const bf16_t*)(WS + OFF_HZ);
  float acc[8];
#pragma unroll
  for (int e = 0; e < 8; ++e) acc[e] = p.conv_b[l * 512 + c0 + e];
#pragma unroll
  for (int w = 0; w < 4; ++w) {
    int dt = w - 3;
    if (tl + dt >= 0) {
      float f[8]; unpack8(*(const u32x4*)(Z + (size_t)(t + dt) * ZW + Z_XRNN + c0), f);
#pragma unroll
      for (int e = 0; e < 8; ++e) acc[e] += f[e] * p.conv_w[(l * 4 + w) * 512 + c0 + e];
    }
  }
  *(u32x4*)((bf16_t*)(WS + OFF_XC) + (size_t)t * 512 + c0) = pack8(acc);
}

DI void mla_up_tile(const Params& p, char* WS, int t, bool kv, char* smem) {
  const int tid = get_tid(), lane = tid & 63, wave = tid >> 6, wm = wave >> 1, wn = wave & 1, r = lane & 31, h = lane >> 5;
  const bf16_t* Z = (const bf16_t*)(WS + OFF_HZ);
  float* rowstat = (float*)(smem + 4 * TILE_ELEMS * 2);
  f32x16 acc[2][2]; zero_acc(acc);
  if (!kv) {
    const int tm = t / 6, tn = t % 6;
    gemm_main<true>(Z + (size_t)tm * 128 * ZW + Z_QLAT, ZW, 64, (const bf16_t*)(WS + OFF_WUQ) + ((size_t)tn * 4 << 13), 64, 8192, 256,
                    (bf16_t*)smem, acc, rowstat);
    bf16_t* Q = (bf16_t*)(WS + OFF_Q);
#pragma unroll
    for (int mi = 0; mi < 2; ++mi)
#pragma unroll
      for (int ni = 0; ni < 2; ++ni)
#pragma unroll
        for (int i = 0; i < 16; ++i) {
          int rl = wm * 64 + mi * 32 + crow(i, h);
          int col = tn * 128 + wn * 64 + ni * 32 + r;
          Q[(size_t)(tm * 128 + rl) * 768 + col] = f2bf(acc[mi][ni][i] * rowstat[rl]);
        }
  } else {
    const int tm = t >> 3, hd = t & 7;
    gemm_main<true>(Z + (size_t)tm * 128 * ZW + Z_KVLAT, ZW, 64, (const bf16_t*)(WS + OFF_WUKV) + ((size_t)hd * 2 << 13), 64, 8192, 128,
                    (bf16_t*)smem, acc, rowstat);
    if (wn == 0) {
      bf16_t* KN = (bf16_t*)(WS + OFF_KNOPE);
#pragma unroll
      for (int mi = 0; mi < 2; ++mi)
#pragma unroll
        for (int ni = 0; ni < 2; ++ni)
#pragma unroll
          for (int i = 0; i < 16; ++i) {
            int rl = wm * 64 + mi * 32 + crow(i, h);
            KN[(size_t)(tm * 128 + rl) * 512 + hd * 64 + ni * 32 + r] = f2bf(acc[mi][ni][i] * rowstat[rl]);
          }
    } else {
      bf16_t* VT = (bf16_t*)(WS + OFF_VT);
      const int b = (tm * 128) >> 11, tl0 = (tm * 128) & (SEQ - 1);
#pragma unroll
      for (int mi = 0; mi < 2; ++mi)
#pragma unroll
        for (int ni = 0; ni < 2; ++ni)
#pragma unroll
          for (int g4 = 0; g4 < 4; ++g4) {
            int rl = wm * 64 + mi * 32 + 8 * g4 + 4 * h;
            u32x2 o;
            o.x = pack2(acc[mi][ni][4 * g4] * rowstat[rl], acc[mi][ni][4 * g4 + 1] * rowstat[rl + 1]);
            o.y = pack2(acc[mi][ni][4 * g4 + 2] * rowstat[rl + 2], acc[mi][ni][4 * g4 + 3] * rowstat[rl + 3]);
            *(u32x2*)(VT + ((size_t)(b * 8 + hd) * 64 + ni * 32 + r) * SEQ + tl0 + rl) = o;
          }
    }
  }
}

DI void mla_elem(const Params& p, char* WS, int l, int bitem) {
  const int idx = bitem * NTHREADS + get_tid();
  const int t = idx >> 4, role = idx & 15;
  const int hd = role & 7; const bool isk = role >= 8;
  bf16_t* Q = (bf16_t*)(WS + OFF_Q);
  const bf16_t* Z = (const bf16_t*)(WS + OFF_HZ);
  const bf16_t* KN = (const bf16_t*)(WS + OFF_KNOPE);
  bf16_t* K = (bf16_t*)(WS + OFF_K);
  const float* rope = (const float*)(WS + OFF_ROPE) + (size_t)t * 56;
  const bf16_t* s0 = isk ? Z + (size_t)t * ZW + Z_KPE : Q + (size_t)t * 768 + hd * 96;
  const bf16_t* s1 = isk ? KN + (size_t)t * 512 + hd * 64 : Q + (size_t)t * 768 + hd * 96 + 32;
  bf16_t* dst = isk ? K + (size_t)t * 768 + hd * 96 : Q + (size_t)t * 768 + hd * 96;
  const float* gain = p.mla_qk_gain + (l * 2 + (isk ? 1 : 0)) * 96;
  float v[96];
#pragma unroll
  for (int q = 0; q < 4; ++q) unpack8(*(const u32x4*)(s0 + q * 8), v + q * 8);
#pragma unroll
  for (int q = 0; q < 8; ++q) unpack8(*(const u32x4*)(s1 + q * 8), v + 32 + q * 8);
  float ss = 0.f;
#pragma unroll
  for (int j = 0; j < 96; ++j) ss += v[j] * v[j];
  const float rs = rsqrtf(ss * (1.f / 96.f) + 1e-6f);
#pragma unroll
  for (int j = 0; j < 96; ++j) v[j] = v[j] * rs * gain[j];
#pragma unroll
  for (int i = 0; i < 16; ++i) {
    float c = rope[i], s = rope[16 + i];
    float x1 = v[i], x2 = v[16 + i];
    v[i] = x1 * c - x2 * s; v[16 + i] = x2 * c + x1 * s;
  }
#pragma unroll
  for (int q = 0; q < 12; ++q) *(u32x4*)(dst + q * 8) = pack8(v + q * 8);
}

DI void rg_gate_tile(const Params& p, char* WS, int l, int t, char* smem) {
  const int tid = get_tid(), lane = tid & 63, wave = tid >> 6, wm = wave >> 1, wn = wave & 1, r = lane & 31, h = lane >> 5;
  const int tm = t >> 3, hd = t & 7;
  const bf16_t* XC = (const bf16_t*)(WS + OFF_XC);
  f32x16 acc[2][2]; zero_acc(acc);
  gemm_main<false>(XC + (size_t)tm * 128 * 512 + hd * 64, 512, 64, (const bf16_t*)(WS + OFF_WRG) + (size_t)hd * 128 * 64, 64, 64, 64,
                   (bf16_t*)smem, acc, nullptr);
  const int ch = hd * 64 + wn * 32 + r;
  const float ba = p.rg_ba[l * 512 + ch], bx = p.rg_bx[l * 512 + ch];
  const float lam = p.rg_lambda[l * 512 + ch];
  const float sp = log1pf(__expf(-lam));
  bf16_t* LOGA = (bf16_t*)(WS + OFF_LOGA);
  bf16_t* INP = (bf16_t*)(WS + OFF_INP);
#pragma unroll
  for (int mi = 0; mi < 2; ++mi)
#pragma unroll
    for (int i = 0; i < 16; ++i) {
      int row = tm * 128 + wm * 64 + mi * 32 + crow(i, h);
      float rg = sigmoidf_(acc[mi][0][i] + ba), ig = sigmoidf_(acc[mi][1][i] + bx);
      float loga = -8.f * rg * sp;
      float mult = sqrtf(fmaxf(1.f - __expf(2.f * loga), 0.f));
      float xc = bf2f(XC[(size_t)row * 512 + ch]);
      LOGA[(size_t)row * 512 + ch] = f2bf(loga);
      INP[(size_t)row * 512 + ch] = f2bf(mult * ig * xc);
    }
}

DI void rg_scan_item(const Params& p, char* WS, int item, char* smem) {
  const int tid = get_tid(), c8 = tid & 7, seg = tid >> 3;
  const int b = item >> 3, hd = item & 7;
  const int ch = hd * 64 + c8 * 8;
  const bf16_t* LOGA = (const bf16_t*)(WS + OFF_LOGA) + (size_t)b * SEQ * 512 + ch;
  const bf16_t* INP = (const bf16_t*)(WS + OFF_INP) + (size_t)b * SEQ * 512 + ch;
  const bf16_t* G = (const bf16_t*)(WS + OFF_HZ) + (size_t)b * SEQ * ZW + Z_GATE + ch;
  bf16_t* YA = (bf16_t*)(WS + OFF_YA) + (size_t)b * SEQ * 512 + ch;
  float* ex = (float*)smem;
  const int ts = seg * 64;
  float P[8], hh[8];
#pragma unroll
  for (int e = 0; e < 8; ++e) { P[e] = 1.f; hh[e] = 0.f; }
#pragma unroll 4
  for (int i = 0; i < 64; ++i) {
    float la[8], in[8];
    unpack8(*(const u32x4*)(LOGA + (size_t)(ts + i) * 512), la);
    unpack8(*(const u32x4*)(INP + (size_t)(ts + i) * 512), in);
#pragma unroll
    for (int e = 0; e < 8; ++e) { float a = __expf(la[e]); hh[e] = a * hh[e] + in[e]; P[e] *= a; }
  }
  __syncthreads();
#pragma unroll
  for (int e = 0; e < 8; ++e) { ex[((seg * 64) + c8 * 8 + e) * 2] = P[e]; ex[((seg * 64) + c8 * 8 + e) * 2 + 1] = hh[e]; }
  __syncthreads();
#pragma unroll
  for (int e = 0; e < 8; ++e) hh[e] = 0.f;
  for (int s2 = 0; s2 < seg; ++s2) {
#pragma unroll
    for (int e = 0; e < 8; ++e) hh[e] = ex[((s2 * 64) + c8 * 8 + e) * 2] * hh[e] + ex[((s2 * 64) + c8 * 8 + e) * 2 + 1];
  }
#pragma unroll 4
  for (int i = 0; i < 64; ++i) {
    float la[8], in[8], gt[8], o[8];
    unpack8(*(const u32x4*)(LOGA + (size_t)(ts + i) * 512), la);
    unpack8(*(const u32x4*)(INP + (size_t)(ts + i) * 512), in);
    unpack8(*(const u32x4*)(G + (size_t)(ts + i) * ZW), gt);
#pragma unroll
    for (int e = 0; e < 8; ++e) { float a = __expf(la[e]); hh[e] = a * hh[e] + in[e]; o[e] = hh[e] * gelu_tanh(gt[e]); }
    *(u32x4*)(YA + (size_t)(ts + i) * 512) = pack8(o);
  }
}

DI void glu_tile(const Params& p, char* WS, int l, int t, char* smem) {
  const int tid = get_tid(), lane = tid & 63, wave = tid >> 6, wm = wave >> 1, wn = wave & 1, r = lane & 31, h = lane >> 5;
  const int tm = t >> 2, tn = t & 3;
  const bf16_t* YS = (const bf16_t*)(WS + OFF_YS5);
  bf16_t* YD = (bf16_t*)(WS + OFF_YD);
  f32x16 acc[2][2]; zero_acc(acc);
  gemm_main<false>(YS + (size_t)tm * 128 * 512, 512, 64, (const bf16_t*)(WS + OFF_WGLU) + ((size_t)tn * 8 << 13), 64, 8192, 512,
                   (bf16_t*)smem, acc, nullptr);
#pragma unroll
  for (int ni = 0; ni < 2; ++ni) {
    const int col = tn * 128 + wn * 64 + ni * 32 + r;
    const float bg = p.s5_bglu[l * 512 + col];
#pragma unroll
    for (int mi = 0; mi < 2; ++mi)
#pragma unroll
      for (int i = 0; i < 16; ++i) {
        int row = tm * 128 + wm * 64 + mi * 32 + crow(i, h);
        float y = bf2f(YS[(size_t)row * 512 + col]);
        YD[(size_t)row * 512 + col] = f2bf(y * sigmoidf_(acc[mi][ni][i] + bg));
      }
  }
}

DI void mla_attn_item(const Params& p, char* WS, int l, int item, char* smem) {
  const int tid = get_tid(), lane = tid & 63, wave = tid >> 6, r = lane & 31, h = lane >> 5;
  const int qt = 15 - (item >> 7); const int bh = item & 127; const int b = bh >> 3, hd = bh & 7;
  const int q0 = qt * 128 + wave * 32;
  constexpr int KLD = 104, VLD = 72;
  bf16_t* Kt = (bf16_t*)smem;
  bf16_t* Vt = Kt + 2 * 64 * KLD;
  const bf16_t* Qp = (const bf16_t*)(WS + OFF_Q) + (size_t)(b * SEQ + q0 + r) * 768 + hd * 96 + h * 8;
  bf16x8 bq[6];
#pragma unroll
  for (int s6 = 0; s6 < 6; ++s6) bq[s6] = *(const bf16x8*)(Qp + s6 * 16);
  const bf16_t* Kb = (const bf16_t*)(WS + OFF_K) + (size_t)b * SEQ * 768 + hd * 96;
  const bf16_t* Vb = (const bf16_t*)(WS + OFF_VT) + (size_t)(b * 8 + hd) * 64 * SEQ;
  const float* g0 = p.mla_qk_gain + (l * 2) * 96; const float* g1 = g0 + 96;
  float m0 = fmaxf(fabsf(g0[lane]), lane < 32 ? fabsf(g0[64 + lane]) : 0.f);
  float m1 = fmaxf(fabsf(g1[lane]), lane < 32 ? fabsf(g1[64 + lane]) : 0.f);
  m0 = wave_max(m0); m1 = wave_max(m1);
  const float LOG2E = 1.4426950408889634f;
  const float sc2 = 0.10206207261596577f * LOG2E;
  const float cc2 = 9.797958971132712f * m0 * m1 * LOG2E;
  int krow[3], kcol[3];
#pragma unroll
  for (int i = 0; i < 3; ++i) { int c = tid + 256 * i; krow[i] = c / 12; kcol[i] = (c % 12) * 8; }
  int vrow[2], vcol[2];
#pragma unroll
  for (int i = 0; i < 2; ++i) { int c = tid + 256 * i; vrow[i] = c >> 3; vcol[i] = (c & 7) * 8; }
  u32x4 rk0[3], rv0[2], rk1[3], rv1[2];
  f32x16 o0, o1;
#pragma unroll
  for (int i = 0; i < 16; ++i) { o0[i] = 0.f; o1[i] = 0.f; }
  float lsum = 0.f;
  const int nkt = qt * 2 + 2;
#define A_LOAD(RK, RV, KT)                                                                                  \
  {                                                                                                         \
    const int kk_ = ((KT) < nkt ? (KT) : nkt - 1) * 64;                                                     \
    _Pragma("unroll") for (int i = 0; i < 3; ++i) RK[i] = *(const u32x4*)(Kb + (size_t)(kk_ + krow[i]) * 768 + kcol[i]); \
    _Pragma("unroll") for (int i = 0; i < 2; ++i) RV[i] = *(const u32x4*)(Vb + (size_t)vrow[i] * SEQ + kk_ + vcol[i]);   \
  }
#define A_STORE(RK, RV, BUF)                                                                                \
  {                                                                                                         \
    _Pragma("unroll") for (int i = 0; i < 3; ++i) *(u32x4*)(Kt + (BUF) * 64 * KLD + krow[i] * KLD + kcol[i]) = RK[i]; \
    _Pragma("unroll") for (int i = 0; i < 2; ++i) *(u32x4*)(Vt + (BUF) * 64 * VLD + vrow[i] * VLD + vcol[i]) = RV[i]; \
  }
#define A_COMPUTE(BUF, KT)                                                                                  \
  {                                                                                                         \
    const int k0 = (KT) * 64;                                                                               \
    const bf16_t* kc = Kt + (BUF) * 64 * KLD;                                                               \
    const bf16_t* vc = Vt + (BUF) * 64 * VLD;                                                               \
    _Pragma("unroll") for (int sub = 0; sub < 2; ++sub) {                                                   \
      const int ks0 = k0 + sub * 32;                                                                        \
      if (ks0 <= q0 + 31) {                                                                                 \
        f32x16 sacc;                                                                                        \
        _Pragma("unroll") for (int i = 0; i < 16; ++i) sacc[i] = 0.f;                                       \
        _Pragma("unroll") for (int s6 = 0; s6 < 6; ++s6) {                                                  \
          bf16x8 ka = *(const bf16x8*)(kc + (sub * 32 + r) * KLD + s6 * 16 + h * 8);                        \
          sacc = MFMA32(ka, bq[s6], sacc);                                                                  \
        }                                                                                                   \
        const bool diag = (ks0 + 31 > q0);                                                                  \
        float pv[16];                                                                                       \
        _Pragma("unroll") for (int i = 0; i < 16; ++i) {                                                    \
          float e = __builtin_amdgcn_exp2f(sacc[i] * sc2 - cc2);                                            \
          if (diag && (ks0 + crow(i, h) > q0 + r)) e = 0.f;                                                 \
          pv[i] = e; lsum += e;                                                                             \
        }                                                                                                   \
        _Pragma("unroll") for (int s2 = 0; s2 < 2; ++s2) {                                                  \
          u32x4 pfu;                                                                                        \
          pfu.x = pack2_mfma(pv[8 * s2 + 0], pv[8 * s2 + 1]); pfu.y = pack2_mfma(pv[8 * s2 + 2], pv[8 * s2 + 3]); \
          pfu.z = pack2_mfma(pv[8 * s2 + 4], pv[8 * s2 + 5]); pfu.w = pack2_mfma(pv[8 * s2 + 6], pv[8 * s2 + 7]); \
          bf16x8 pf = __builtin_bit_cast(bf16x8, pfu);                                                      \
          const bf16_t* vp = vc + r * VLD + sub * 32 + 16 * s2 + 4 * h;                                     \
          bf16x4 l0 = *(const bf16x4*)vp, h0 = *(const bf16x4*)(vp + 8);                                    \
          bf16x4 l1 = *(const bf16x4*)(vp + 32 * VLD), h1 = *(const bf16x4*)(vp + 32 * VLD + 8);            \
          bf16x8 va0 = __builtin_shufflevector(l0, h0, 0, 1, 2, 3, 4, 5, 6, 7);                             \
          bf16x8 va1 = __builtin_shufflevector(l1, h1, 0, 1, 2, 3, 4, 5, 6, 7);                             \
          o0 = MFMA32(va0, pf, o0); o1 = MFMA32(va1, pf, o1);                                               \
        }                                                                                                   \
      }                                                                                                     \
    }                                                                                                       \
  }
  A_LOAD(rk0, rv0, 0);
  A_LOAD(rk1, rv1, 1);
  __syncthreads();
  A_STORE(rk0, rv0, 0);
  __syncthreads();
  for (int kt = 0; kt < nkt; kt += 2) {
    A_LOAD(rk0, rv0, kt + 2);
    __builtin_amdgcn_sched_barrier(0);
    A_COMPUTE(0, kt);
    __builtin_amdgcn_sched_barrier(0);
    A_STORE(rk1, rv1, 1);
    __syncthreads();
    A_LOAD(rk1, rv1, kt + 3);
    __builtin_amdgcn_sched_barrier(0);
    A_COMPUTE(1, kt + 1);
    __builtin_amdgcn_sched_barrier(0);
    A_STORE(rk0, rv0, 0);
    __syncthreads();
  }
#undef A_LOAD
#undef A_STORE
#undef A_COMPUTE
  const float lt = lsum + xshfl_xor(lsum, 32);
  const float inv = 1.f / lt;
  bf16_t* yb = (bf16_t*)(WS + OFF_YB) + (size_t)(b * SEQ + q0 + r) * 512 + hd * 64;
#pragma unroll
  for (int g4 = 0; g4 < 4; ++g4) {
    u32x2 a, c;
    a.x = pack2(o0[4 * g4] * inv, o0[4 * g4 + 1] * inv); a.y = pack2(o0[4 * g4 + 2] * inv, o0[4 * g4 + 3] * inv);
    c.x = pack2(o1[4 * g4] * inv, o1[4 * g4 + 1] * inv); c.y = pack2(o1[4 * g4 + 2] * inv, o1[4 * g4 + 3] * inv);
    *(u32x2*)(yb + 8 * g4 + 4 * h) = a;
    *(u32x2*)(yb + 32 + 8 * g4 + 4 * h) = c;
  }
}

DI uint32_t sortable(float f) { uint32_t u = __float_as_uint(f); return (u & 0x80000000u) ? ~u : (u | 0x80000000u); }
DI float idx_score(const f32x16& a, const uint32_t (&wvp)[8], int jq) {
  float s = 0.f;
#pragma unroll
  for (int hd = 0; hd < 8; ++hd) {
    const uint32_t pw = wvp[4 * jq + (hd >> 1)];
    const float w = __uint_as_float((hd & 1) ? (pw & 0xffff0000u) : (pw << 16));
    s = fmaf(w, fmaxf(a[8 * jq + hd], 0.f), s);
  }
  return s;
}
DI int half_sum(int v) {
#pragma unroll
  for (int o = 16; o > 0; o >>= 1) v += xshfl_xor_i(v, o);
  return v;
}
DI void dsa_scores(const bf16_t* KI, const bf16x8 (&aqi)[2], const uint32_t (&wv)[8], int r, int h, int myq0, int ktmax,
                   uint32_t (&sk)[64], uint32_t* stash) {
  const bf16_t* kp = KI + (size_t)r * 32 + 8 * h;
#pragma unroll
  for (int g4 = 0; g4 < 16; ++g4) {
    if (g4 * 4 <= ktmax) {
      asm volatile("" : "+v"(kp));
#pragma unroll
      for (int e = 0; e < 4; ++e) {
        const int kt = g4 * 4 + e;
        f32x16 a;
#pragma unroll
        for (int i = 0; i < 16; ++i) a[i] = 0.f;
#pragma unroll
        for (int s2 = 0; s2 < 2; ++s2) {
          bf16x8 kb = *(const bf16x8*)(kp + e * 1024 + 16 * s2);
          a = MFMA32(aqi[s2], kb, a);
        }
        const int key = kt * 32 + r;
        const float s0 = idx_score(a, wv, 0), s1 = idx_score(a, wv, 1);
        sk[kt] = (key <= myq0) ? sortable(s0) : 0u;
        stash[kt * 64] = (key <= myq0 + 1) ? sortable(s1) : 0u;
      }
      kp += 4 * 1024;
    } else {
#pragma unroll
      for (int e = 0; e < 4; ++e) { sk[4 * g4 + e] = 0u; stash[(4 * g4 + e) * 64] = 0u; }
    }
  }
}
DI void dsa_unstash(uint32_t (&sk)[64], const uint32_t* stash, int ktmax) {
#pragma unroll
  for (int g8 = 0; g8 < 8; ++g8) {
    if (g8 * 8 <= ktmax) {
#pragma unroll
      for (int e = 0; e < 8; ++e) sk[8 * g8 + e] = stash[(8 * g8 + e) * 64];
    } else {
#pragma unroll
      for (int e = 0; e < 8; ++e) sk[8 * g8 + e] = 0u;
    }
  }
}
DI void dsa_threshold(const uint32_t (&sk)[64], int r, int ktmax, uint32_t& thr_out, int& cut_out) {
  uint32_t prefix = 0u;
#pragma unroll 1
  for (int bit = 31; bit >= 0; --bit) {
    const uint32_t cand = prefix | (1u << bit);
    int cnt = 0;
#pragma unroll
    for (int g8 = 0; g8 < 8; ++g8) {
      if (g8 * 8 <= ktmax) {
#pragma unroll
        for (int e = 0; e < 8; ++e) cnt += (sk[g8 * 8 + e] >= cand) ? 1 : 0;
      }
    }
    cnt = half_sum(cnt);
    if (cnt >= 256) prefix = cand;
  }
  int cgt = 0, ceq = 0;
#pragma unroll
  for (int kt = 0; kt < 64; ++kt) { cgt += (sk[kt] > prefix) ? 1 : 0; ceq += (sk[kt] == prefix) ? 1 : 0; }
  cgt = half_sum(cgt); ceq = half_sum(ceq);
  const int need = 256 - cgt;
  int c = 0x7fffffff;
  const bool excess = (prefix != 0u) && (ceq > need);
  if (__any(excess)) {
    int cc = 0;
#pragma unroll 1
    for (int bit = 10; bit >= 0; --bit) {
      const int test = cc | (1 << bit);
      int cnt = 0;
#pragma unroll
      for (int kt = 0; kt < 64; ++kt) cnt += (sk[kt] == prefix && (kt * 32 + r) < test) ? 1 : 0;
      cnt = half_sum(cnt);
      if (cnt < need) cc = test;
    }
    if (excess) c = cc;
  }
  thr_out = prefix; cut_out = c;
}

DI void dsa_item(const Params& p, char* WS, int l, int item, char* smem) {
  const int tid = get_tid(), lane = tid & 63, wave = tid >> 6, r = lane & 31, h = lane >> 5;
  const int qt = 127 - (item >> 4); const int b = item & 15;
  const int tq0 = qt * 16 + wave * 4;
  const bf16_t* Z = (const bf16_t*)(WS + OFF_HZ);
  const bf16_t* KI = (const bf16_t*)(WS + OFF_KI) + (size_t)b * SEQ * 32;
  const bf16_t* KD = (const bf16_t*)(WS + OFF_KD) + (size_t)b * SEQ * 64;
  const bf16_t* VTD = (const bf16_t*)(WS + OFF_VTD) + (size_t)b * 64 * SEQ;
  const int ai = (r & 3) + 4 * (r >> 3);
  const int aq = 2 * ((r >> 2) & 1) + (ai >> 3), ah = ai & 7;
  bf16x8 aqi[2];
#pragma unroll
  for (int s2 = 0; s2 < 2; ++s2)
    aqi[s2] = *(const bf16x8*)(Z + (size_t)(b * SEQ + tq0 + aq) * ZW + Z_QIDX + ah * 32 + 16 * s2 + 8 * h);
  uint32_t wv[8];
#pragma unroll
  for (int jq = 0; jq < 2; ++jq) {
    u32x4 w8 = *(const u32x4*)(Z + (size_t)(b * SEQ + tq0 + 2 * h + jq) * ZW + Z_WIDX);
    wv[4 * jq] = w8.x; wv[4 * jq + 1] = w8.y; wv[4 * jq + 2] = w8.z; wv[4 * jq + 3] = w8.w;
  }
  const int myq0 = tq0 + 2 * h;
  const int ktmax = (tq0 + 3) >> 5;
  uint32_t thr[2]; int cut[2];
  {
    uint32_t* stash = (uint32_t*)smem + (size_t)wave * 64 * 64 + lane;
    uint32_t sk[64];
    dsa_scores(KI, aqi, wv, r, h, myq0, ktmax, sk, stash);
    asm volatile("" ::: "memory");
    dsa_threshold(sk, r, ktmax, thr[0], cut[0]);
    dsa_unstash(sk, stash, ktmax);
    asm volatile("" ::: "memory");
    dsa_threshold(sk, r, ktmax, thr[1], cut[1]);
  }
  asm volatile("" ::: "memory");
  constexpr int KLD = 72, VLD = 72, ILD = 40;
  bf16_t* Kt = (bf16_t*)smem;
  bf16_t* Vt = Kt + 2 * 64 * KLD;
  bf16_t* It = Vt + 2 * 64 * VLD;
  const int cq = r >> 3, chd = r & 7;
  bf16x8 bq[4];
#pragma unroll
  for (int s4 = 0; s4 < 4; ++s4)
    bq[s4] = *(const bf16x8*)(Z + (size_t)(b * SEQ + tq0 + cq) * ZW + Z_QDSA + chd * 64 + 16 * s4 + 8 * h);
  const float* g0 = p.dsa_qk_gain + (l * 2) * 64; const float* g1 = g0 + 64;
  const float m0 = wave_max(fabsf(g0[lane])), m1 = wave_max(fabsf(g1[lane]));
  const float LOG2E = 1.4426950408889634f;
  const float sc2 = 0.125f * LOG2E;
  const float cc2 = 8.f * m0 * m1 * LOG2E;
  f32x16 o0, o1;
#pragma unroll
  for (int i = 0; i < 16; ++i) { o0[i] = 0.f; o1[i] = 0.f; }
  float lsum = 0.f;
  const int nkt = ((qt * 16 + 15) >> 6) + 1;
  const int srow0 = tid >> 3, scol0 = (tid & 7) * 8;
  const int irow = tid >> 2, icol = (tid & 3) * 8;
  u32x4 rk0[2], rv0[2], ri0, rk1[2], rv1[2], ri1;
#define D_LOAD(RK, RV, RI, KT)                                                                              \
  {                                                                                                         \
    const int kk_ = ((KT) < nkt ? (KT) : nkt - 1) * 64;                                                     \
    _Pragma("unroll") for (int i = 0; i < 2; ++i) {                                                         \
      RK[i] = *(const u32x4*)(KD + (size_t)(kk_ + srow0 + 32 * i) * 64 + scol0);                            \
      RV[i] = *(const u32x4*)(VTD + (size_t)(srow0 + 32 * i) * SEQ + kk_ + scol0);                          \
    }                                                                                                       \
    RI = *(const u32x4*)(KI + (size_t)(kk_ + irow) * 32 + icol);                                            \
  }
#define D_STORE(RK, RV, RI, BUF)                                                                            \
  {                                                                                                         \
    _Pragma("unroll") for (int i = 0; i < 2; ++i) {                                                         \
      *(u32x4*)(Kt + (BUF) * 64 * KLD + (srow0 + 32 * i) * KLD + scol0) = RK[i];                            \
      *(u32x4*)(Vt + (BUF) * 64 * VLD + (srow0 + 32 * i) * VLD + scol0) = RV[i];                            \
    }                                                                                                       \
    *(u32x4*)(It + (BUF) * 64 * ILD + irow * ILD + icol) = RI;                                              \
  }
#define D_COMPUTE(BUF, KT)                                                                                  \
  {                                                                                                         \
    const int k0 = (KT) * 64;                                                                               \
    const bf16_t* kc = Kt + (BUF) * 64 * KLD;                                                               \
    const bf16_t* vc = Vt + (BUF) * 64 * VLD;                                                               \
    const bf16_t* ic = It + (BUF) * 64 * ILD;                                                               \
    _Pragma("unroll") for (int sub = 0; sub < 2; ++sub) {                                                   \
      if ((KT) * 2 + sub <= ktmax) {                                                                        \
        const int ks0 = k0 + sub * 32;                                                                      \
        f32x16 a;                                                                                           \
        _Pragma("unroll") for (int i = 0; i < 16; ++i) a[i] = 0.f;                                          \
        _Pragma("unroll") for (int s2 = 0; s2 < 2; ++s2) {                                                  \
          bf16x8 kb = *(const bf16x8*)(ic + (sub * 32 + r) * ILD + 16 * s2 + 8 * h);                        \
          a = MFMA32(aqi[s2], kb, a);                                                                       \
        }                                                                                                   \
        const int key = ks0 + r;                                                                            \
        const uint32_t u0 = sortable(idx_score(a, wv, 0)), u1 = sortable(idx_score(a, wv, 1));              \
        const bool sel0 = (key <= myq0) && (u0 > thr[0] || (u0 == thr[0] && key <= cut[0]));                \
        const bool sel1 = (key <= myq0 + 1) && (u1 > thr[1] || (u1 == thr[1] && key <= cut[1]));            \
        const unsigned long long bl0 = __ballot(sel0), bl1 = __ballot(sel1);                                \
        const unsigned long long blq = (cq & 1) ? bl1 : bl0;                                                \
        const uint32_t mymask = (uint32_t)(blq >> (32 * (cq >> 1)));                                        \
        f32x16 sacc;                                                                                        \
        _Pragma("unroll") for (int i = 0; i < 16; ++i) sacc[i] = 0.f;                                       \
        _Pragma("unroll") for (int s4 = 0; s4 < 4; ++s4) {                                                  \
          bf16x8 ka = *(const bf16x8*)(kc + (sub * 32 + r) * KLD + 16 * s4 + 8 * h);                        \
          sacc = MFMA32(ka, bq[s4], sacc);                                                                  \
        }                                                                                                   \
        float pv[16];                                                                                       \
        _Pragma("unroll") for (int i = 0; i < 16; ++i) {                                                    \
          float e = __builtin_amdgcn_exp2f(sacc[i] * sc2 - cc2);                                            \
          e = ((mymask >> crow(i, h)) & 1u) ? e : 0.f;                                                      \
          pv[i] = e; lsum += e;                                                                             \
        }                                                                                                   \
        _Pragma("unroll") for (int s2 = 0; s2 < 2; ++s2) {                                                  \
          u32x4 pfu;                                                                                        \
          pfu.x = pack2_mfma(pv[8 * s2 + 0], pv[8 * s2 + 1]); pfu.y = pack2_mfma(pv[8 * s2 + 2], pv[8 * s2 + 3]); \
          pfu.z = pack2_mfma(pv[8 * s2 + 4], pv[8 * s2 + 5]); pfu.w = pack2_mfma(pv[8 * s2 + 6], pv[8 * s2 + 7]); \
          bf16x8 pf = __builtin_bit_cast(bf16x8, pfu);                                                      \
          const bf16_t* vp = vc + r * VLD + sub * 32 + 16 * s2 + 4 * h;                                     \
          bf16x4 l0 = *(const bf16x4*)vp, h0 = *(const bf16x4*)(vp + 8);                                    \
          bf16x4 l1 = *(const bf16x4*)(vp + 32 * VLD), h1 = *(const bf16x4*)(vp + 32 * VLD + 8);            \
          bf16x8 va0 = __builtin_shufflevector(l0, h0, 0, 1, 2, 3, 4, 5, 6, 7);                             \
          bf16x8 va1 = __builtin_shufflevector(l1, h1, 0, 1, 2, 3, 4, 5, 6, 7);                             \
          o0 = MFMA32(va0, pf, o0); o1 = MFMA32(va1, pf, o1);                                               \
        }                                                                                                   \
      }                                                                                                     \
    }                                                                                                       \
  }
  D_LOAD(rk0, rv0, ri0, 0);
  D_LOAD(rk1, rv1, ri1, 1);
  __syncthreads();
  D_STORE(rk0, rv0, ri0, 0);
  __syncthreads();
  for (int kt = 0; kt < nkt; kt += 2) {
    D_LOAD(rk0, rv0, ri0, kt + 2);
    __builtin_amdgcn_sched_barrier(0);
    D_COMPUTE(0, kt);
    __builtin_amdgcn_sched_barrier(0);
    D_STORE(rk1, rv1, ri1, 1);
    __syncthreads();
    D_LOAD(rk1, rv1, ri1, kt + 3);
    __builtin_amdgcn_sched_barrier(0);
    if (kt + 1 < nkt) D_COMPUTE(1, kt + 1);
    __builtin_amdgcn_sched_barrier(0);
    D_STORE(rk0, rv0, ri0, 0);
    __syncthreads();
  }
#undef D_LOAD
#undef D_STORE
#undef D_COMPUTE
  const float lt = lsum + xshfl_xor(lsum, 32);
  const float inv = 1.f / lt;
  bf16_t* yc = (bf16_t*)(WS + OFF_YC) + (size_t)(b * SEQ + tq0 + cq) * 512 + chd * 64;
#pragma unroll
  for (int g4 = 0; g4 < 4; ++g4) {
    u32x2 a2, c2;
    a2.x = pack2(o0[4 * g4] * inv, o0[4 * g4 + 1] * inv); a2.y = pack2(o0[4 * g4 + 2] * inv, o0[4 * g4 + 3] * inv);
    c2.x = pack2(o1[4 * g4] * inv, o1[4 * g4 + 1] * inv); c2.y = pack2(o1[4 * g4 + 2] * inv, o1[4 * g4 + 3] * inv);
    *(u32x2*)(yc + 8 * g4 + 4 * h) = a2;
    *(u32x2*)(yc + 32 + 8 * g4 + 4 * h) = c2;
  }
}

DI int snake512(int j) {
  const int round = j >> 9, u = j & 511;
  return (round & 1) ? (round << 9) + (511 - u) : j;
}

DI void phase_mix1(const Params& p, char* WS, int l, char* smem, int rep) {
  constexpr int N_S5 = 512, N_Q = 1536, N_KV = 2048, N_VT = 512, N_QK = (T * 9 + 255) / 256, N_IDX = N_QK, N_CONV = T * 64 / 256;
  constexpr int E0 = N_S5, E1 = E0 + N_Q, E2 = E1 + N_KV, E3 = E2 + N_VT, E4 = E3 + N_QK, E5 = E4 + N_IDX, E6 = E5 + N_CONV;
  for (int it = get_bid(); it < E6; it += get_nb()) {
    if (it < E0) s5_item<false>(p, WS, l, it, smem);
    else if (it < E1) mla_up_tile(p, WS, it - E0, false, smem);
    else if (it < E2) mla_up_tile(p, WS, it - E1, true, smem);
    else if (it < E3) dsa_prep_vt(p, WS, it - E2, smem);
    else if (it < E4) { if (rep == 0) dsa_prep_qk(p, WS, l, it - E3); }
    else if (it < E5) { if (rep == 0) dsa_prep_idx(p, WS, it - E4); }
    else rg_conv(p, WS, l, it - E5);
  }
}
DI void phase_mix2(const Params& p, char* WS, int l, char* smem, int rep) {
  constexpr int N_DSA = 2048, N_S5 = 512, N_RG = 2048, N_EL = T * 16 / 256;
  constexpr int E0 = N_DSA, E1 = E0 + N_S5, E2 = E1 + N_RG, E3 = E2 + N_EL;
  for (int it = get_bid(); it < E3; it += get_nb()) {
    if (it < E0) dsa_item(p, WS, l, snake512(it), smem);
    else if (it < E1) s5_item<true>(p, WS, l, it - E0, smem);
    else if (it < E2) rg_gate_tile(p, WS, l, it - E1, smem);
    else if (rep == 0) mla_elem(p, WS, l, it - E2);
  }
}
DI void phase_mix3(const Params& p, char* WS, int l, char* smem) {
  constexpr int N_RG = 128, N_ATT = 2048, N_GLU = 1024;
  constexpr int E0 = N_RG, E1 = E0 + N_ATT, E2 = E1 + N_GLU;
  for (int it = get_bid(); it < E2; it += get_nb()) {
    if (it < E0) rg_scan_item(p, WS, it, smem);
    else if (it < E1) mla_attn_item(p, WS, l, snake512(it - E0), smem);
    else glu_tile(p, WS, l, it - E1, smem);
  }
}

constexpr int NPHASE = 1 + NL * 13;

DI void run_phase(const Params& p, char* WS, int ph, char* smem_blk, int rep) {
  const int l = (ph - 1) / 13, s = (ph - 1) % 13;
  char* smem = smem_blk + get_team() * SMEM_BYTES;
#define MODP ((const float*)(WS + OFF_MOD) + (size_t)l * 16 * 9216)
  switch (s) {
    case 0: phase_convert(p, WS, l, smem); phase_norm(p, WS, l, 0); break;
    case 1: phase_ffn_up(p, WS, 0, smem_blk); break;
    case 2: phase_gemm_resid(p, WS, (const bf16_t*)(WS + OFF_HZ), (const bf16_t*)(WS + OFF_WDN), DFF, MODP + 2 * 1024, 0.5f, smem_blk); break;
    case 3: phase_norm(p, WS, l, 1); break;
    case 4: phase_inproj(p, WS, smem_blk); break;
    case 5: phase_mix1(p, WS, l, smem, rep); break;
    case 6: phase_mix2(p, WS, l, smem, rep); break;
    case 7: phase_mix3(p, WS, l, smem); break;
    case 8: phase_merge(p, WS, smem); break;
    case 9: phase_gemm_resid(p, WS, (const bf16_t*)(WS + OFF_MERGED), (const bf16_t*)(WS + OFF_WOUT), 1024, MODP + 5 * 1024, 1.0f, smem_blk); break;
    case 10: phase_norm(p, WS, l, 2); break;
    case 11: phase_ffn_up(p, WS, 1, smem_blk); break;
    case 12: phase_gemm_resid(p, WS, (const bf16_t*)(WS + OFF_HZ), (const bf16_t*)(WS + OFF_WDN) + (size_t)1024 * DFF, DFF, MODP + 8 * 1024, 0.5f, smem_blk); break;
  }
}

__global__ void __launch_bounds__(NTHREADS_BLK) mega_kernel(Params p, int ph_lo, int ph_hi, int probe) {
  __shared__ __attribute__((aligned(16))) char smem[SMEM_BLK];
  if (ph_lo == 0) {
    phase_init(p, p.ws, smem + get_team() * SMEM_BYTES);
    if (blockIdx.x == 0 && threadIdx.x == 0) {
      Params* tb = (Params*)(p.ws + OFF_TBL);
      tb->x = p.x;
      tb->c = p.c;
      tb->pos = p.pos;
      tb->ada_w = p.ada_w;
      tb->ada_b = p.ada_b;
      tb->norm_g = p.norm_g;
      tb->ffn_w1 = p.ffn_w1;
      tb->ffn_w3 = p.ffn_w3;
      tb->ffn_w2 = p.ffn_w2;
      tb->w_in = p.w_in;
      tb->conv_w = p.conv_w;
      tb->conv_b = p.conv_b;
      tb->rg_wa = p.rg_wa;
      tb->rg_ba = p.rg_ba;
      tb->rg_wx = p.rg_wx;
      tb->rg_bx = p.rg_bx;
      tb->rg_lambda = p.rg_lambda;
      tb->mla_q_norm = p.mla_q_norm;
      tb->mla_w_uq = p.mla_w_uq;
      tb->mla_kv_norm = p.mla_kv_norm;
      tb->mla_w_ukv = p.mla_w_ukv;
      tb->mla_qk_gain = p.mla_qk_gain;
      tb->dsa_qk_gain = p.dsa_qk_gain;
      tb->s5_lre = p.s5_lre;
      tb->s5_lim = p.s5_lim;
      tb->s5_logdt = p.s5_logdt;
      tb->s5_bre = p.s5_bre;
      tb->s5_bim = p.s5_bim;
      tb->s5_cre = p.s5_cre;
      tb->s5_cim = p.s5_cim;
      tb->s5_d = p.s5_d;
      tb->s5_wglu = p.s5_wglu;
      tb->s5_bglu = p.s5_bglu;
      tb->w_branch = p.w_branch;
      tb->w_out = p.w_out;
      tb->xo = p.xo;
      tb->ws = p.ws;
    }
    ph_lo = 1;
    if (ph_lo < ph_hi) cg::this_grid().sync();
  }
  for (int ph = ph_lo; ph < ph_hi; ++ph) {
    char* ws = p.ws;
    asm volatile("" : "+s"(ws));
    const Params& q = *(const Params*)(ws + OFF_TBL);
    const int nrep = (((ph - 1) % 13) == (probe & 255)) ? (probe >> 8) : 1;
    for (int rep = 0; rep < nrep; ++rep) {
      run_phase(q, ws, ph, smem, rep);
      if (rep + 1 < nrep) cg::this_grid().sync();
    }
    if (ph + 1 < ph_hi) cg::this_grid().sync();
  }
}

extern "C" void kernel_launch(void* const* d_in, const int* in_sizes, int n_in, void* d_out, int out_size, void* d_ws,
                              size_t ws_size, hipStream_t stream) {
  Params p{};
  p.x = (const float*)d_in[0]; p.c = (const float*)d_in[1]; p.pos = (const int*)d_in[2];
  p.ada_w = (const float*)d_in[3]; p.ada_b = (const float*)d_in[4]; p.norm_g = (const float*)d_in[5];
  p.ffn_w1 = (const float*)d_in[6]; p.ffn_w3 = (const float*)d_in[7]; p.ffn_w2 = (const float*)d_in[8];
  p.w_in = (const float*)d_in[9]; p.conv_w = (const float*)d_in[10]; p.conv_b = (const float*)d_in[11];
  p.rg_wa = (const float*)d_in[12]; p.rg_ba = (const float*)d_in[13]; p.rg_wx = (const float*)d_in[14];
  p.rg_bx = (const float*)d_in[15]; p.rg_lambda = (const float*)d_in[16]; p.mla_q_norm = (const float*)d_in[17];
  p.mla_w_uq = (const float*)d_in[18]; p.mla_kv_norm = (const float*)d_in[19]; p.mla_w_ukv = (const float*)d_in[20];
  p.mla_qk_gain = (const float*)d_in[21]; p.dsa_qk_gain = (const float*)d_in[22]; p.s5_lre = (const float*)d_in[23];
  p.s5_lim = (const float*)d_in[24]; p.s5_logdt = (const float*)d_in[25]; p.s5_bre = (const float*)d_in[26];
  p.s5_bim = (const float*)d_in[27]; p.s5_cre = (const float*)d_in[28]; p.s5_cim = (const float*)d_in[29];
  p.s5_d = (const float*)d_in[30]; p.s5_wglu = (const float*)d_in[31]; p.s5_bglu = (const float*)d_in[32];
  p.w_branch = (const float*)d_in[33]; p.w_out = (const float*)d_in[34];
  p.xo = (float*)d_out; p.ws = (char*)d_ws;
  if (ws_size < WS_NEED) fprintf(stderr, "workspace too small: %zu < %zu\n", ws_size, (size_t)WS_NEED);
  static int grid_blocks = 0;
  if (!grid_blocks) {
    int dev = 0, cus = 0, per_cu = 0;
    hipGetDevice(&dev);
    hipDeviceGetAttribute(&cus, hipDeviceAttributeMultiprocessorCount, dev);
    hipOccupancyMaxActiveBlocksPerMultiprocessor(&per_cu, mega_kernel, NTHREADS_BLK, 0);
    if (per_cu > 1) per_cu = 1;
    if (per_cu < 1) per_cu = 1;
    grid_blocks = cus * per_cu;
  }
#if MEGA
  int lo = 0, hi = NPHASE, probe = PROBE_CFG;
  void* args[] = {&p, &lo, &hi, &probe};
  hipError_t e = hipLaunchCooperativeKernel((void*)mega_kernel, dim3(grid_blocks), dim3(NTHREADS_BLK), args, 0, stream);
  if (e != hipSuccess) fprintf(stderr, "cooperative launch failed: %s (grid %d)\n", hipGetErrorString(e), grid_blocks);
#else
  for (int ph = 0; ph < NPHASE; ++ph) mega_kernel<<<grid_blocks, NTHREADS_BLK, 0, stream>>>(p, ph, ph + 1, PROBE_CFG);
#endif
}
```

```cpp
#include <hip/hip_runtime.h>
#include <hip/hip_cooperative_groups.h>
#include <stdint.h>
#include <stdio.h>
namespace cg = cooperative_groups;

#ifndef MEGA
#define MEGA 1
#endif
#ifndef PROBE_CFG
#define PROBE_CFG (255 | (1 << 8))
#endif

typedef unsigned short bf16_t;
using bf16x8 = __attribute__((ext_vector_type(8))) short;
using bf16x4 = __attribute__((ext_vector_type(4))) short;
using f32x16 = __attribute__((ext_vector_type(16))) float;
using u32x4 = __attribute__((ext_vector_type(4))) uint32_t;
using u32x2 = __attribute__((ext_vector_type(2))) uint32_t;

#define DI __device__ __forceinline__
#define MFMA32(a, b, c) __builtin_amdgcn_mfma_f32_32x32x16_bf16((a), (b), (c), 0, 0, 0)

constexpr int T = 32768, SEQ = 2048, NB = 16, D = 1024, DFF = 2816, ZW = 2944, DIN = 6984, NL = 4;
constexpr int NTHREADS = 256;
constexpr int NTHREADS_BLK = 512;
constexpr int Z_XRNN = 0, Z_GATE = 512, Z_QLAT = 1024, Z_KVLAT = 1280, Z_KPE = 1408, Z_QDSA = 1440, Z_KDSA = 1952,
              Z_VDSA = 2016, Z_QIDX = 2080, Z_KIDX = 2336, Z_WIDX = 2368, Z_US5 = 2376, Z_GATES = 2888;

constexpr size_t AL(size_t x) { return (x + 255) & ~(size_t)255; }
constexpr size_t OFF_WUP = 0;
constexpr size_t OFF_WDN = OFF_WUP + AL((size_t)2 * 5632 * 1024 * 2);
constexpr size_t OFF_WIN = OFF_WDN + AL((size_t)2 * 1024 * 2816 * 2);
constexpr size_t OFF_WBR = OFF_WIN + AL((size_t)7040 * 1024 * 2);
constexpr size_t OFF_WOUT = OFF_WBR + AL((size_t)4 * 1024 * 512 * 2);
constexpr size_t OFF_WUQ = OFF_WOUT + AL((size_t)1024 * 1024 * 2);
constexpr size_t OFF_WUKV = OFF_WUQ + AL((size_t)768 * 256 * 2);
constexpr size_t OFF_WRG = OFF_WUKV + AL((size_t)1024 * 128 * 2);
constexpr size_t OFF_WGLU = OFF_WRG + AL((size_t)8 * 128 * 64 * 2);
constexpr size_t OFF_S5AB = OFF_WGLU + AL((size_t)512 * 512 * 2);
constexpr size_t OFF_S5BB = OFF_S5AB + AL((size_t)32 * 64 * 4 * 4);
constexpr size_t OFF_S5CT = OFF_S5BB + AL((size_t)32 * 128 * 16 * 2);
constexpr size_t OFF_MOD = OFF_S5CT + AL((size_t)32 * 16 * 128 * 2);
constexpr size_t OFF_ROPE = OFF_MOD + AL((size_t)4 * 16 * 9216 * 4);
constexpr size_t OFF_U = OFF_ROPE + AL((size_t)T * 56 * 4);
constexpr size_t OFF_HZ = OFF_U + AL((size_t)T * 1024 * 2);
constexpr size_t OFF_XC = OFF_HZ + AL((size_t)T * ZW * 2);
constexpr size_t OFF_Q = OFF_XC + AL((size_t)T * 512 * 2);
constexpr size_t OFF_KNOPE = OFF_Q + AL((size_t)T * 768 * 2);
constexpr size_t OFF_VT = OFF_KNOPE + AL((size_t)T * 512 * 2);
constexpr size_t OFF_K = OFF_VT + AL((size_t)T * 512 * 2);
constexpr size_t OFF_KD = OFF_K + AL((size_t)T * 768 * 2);
constexpr size_t OFF_VTD = OFF_KD + AL((size_t)T * 64 * 2);
constexpr size_t OFF_KI = OFF_VTD + AL((size_t)T * 64 * 2);
constexpr size_t OFF_ENDS = OFF_KI + AL((size_t)T * 32 * 2);
constexpr size_t OFF_YS5 = OFF_ENDS + AL((size_t)16 * 32 * 32 * 128 * 4);
constexpr size_t OFF_LOGA = OFF_YS5 + AL((size_t)T * 512 * 2);
constexpr size_t OFF_INP = OFF_LOGA + AL((size_t)T * 512 * 2);
constexpr size_t OFF_YC = OFF_INP + AL((size_t)T * 512 * 2);
constexpr size_t OFF_YD = OFF_YC + AL((size_t)T * 512 * 2);
constexpr size_t OFF_TBL = OFF_YD + AL((size_t)T * 512 * 2);
constexpr size_t WS_NEED = OFF_TBL + 1024;
constexpr size_t OFF_YA = OFF_XC, OFF_YB = OFF_KNOPE, OFF_MERGED = OFF_HZ;

struct Params {
  const float* x; const float* c; const int* pos;
  const float *ada_w, *ada_b, *norm_g, *ffn_w1, *ffn_w3, *ffn_w2, *w_in, *conv_w, *conv_b, *rg_wa, *rg_ba, *rg_wx, *rg_bx,
      *rg_lambda, *mla_q_norm, *mla_w_uq, *mla_kv_norm, *mla_w_ukv, *mla_qk_gain, *dsa_qk_gain, *s5_lre, *s5_lim, *s5_logdt,
      *s5_bre, *s5_bim, *s5_cre, *s5_cim, *s5_d, *s5_wglu, *s5_bglu, *w_branch, *w_out;
  float* xo;
  char* ws;
};

DI int get_tid512() { int t = threadIdx.x; asm volatile("" : "+v"(t)); return t; }
DI int get_tid() { int t = threadIdx.x & 255; asm volatile("" : "+v"(t)); return t; }
DI int get_team() { int t = __builtin_amdgcn_readfirstlane(threadIdx.x >> 8); asm volatile("" : "+s"(t)); return t; }
DI int get_bid() { int b = blockIdx.x * 2 + __builtin_amdgcn_readfirstlane(threadIdx.x >> 8); asm volatile("" : "+s"(b)); return b; }
DI int get_nb() { int b = gridDim.x * 2; asm volatile("" : "+s"(b)); return b; }
DI int get_bid_real() { int b = blockIdx.x; asm volatile("" : "+s"(b)); return b; }
DI int get_nb_real() { int b = gridDim.x; asm volatile("" : "+s"(b)); return b; }
DI float xshfl_xor(float v, int m) { int l = (get_tid() & 63) ^ m; return __int_as_float(__builtin_amdgcn_ds_bpermute(l << 2, __float_as_int(v))); }
DI int xshfl_xor_i(int v, int m) { int l = (get_tid() & 63) ^ m; return __builtin_amdgcn_ds_bpermute(l << 2, v); }
DI float xshfl(float v, int src) { return __int_as_float(__builtin_amdgcn_ds_bpermute(src << 2, __float_as_int(v))); }
DI float bf2f(bf16_t v) { return __uint_as_float(((uint32_t)v) << 16); }
DI uint32_t pack2(float a, float b) { uint32_t r; asm("v_cvt_pk_bf16_f32 %0, %1, %2" : "=v"(r) : "v"(a), "v"(b)); return r; }
DI uint32_t pack2_mfma(float a, float b) { uint32_t r; asm volatile("v_cvt_pk_bf16_f32 %0, %1, %2\n\ts_nop 1" : "=v"(r) : "v"(a), "v"(b)); return r; }
DI bf16_t f2bf(float f) { return (bf16_t)(pack2(f, f) & 0xffffu); }
DI int crow(int i, int h) { return (i & 3) + 8 * (i >> 2) + 4 * h; }
DI float wave_sum(float v) {
#pragma unroll
  for (int o = 32; o > 0; o >>= 1) v += xshfl_xor(v, o);
  return v;
}
DI float wave_max(float v) {
#pragma unroll
  for (int o = 32; o > 0; o >>= 1) v = fmaxf(v, xshfl_xor(v, o));
  return v;
}
DI float sigmoidf_(float x) { return __builtin_amdgcn_rcpf(1.f + __expf(-x)); }
DI float gelu_tanh(float x) {
  float u = 0.7978845608028654f * (x + 0.044715f * x * x * x);
  float t = 1.f - 2.f * __builtin_amdgcn_rcpf(1.f + __expf(2.f * u));
  return 0.5f * x * (1.f + t);
}
DI void unpack8(u32x4 v, float* f) {
  f[0] = __uint_as_float(v.x << 16); f[1] = __uint_as_float(v.x & 0xffff0000u);
  f[2] = __uint_as_float(v.y << 16); f[3] = __uint_as_float(v.y & 0xffff0000u);
  f[4] = __uint_as_float(v.z << 16); f[5] = __uint_as_float(v.z & 0xffff0000u);
  f[6] = __uint_as_float(v.w << 16); f[7] = __uint_as_float(v.w & 0xffff0000u);
}
DI u32x4 pack8(const float* f) {
  u32x4 v; v.x = pack2(f[0], f[1]); v.y = pack2(f[2], f[3]); v.z = pack2(f[4], f[5]); v.w = pack2(f[6], f[7]); return v;
}
DI void sincos_rev(float ang, float* s, float* c) {
  double rev = (double)ang * 0.15915494309189535; rev -= rint(rev);
  float rv = (float)rev;
  *s = __builtin_amdgcn_sinf(rv); *c = __builtin_amdgcn_cosf(rv);
}

constexpr int LDT = 72;
constexpr int TILE_ELEMS = 128 * LDT;
constexpr int SMEM_BYTES = 4 * TILE_ELEMS * 2 + 1024;
constexpr int SMEM_BLK = 2 * SMEM_BYTES;

template <int NI>
struct Stage { u32x4 a[4]; u32x4 b[2 * NI]; };

template <bool SUMSQ, int UNR = 4, int NI = 2>
DI void gemm_main(const bf16_t* __restrict__ A, int lda, int ksa, const bf16_t* __restrict__ Bt, int ldb, int ksb, int K, bf16_t* sm,
                  f32x16 (&acc)[2][NI], float* rowstat) {
  const int tid = get_tid(), lane = tid & 63, wave = tid >> 6;
  const int wm = wave >> 1, wn = wave & 1, r = lane & 31, h = lane >> 5;
  const int lrow = tid >> 3, lkc = (tid & 7) * 8;
  const bf16_t* ga = A + (size_t)lrow * lda + lkc;
  const bf16_t* gb = Bt + (size_t)lrow * ldb + lkc;
  bf16_t* sA = sm;
  bf16_t* sB = sm + 2 * TILE_ELEMS;
  const int nk = K >> 6;
  float ss[4] = {0.f, 0.f, 0.f, 0.f};
  u32x4 r0a[4], r0b[2 * NI], r1a[4], r1b[2 * NI];
#define G_LOAD(RA, RB, KT)                                                                          \
  {                                                                                                 \
    const size_t ka_ = (size_t)(KT) * ksa, kb_ = (size_t)(KT) * ksb;                                \
    _Pragma("unroll") for (int i = 0; i < 4; ++i) RA[i] = *(const u32x4*)(ga + (size_t)(32 * i) * lda + ka_);      \
    _Pragma("unroll") for (int i = 0; i < 2 * NI; ++i) RB[i] = *(const u32x4*)(gb + (size_t)(32 * i) * ldb + kb_); \
  }
#define G_STORE(RA, RB, BUF)                                                                        \
  {                                                                                                 \
    bf16_t* nA_ = sA + (BUF) * TILE_ELEMS; bf16_t* nB_ = sB + (BUF) * TILE_ELEMS;                   \
    _Pragma("unroll") for (int i = 0; i < 4; ++i) {                                                 \
      *(u32x4*)(nA_ + (lrow + 32 * i) * LDT + lkc) = RA[i];                                         \
      if (SUMSQ) { float f_[8]; unpack8(RA[i], f_);                                                 \
        _Pragma("unroll") for (int e = 0; e < 8; ++e) ss[i] += f_[e] * f_[e]; }                     \
    }                                                                                               \
    _Pragma("unroll") for (int i = 0; i < 2 * NI; ++i) *(u32x4*)(nB_ + (lrow + 32 * i) * LDT + lkc) = RB[i]; \
  }
#define G_COMPUTE(BUF)                                                                              \
  {                                                                                                 \
    const bf16_t* cA = sA + (BUF) * TILE_ELEMS + (wm * 64 + r) * LDT + h * 8;                       \
    const bf16_t* cB = sB + (BUF) * TILE_ELEMS + (wn * 32 * NI + r) * LDT + h * 8;                  \
    _Pragma("unroll") for (int ks = 0; ks < 4; ++ks) {                                              \
      bf16x8 a0 = *(const bf16x8*)(cA + ks * 16);                                                   \
      bf16x8 a1 = *(const bf16x8*)(cA + 32 * LDT + ks * 16);                                        \
      _Pragma("unroll") for (int ni = 0; ni < NI; ++ni) {                                           \
        bf16x8 b0 = *(const bf16x8*)(cB + ni * 32 * LDT + ks * 16);                                 \
        acc[0][ni] = MFMA32(a0, b0, acc[0][ni]);                                                    \
        acc[1][ni] = MFMA32(a1, b0, acc[1][ni]);                                                    \
      }                                                                                             \
    }                                                                                               \
  }
  G_LOAD(r0a, r0b, 0);
  G_LOAD(r1a, r1b, (nk > 1 ? 1 : 0));
  __syncthreads();
  G_STORE(r0a, r0b, 0);
  __syncthreads();
  for (int kt = 0; kt < nk; kt += 2) {
    G_LOAD(r0a, r0b, (kt + 2 < nk ? kt + 2 : nk - 1));
    __builtin_amdgcn_sched_barrier(0);
    G_COMPUTE(0);
    __builtin_amdgcn_sched_barrier(0);
    if (kt + 1 < nk) G_STORE(r1a, r1b, 1);
    __syncthreads();
    if (kt + 1 < nk) {
      G_LOAD(r1a, r1b, (kt + 3 < nk ? kt + 3 : nk - 1));
      __builtin_amdgcn_sched_barrier(0);
      G_COMPUTE(1);
      __builtin_amdgcn_sched_barrier(0);
      if (kt + 2 < nk) G_STORE(r0a, r0b, 0);
      __syncthreads();
    }
  }
#undef G_LOAD
#undef G_STORE
#undef G_COMPUTE
  if (SUMSQ) {
#pragma unroll
    for (int i = 0; i < 4; ++i) {
      float v = ss[i];
      v += xshfl_xor(v, 1); v += xshfl_xor(v, 2); v += xshfl_xor(v, 4);
      if ((tid & 7) == 0) rowstat[lrow + 32 * i] = rsqrtf(v / (float)K + 1e-6f);
    }
    __syncthreads();
  }
}

DI size_t tiled_off(int row, int col, int nk) {
  return ((size_t)((row >> 7) * nk + (col >> 6)) << 13) + ((row & 127) << 6) + (col & 63);
}
DI void zero_acc(f32x16 (&acc)[2][2]) {
#pragma unroll
  for (int a = 0; a < 2; ++a)
#pragma unroll
    for (int b = 0; b < 2; ++b)
#pragma unroll
      for (int i = 0; i < 16; ++i) acc[a][b][i] = 0.f;
}
DI void gemm256_main(const bf16_t* __restrict__ A, const bf16_t* __restrict__ Bt, int K, bf16_t* sm, f32x16 (&acc)[4][2]) {
  const int tid = get_tid512(), lane = tid & 63, wave = tid >> 6;
  const int wm = wave >> 2, wn = wave & 3, r = lane & 31, h = lane >> 5;
  const int lrow = tid >> 3, lkc = (tid & 7) * 8;
  const int nk = K >> 6;
  const bf16_t* ga = A + (size_t)lrow * 64 + lkc;
  const bf16_t* gb = Bt + (size_t)lrow * 64 + lkc;
  const size_t rts = (size_t)nk << 13;
  constexpr int TE = 256 * LDT;
  bf16_t* sA = sm;
  bf16_t* sB = sm + 2 * TE;
  u32x4 r0a[4], r0b[4], r1a[4], r1b[4];
#define H_LOAD(RA, RB, KT)                                                                                   \
  {                                                                                                          \
    const size_t ko_ = (size_t)(KT) << 13;                                                                   \
    _Pragma("unroll") for (int i = 0; i < 4; ++i) {                                                          \
      RA[i] = *(const u32x4*)(ga + (i >> 1) * rts + (i & 1) * 4096 + ko_);                                   \
      RB[i] = *(const u32x4*)(gb + (i >> 1) * rts + (i & 1) * 4096 + ko_);                                   \
    }                                                                                                        \
  }
#define H_STORE(RA, RB, BUF)                                                                                 \
  {                                                                                                          \
    _Pragma("unroll") for (int i = 0; i < 4; ++i) {                                                          \
      *(u32x4*)(sA + (BUF) * TE + (lrow + 64 * i) * LDT + lkc) = RA[i];                                      \
      *(u32x4*)(sB + (BUF) * TE + (lrow + 64 * i) * LDT + lkc) = RB[i];                                      \
    }                                                                                                        \
  }
#define H_COMPUTE(BUF, KS0, KS1)                                                                             \
  {                                                                                                          \
    const bf16_t* cA = sA + (BUF) * TE + (wm * 128 + r) * LDT + h * 8;                                       \
    const bf16_t* cB = sB + (BUF) * TE + (wn * 64 + r) * LDT + h * 8;                                        \
    _Pragma("unroll") for (int ks = KS0; ks < KS1; ++ks) {                                                   \
      bf16x8 b0 = *(const bf16x8*)(cB + ks * 16);                                                            \
      bf16x8 b1 = *(const bf16x8*)(cB + 32 * LDT + ks * 16);                                                 \
      _Pragma("unroll") for (int mi = 0; mi < 4; ++mi) {                                                     \
        bf16x8 a0 = *(const bf16x8*)(cA + mi * 32 * LDT + ks * 16);                                          \
        acc[mi][0] = MFMA32(a0, b0, acc[mi][0]);                                                             \
        acc[mi][1] = MFMA32(a0, b1, acc[mi][1]);                                                             \
      }                                                                                                      \
    }                                                                                                        \
  }
  H_LOAD(r0a, r0b, 0);
  H_LOAD(r1a, r1b, (nk > 1 ? 1 : 0));
  __syncthreads();
  H_STORE(r0a, r0b, 0);
  __syncthreads();
  for (int kt = 0; kt < nk; kt += 2) {
    H_LOAD(r0a, r0b, (kt + 2 < nk ? kt + 2 : nk - 1));
    __builtin_amdgcn_sched_barrier(0);
    H_COMPUTE(0, 0, 2);
    __builtin_amdgcn_sched_barrier(0);
    if (kt + 1 < nk) H_STORE(r1a, r1b, 1);
    __builtin_amdgcn_sched_barrier(0);
    H_COMPUTE(0, 2, 4);
    __syncthreads();
    if (kt + 1 < nk) {
      H_LOAD(r1a, r1b, (kt + 3 < nk ? kt + 3 : nk - 1));
      __builtin_amdgcn_sched_barrier(0);
      H_COMPUTE(1, 0, 2);
      __builtin_amdgcn_sched_barrier(0);
      if (kt + 2 < nk) H_STORE(r0a, r0b, 0);
      __builtin_amdgcn_sched_barrier(0);
      H_COMPUTE(1, 2, 4);
      __syncthreads();
    }
  }
#undef H_LOAD
#undef H_STORE
#undef H_COMPUTE
}
DI void zero_acc42(f32x16 (&acc)[4][2]) {
#pragma unroll
  for (int a = 0; a < 4; ++a)
#pragma unroll
    for (int b = 0; b < 2; ++b)
#pragma unroll
      for (int i = 0; i < 16; ++i) acc[a][b][i] = 0.f;
}
struct TileIter256 {
  int x, i, step, ntn, total, tmw_l2, ngm_l2, tnw;
  DI TileIter256(int ntn_, int tnw_l2) {
    const int b = get_bid_real(), nb = get_nb_real();
    x = b & 7; i = b >> 3; step = nb >> 3; ntn = ntn_;
    tnw = 1 << tnw_l2; tmw_l2 = 5 - tnw_l2; ngm_l2 = 4 - tmw_l2;
    total = (32 << ngm_l2) * (ntn_ >> tnw_l2);
  }
  DI bool next(int& tm, int& tn) {
    if (i >= total) return false;
    const int sup = i >> 5, within = i & 31;
    tm = x * 16 + ((sup & ((1 << ngm_l2) - 1)) << tmw_l2) + (within & ((1 << tmw_l2) - 1));
    tn = (sup >> ngm_l2) * tnw + (within >> tmw_l2);
    i += step;
    return true;
  }
};

DI void tile_map(int t, int ntn, int& tm, int& tn) {
  int per = 8 * ntn; int g = t / per; int rem = t - g * per;
  tm = g * 8 + (rem & 7); tn = rem >> 3;
}
struct TileIter {
  int x, i, step, ntn, total;
  DI TileIter(int ntn_) {
    const int b = get_bid(), nb = get_nb();
    x = b & 7; i = b >> 3; step = nb >> 3; ntn = ntn_;
    total = 32 * ((ntn_ + 7) & ~7);
  }
  DI bool next(int& tm, int& tn) {
    while (i < total) {
      const int blk = i >> 6, within = i & 63;
      tm = x * 32 + (blk & 3) * 8 + (within & 7);
      tn = (blk >> 2) * 8 + (within >> 3);
      i += step;
      if (tn < ntn) return true;
    }
    return false;
  }
};

DI void phase_init(const Params& p, char* WS, char* smem) {
  const int tid = get_tid(), lane = tid & 63, wave = tid >> 6;
  const size_t gtid = (size_t)get_bid() * NTHREADS + tid, gsz = (size_t)get_nb() * NTHREADS;
  const float4* src = (const float4*)p.x; float4* dst = (float4*)p.xo;
  for (size_t i = gtid; i < (size_t)T * D / 4; i += gsz) dst[i] = src[i];
  float* rope = (float*)(WS + OFF_ROPE);
  for (size_t i = gtid; i < (size_t)T * 28; i += gsz) {
    int t = (int)(i / 28), j = (int)(i % 28);
    float ex; int co, so;
    if (j < 16) { ex = (float)(2 * j) / 32.f; co = j; so = 16 + j; }
    else if (j < 24) { ex = (float)(2 * (j - 16)) / 16.f; co = 32 + j - 16; so = 40 + j - 16; }
    else { ex = (float)(2 * (j - 24)) / 8.f; co = 48 + j - 24; so = 52 + j - 24; }
    float inv = exp2f(-ex * 18.931568569324174f);
    float ang = (float)p.pos[t] * inv;
    float s, c; sincos_rev(ang, &s, &c);
    rope[(size_t)t * 56 + co] = c; rope[(size_t)t * 56 + so] = s;
  }
  float* cact = (float*)smem;
  float* part = (float*)(smem + 16384);
  float* mod = (float*)(WS + OFF_MOD);
  for (int it = get_bid(); it < NL * 144; it += get_nb()) {
    const int l = it / 144, c0 = (it % 144) * 64;
    float acc[16];
#pragma unroll
    for (int b = 0; b < 16; ++b) acc[b] = 0.f;
    for (int kc = 0; kc < 4; ++kc) {
      __syncthreads();
      for (int e = tid; e < 4096; e += NTHREADS) {
        int kk = e >> 4, b = e & 15; float cv = p.c[b * 1024 + kc * 256 + kk];
        cact[e] = cv / (1.f + __expf(-cv));
      }
      __syncthreads();
      const float* wp = p.ada_w + ((size_t)l * 1024 + kc * 256 + wave * 64) * 9216 + c0 + lane;
#pragma unroll 8
      for (int kk = 0; kk < 64; ++kk) {
        float w = wp[(size_t)kk * 9216];
        const float4* cv = (const float4*)(cact + (wave * 64 + kk) * 16);
        float4 c0v = cv[0], c1v = cv[1], c2v = cv[2], c3v = cv[3];
        acc[0] += c0v.x * w; acc[1] += c0v.y * w; acc[2] += c0v.z * w; acc[3] += c0v.w * w;
        acc[4] += c1v.x * w; acc[5] += c1v.y * w; acc[6] += c1v.z * w; acc[7] += c1v.w * w;
        acc[8] += c2v.x * w; acc[9] += c2v.y * w; acc[10] += c2v.z * w; acc[11] += c2v.w * w;
        acc[12] += c3v.x * w; acc[13] += c3v.y * w; acc[14] += c3v.z * w; acc[15] += c3v.w * w;
      }
    }
    __syncthreads();
#pragma unroll
    for (int b = 0; b < 16; ++b) part[(wave * 16 + b) * 64 + lane] = acc[b];
    __syncthreads();
    for (int e = tid; e < 1024; e += NTHREADS) {
      int b = e >> 6, cl = e & 63;
      float s = part[(0 * 16 + b) * 64 + cl] + part[(1 * 16 + b) * 64 + cl] + part[(2 * 16 + b) * 64 + cl] +
                part[(3 * 16 + b) * 64 + cl] + p.ada_b[l * 9216 + c0 + cl];
      mod[((size_t)l * 16 + b) * 9216 + c0 + cl] = s;
    }
  }
}

DI void conv_tile(const float* __restrict__ src, int lds_, int jmax, bf16_t* __restrict__ dst, int ldd,
                          const float* __restrict__ scale, float* tile) {
  const int tid = get_tid();
  __syncthreads();
  {
    const int j = tid & 31, kb = tid >> 5;
#pragma unroll
    for (int i = 0; i < 8; ++i) {
      int kk = kb + 8 * i;
      float v = (j < jmax) ? src[(size_t)kk * lds_ + j] : 0.f;
      if (scale) v *= scale[kk];
      tile[kk * 33 + j] = v;
    }
  }
  __syncthreads();
  {
    const int j = tid >> 3, kq = (tid & 7) * 8;
    float f[8];
#pragma unroll
    for (int e = 0; e < 8; ++e) f[e] = tile[(kq + e) * 33 + j];
    *(u32x4*)(dst + (size_t)j * ldd + kq) = pack8(f);
  }
}

DI void phase_convert(const Params& p, char* WS, int l, char* smem) {
  float* tile = (float*)smem;
  char* ws = WS;
  constexpr int J0 = 2816, J1 = 2816, J2 = 1408, J3 = 1408, J4 = 3520, J5 = 1024, J6 = 512, J7 = 96, J8 = 64, J9 = 32, J10 = 128, J11 = 8;
  constexpr int E0 = J0, E1 = E0 + J1, E2 = E1 + J2, E3 = E2 + J3, E4 = E3 + J4, E5 = E4 + J5, E6 = E5 + J6, E7 = E6 + J7,
                E8 = E7 + J8, E9 = E8 + J9, E10 = E9 + J10, E11 = E10 + J11;
  for (int it = get_bid(); it < E11; it += get_nb()) {
    if (it < E1) {
      int a = it >= E0; int t = it - (a ? E0 : 0);
      int G = t >> 4, kt = t & 15; int grp = G >> 1, which = G & 1;
      const float* w = (which ? p.ffn_w3 : p.ffn_w1) + ((size_t)(l * 2 + a) * 1024 + kt * 64) * DFF + grp * 32;
      bf16_t* d = (bf16_t*)(ws + OFF_WUP) + (size_t)a * 5632 * 1024 + tiled_off(G * 32, kt * 64, 16);
      conv_tile(w, DFF, 32, d, 64, nullptr, tile);
    } else if (it < E3) {
      int a = it >= E2; int t = it - (a ? E2 : E1);
      int G = t / 44, kt = t % 44;
      const float* w = p.ffn_w2 + ((size_t)(l * 2 + a) * DFF + kt * 64) * 1024 + G * 32;
      bf16_t* d = (bf16_t*)(ws + OFF_WDN) + (size_t)a * 1024 * DFF + tiled_off(G * 32, kt * 64, 44);
      conv_tile(w, 1024, 32, d, 64, nullptr, tile);
    } else if (it < E4) {
      int t = it - E3; int G = t >> 4, kt = t & 15;
      const int scol = (G < 92) ? G * 32 : Z_GATES + (G - 92) * 32;
      const float* w = p.w_in + ((size_t)l * 1024 + kt * 64) * DIN + scol;
      bf16_t* d = (G < 92) ? (bf16_t*)(ws + OFF_WIN) + tiled_off(G * 32, kt * 64, 16)
                           : (bf16_t*)(ws + OFF_WIN) + (size_t)2944 * 1024 + tiled_off((G - 92) * 32, kt * 64, 16);
      conv_tile(w, DIN, 32, d, 64, nullptr, tile);
    } else if (it < E5) {
      int t = it - E4; int n = t >> 8; int rem = t & 255; int G = rem >> 3, kt = rem & 7;
      const float* w = p.w_branch + ((size_t)(l * 4 + n) * 512 + kt * 64) * 1024 + G * 32;
      bf16_t* d = (bf16_t*)(ws + OFF_WBR) + (size_t)n * 1024 * 512 + tiled_off(G * 32, kt * 64, 8);
      conv_tile(w, 1024, 32, d, 64, nullptr, tile);
    } else if (it < E6) {
      int t = it - E5; int G = t >> 4, kt = t & 15;
      const float* w = p.w_out + ((size_t)l * 1024 + kt * 64) * 1024 + G * 32;
      bf16_t* d = (bf16_t*)(ws + OFF_WOUT) + tiled_off(G * 32, kt * 64, 16);
      conv_tile(w, 1024, 32, d, 64, nullptr, tile);
    } else if (it < E7) {
      int t = it - E6; int G = t >> 2, kt = t & 3;
      const float* w = p.mla_w_uq + ((size_t)l * 256 + kt * 64) * 768 + G * 32;
      bf16_t* d = (bf16_t*)(ws + OFF_WUQ) + tiled_off(G * 32, kt * 64, 4);
      conv_tile(w, 768, 32, d, 64, p.mla_q_norm + l * 256 + kt * 64, tile);
    } else if (it < E8) {
      int t = it - E7; int G = t >> 1, kt = t & 1;
      const float* w = p.mla_w_ukv + ((size_t)l * 128 + kt * 64) * 1024 + G * 32;
      bf16_t* d = (bf16_t*)(ws + OFF_WUKV) + tiled_off(G * 32, kt * 64, 2);
      conv_tile(w, 1024, 32, d, 64, p.mla_kv_norm + l * 128 + kt * 64, tile);
    } else if (it < E9) {
      int t = it - E8; int hd = t >> 2, G = t & 3; int half = G >> 1, which = G & 1;
      const float* w = (which ? p.rg_wx : p.rg_wa) + ((size_t)(l * 8 + hd) * 64) * 64 + half * 32;
      bf16_t* d = (bf16_t*)(ws + OFF_WRG) + ((size_t)hd * 128 + G * 32) * 64;
      conv_tile(w, 64, 32, d, 64, nullptr, tile);
    } else if (it < E10) {
      int t = it - E9; int G = t >> 3, kt = t & 7;
      const float* w = p.s5_wglu + ((size_t)l * 512 + kt * 64) * 512 + G * 32;
      bf16_t* d = (bf16_t*)(ws + OFF_WGLU) + tiled_off(G * 32, kt * 64, 8);
      conv_tile(w, 512, 32, d, 64, nullptr, tile);
    } else {
      int idx = (it - E10) * 256 + get_tid();
      int g = idx >> 6, pst = idx & 63;
      float lr = p.s5_lre[(l * 32 + g) * 64 + pst], li = p.s5_lim[(l * 32 + g) * 64 + pst];
      float dt = expf(p.s5_logdt[l * 32 + g]);
      float mag = expf(lr * dt);
      float sn, cs; sincos_rev(li * dt, &sn, &cs);
      float abr = mag * cs, abi = mag * sn;
      float den = lr * lr + li * li;
      float nr = abr - 1.f, ni = abi;
      float fr = (nr * lr + ni * li) / den, fi = (ni * lr - nr * li) / den;
      float pr = abr, pi = abi;
#pragma unroll
      for (int q = 0; q < 6; ++q) { float tr = pr * pr - pi * pi, ti = pr * pi; ti = ti + ti; pr = tr; pi = ti; }
      float* ab = (float*)(ws + OFF_S5AB) + (size_t)idx * 4;
      ab[0] = abr; ab[1] = abi; ab[2] = pr; ab[3] = pi;
      const float* br = p.s5_bre + ((size_t)(l * 32 + g) * 64 + pst) * 16;
      const float* bi = p.s5_bim + ((size_t)(l * 32 + g) * 64 + pst) * 16;
      bf16_t* bb = (bf16_t*)(ws + OFF_S5BB) + (size_t)g * 128 * 16;
#pragma unroll
      for (int j = 0; j < 16; ++j) {
        float r_ = br[j], i_ = bi[j];
        bb[(pst) * 16 + j] = f2bf(fr * r_ - fi * i_);
        bb[(64 + pst) * 16 + j] = f2bf(fr * i_ + fi * r_);
      }
      bf16_t* ct = (bf16_t*)(ws + OFF_S5CT) + (size_t)g * 16 * 128;
#pragma unroll
      for (int j = 0; j < 16; ++j) {
        ct[j * 128 + pst] = f2bf(p.s5_cre[((size_t)(l * 32 + g) * 16 + j) * 64 + pst]);
        ct[j * 128 + 64 + pst] = f2bf(-p.s5_cim[((size_t)(l * 32 + g) * 16 + j) * 64 + pst]);
      }
    }
  }
}

DI void phase_norm(const Params& p, char* WS, int l, int which) {
  const int tid = get_tid(), lane = tid & 63, wave = tid >> 6;
  const float* g = p.norm_g + (l * 3 + which) * 1024;
  const float* mod = (const float*)(WS + OFF_MOD) + (size_t)l * 16 * 9216;
  bf16_t* U = (bf16_t*)(WS + OFF_U);
  const float* xo = p.xo;
  for (int row0 = (get_bid() * 4 + wave) * 4; row0 < T; row0 += get_nb() * 16) {
    float4 v[4][4]; float ss[4];
#pragma unroll
    for (int q = 0; q < 4; ++q) {
      const float4* xr = (const float4*)(xo + (size_t)(row0 + q) * 1024);
#pragma unroll
      for (int i = 0; i < 4; ++i) v[q][i] = xr[lane + 64 * i];
    }
#pragma unroll
    for (int q = 0; q < 4; ++q) {
      float a = 0.f;
#pragma unroll
      for (int i = 0; i < 4; ++i) a += v[q][i].x * v[q][i].x + v[q][i].y * v[q][i].y + v[q][i].z * v[q][i].z + v[q][i].w * v[q][i].w;
      ss[q] = a;
    }
#pragma unroll
    for (int o = 32; o > 0; o >>= 1) {
#pragma unroll
      for (int q = 0; q < 4; ++q) ss[q] += xshfl_xor(ss[q], o);
    }
    const int b = row0 >> 11;
    const float* sh = mod + (size_t)b * 9216 + (3 * which) * 1024;
    const float* sc = sh + 1024;
#pragma unroll
    for (int i = 0; i < 4; ++i) {
      const int c = (lane + 64 * i) * 4;
      float4 gg = *(const float4*)(g + c), s4 = *(const float4*)(sh + c), c4 = *(const float4*)(sc + c);
      const float m0 = gg.x * (1.f + c4.x), m1 = gg.y * (1.f + c4.y), m2 = gg.z * (1.f + c4.z), m3 = gg.w * (1.f + c4.w);
#pragma unroll
      for (int q = 0; q < 4; ++q) {
        const float rstd = rsqrtf(ss[q] * (1.f / 1024.f) + 1e-6f);
        u32x2 o;
        o.x = pack2(v[q][i].x * rstd * m0 + s4.x, v[q][i].y * rstd * m1 + s4.y);
        o.y = pack2(v[q][i].z * rstd * m2 + s4.z, v[q][i].w * rstd * m3 + s4.w);
        *(u32x2*)(U + tiled_off(row0 + q, c, 16)) = o;
      }
    }
  }
}

DI void phase_ffn_up(const Params& p, char* WS, int a, char* smem) {
  const int tid = get_tid512(), lane = tid & 63, wave = tid >> 6, wm = wave >> 2, wn = wave & 3, r = lane & 31, h = lane >> 5;
  const bf16_t* U = (const bf16_t*)(WS + OFF_U);
  const bf16_t* W = (const bf16_t*)(WS + OFF_WUP) + (size_t)a * 5632 * 1024;
  bf16_t* H = (bf16_t*)(WS + OFF_HZ);
  TileIter256 ti(22, 1);
  for (int tm, tn; ti.next(tm, tn);) {
    f32x16 acc[4][2]; zero_acc42(acc);
    gemm256_main(U + ((size_t)tm * 2 * 16 << 13), W + ((size_t)tn * 2 * 16 << 13), 1024, (bf16_t*)smem, acc);
    {
      constexpr int SLD = 128 + 8;
      bf16_t* st = (bf16_t*)smem;
#pragma unroll
      for (int mi = 0; mi < 4; ++mi)
#pragma unroll
        for (int i = 0; i < 16; ++i) {
          float v1 = acc[mi][0][i], v3 = acc[mi][1][i];
          st[(wm * 128 + mi * 32 + crow(i, h)) * SLD + wn * 32 + r] = f2bf(v1 * sigmoidf_(v1) * v3);
        }
      __syncthreads();
#pragma unroll
      for (int q = 0; q < 8; ++q) {
        const int c = get_tid512() + 512 * q;
        const int row = c >> 4, cc = (c & 15) * 8;
        u32x4 v = *(const u32x4*)(st + row * SLD + cc);
        *(u32x4*)(H + tiled_off(tm * 256 + row, tn * 128 + cc, 44)) = v;
      }
    }
  }
}

DI void phase_gemm_resid(const Params& p, char* WS, const bf16_t* A, const bf16_t* Bt, int K, const float* gmod,
                         float coef, char* smem) {
  const int tid = get_tid512(), lane = tid & 63, wave = tid >> 6, wm = wave >> 2, wn = wave & 3, r = lane & 31, h = lane >> 5;
  float* xo = p.xo;
  TileIter256 ti(4, 2);
  for (int tm, tn; ti.next(tm, tn);) {
    f32x16 acc[4][2]; zero_acc42(acc);
    gemm256_main(A + ((size_t)tm * 2 * (K >> 6) << 13), Bt + ((size_t)tn * 2 * (K >> 6) << 13), K, (bf16_t*)smem, acc);
    const int b = (tm * 256) >> 11;
    {
      constexpr int SLD = 128 + 4;
      float* st = (float*)smem;
#pragma unroll
      for (int ni = 0; ni < 2; ++ni) {
        const int col = tn * 256 + wn * 64 + ni * 32 + r;
        const float gs = coef * (1.f + gmod[(size_t)b * 9216 + col]);
#pragma unroll
        for (int mi = 0; mi < 4; ++mi)
#pragma unroll
          for (int i = 0; i < 16; ++i) st[(wm * 128 + mi * 32 + crow(i, h)) * SLD + wn * 32 + r] = gs * acc[mi][ni][i];
        __syncthreads();
#pragma unroll 4
        for (int q = 0; q < 16; ++q) {
          const int c = get_tid512() + 512 * q;
          const int row = c >> 5, c4 = (c & 31) * 4;
          const int gcol = tn * 256 + (c4 >> 5) * 64 + ni * 32 + (c4 & 31);
          const float4 v = *(const float4*)(st + row * SLD + c4);
          float4* xp = (float4*)(xo + (size_t)(tm * 256 + row) * 1024 + gcol);
          float4 xv = *xp;
          xv.x += v.x; xv.y += v.y; xv.z += v.z; xv.w += v.w;
          *xp = xv;
        }
        __syncthreads();
      }
    }
  }
}

DI void phase_inproj(const Params& p, char* WS, char* smem) {
  const int tid = get_tid512(), lane = tid & 63, wave = tid >> 6, wm = wave >> 2, wn = wave & 3, r = lane & 31, h = lane >> 5;
  const bf16_t* U = (const bf16_t*)(WS + OFF_U);
  const bf16_t* W = (const bf16_t*)(WS + OFF_WIN);
  bf16_t* Z = (bf16_t*)(WS + OFF_HZ);
  TileIter256 ti(12, 2);
  for (int tm, tn; ti.next(tm, tn);) {
    f32x16 acc[4][2]; zero_acc42(acc);
    gemm256_main(U + ((size_t)tm * 2 * 16 << 13), W + ((size_t)tn * 2 * 16 << 13), 1024, (bf16_t*)smem, acc);
    {
      constexpr int SLD = 256 + 8;
      bf16_t* st = (bf16_t*)smem;
#pragma unroll
      for (int ni = 0; ni < 2; ++ni)
#pragma unroll
        for (int mi = 0; mi < 4; ++mi)
#pragma unroll
          for (int i = 0; i < 16; ++i)
            st[(wm * 128 + mi * 32 + crow(i, h)) * SLD + wn * 64 + ni * 32 + r] = f2bf(acc[mi][ni][i]);
      __syncthreads();
#pragma unroll
      for (int q = 0; q < 16; ++q) {
        const int c = get_tid512() + 512 * q;
        const int row = c >> 5, cc = (c & 31) * 8;
        if (tn * 256 + cc < ZW) {
          u32x4 v = *(const u32x4*)(st + row * SLD + cc);
          *(u32x4*)(Z + (size_t)(tm * 256 + row) * ZW + tn * 256 + cc) = v;
        }
      }
    }
  }
}

DI void phase_merge(const Params& p, char* WS, char* smem) {
  const int tid = get_tid(), lane = tid & 63, wave = tid >> 6, wm = wave >> 1, wn = wave & 1, r = lane & 31, h = lane >> 5;
  const bf16_t* U = (const bf16_t*)(WS + OFF_U);
  const bf16_t* WG = (const bf16_t*)(WS + OFF_WIN) + (size_t)2944 * 1024;
  const bf16_t* WB = (const bf16_t*)(WS + OFF_WBR);
  bf16_t* M = (bf16_t*)(WS + OFF_MERGED);
  TileIter ti(16);
  for (int tm, tn; ti.next(tm, tn);) {
    f32x16 am[2][1];
#pragma unroll
    for (int i = 0; i < 16; ++i) { am[0][0][i] = 0.f; am[1][0][i] = 0.f; }
#pragma unroll 1
    for (int n = 0; n < 4; ++n) {
      const size_t yoff = (n == 0) ? OFF_YA : (n == 1) ? OFF_YB : (n == 2) ? OFF_YC : OFF_YD;
      const bf16_t* Y = (const bf16_t*)(WS + yoff);
      f32x16 ag[2][1], ab[2][1];
#pragma unroll
      for (int i = 0; i < 16; ++i) { ag[0][0][i] = 0.f; ag[1][0][i] = 0.f; ab[0][0][i] = 0.f; ab[1][0][i] = 0.f; }
      gemm_main<false, 4, 1>(U + ((size_t)tm * 16 << 13), 64, 8192,
                             WG + ((size_t)((n * 1024 + tn * 64) >> 7) * 16 << 13) + (tn & 1) * 64 * 64, 64, 8192, 1024,
                             (bf16_t*)smem, ag, nullptr);
      gemm_main<false, 4, 1>(Y + (size_t)tm * 128 * 512, 512, 64, WB + (size_t)n * 1024 * 512 + ((size_t)(tn >> 1) * 8 << 13) + (tn & 1) * 64 * 64, 64, 8192, 512, (bf16_t*)smem, ab, nullptr);
#pragma unroll
      for (int x = 0; x < 2; ++x)
#pragma unroll
        for (int i = 0; i < 16; ++i) am[x][0][i] += sigmoidf_(ag[x][0][i]) * ab[x][0][i];
    }
    {
      constexpr int SLD = 64 + 8;
      bf16_t* st = (bf16_t*)smem;
#pragma unroll
      for (int mi = 0; mi < 2; ++mi)
#pragma unroll
        for (int i = 0; i < 16; ++i) st[(wm * 64 + mi * 32 + crow(i, h)) * SLD + wn * 32 + r] = f2bf(am[mi][0][i]);
      __syncthreads();
#pragma unroll
      for (int q = 0; q < 4; ++q) {
        const int c = get_tid() + 256 * q;
        const int row = c >> 3, cc = (c & 7) * 8;
        u32x4 v = *(const u32x4*)(st + row * SLD + cc);
        *(u32x4*)(M + tiled_off(tm * 128 + row, tn * 64 + cc, 16)) = v;
      }
    }
  }
}

template <bool PASS2>
DI void s5_item(const Params& p, char* WS, int l, int item, char* smem) {
  const int tid = get_tid(), lane = tid & 63, wave = tid >> 6, r = lane & 31, h = lane >> 5;
  const int b = item >> 5, ck = item & 31;
  const int t0 = b * SEQ + ck * 64;
  const bf16_t* Z = (const bf16_t*)(WS + OFF_HZ);
  const float* AB = (const float*)(WS + OFF_S5AB);
  const bf16_t* BB = (const bf16_t*)(WS + OFF_S5BB);
  const bf16_t* CT = (const bf16_t*)(WS + OFF_S5CT);
  float* ENDS = (float*)(WS + OFF_ENDS);
  bf16_t* YS = (bf16_t*)(WS + OFF_YS5);
  constexpr int XLD = 136;
  bf16_t* img = (bf16_t*)smem + (size_t)wave * 64 * XLD;
  const int tokA = 32 * ((r >> 2) & 1) + (r & 3) + 4 * (r >> 3);
  for (int gi = 0; gi < 8; ++gi) {
    const int g = wave * 8 + gi;
    bf16x8 af[2];
#pragma unroll
    for (int m = 0; m < 2; ++m) af[m] = *(const bf16x8*)(Z + (size_t)(t0 + tokA + 16 * m) * ZW + Z_US5 + g * 16 + 8 * h);
    if (PASS2) __syncthreads();
#pragma unroll 1
    for (int sb = 0; sb < 2; ++sb) {
      const int st = sb * 32 + r;
      const float4 abv = *(const float4*)(AB + (size_t)(g * 64 + st) * 4);
      const float ar = abv.x, ai = abv.y;
      bf16x8 bfr = *(const bf16x8*)(BB + ((size_t)g * 128 + st) * 16 + 8 * h);
      bf16x8 bfi = *(const bf16x8*)(BB + ((size_t)g * 128 + 64 + st) * 16 + 8 * h);
      f32x16 zr;
#pragma unroll
      for (int i = 0; i < 16; ++i) zr[i] = 0.f;
      f32x16 bur0 = MFMA32(af[0], bfr, zr), bur1 = MFMA32(af[1], bfr, zr);
      f32x16 bui0 = MFMA32(af[0], bfi, zr), bui1 = MFMA32(af[1], bfi, zr);
      float cr = 0.f, ci = 0.f;
      if (PASS2) {
        const float a64r = abv.z, a64i = abv.w;
        const float* e0 = ENDS + (((size_t)(b * 32) * 32 + g) * 128) + st;
        int c2 = 0;
        for (; c2 + 2 <= ck; c2 += 2) {
          float er[2], ei[2];
#pragma unroll
          for (int q = 0; q < 2; ++q) { er[q] = e0[(size_t)(c2 + q) * 4096]; ei[q] = e0[(size_t)(c2 + q) * 4096 + 64]; }
#pragma unroll
          for (int q = 0; q < 2; ++q) {
            float nr = a64r * cr - a64i * ci + er[q], ni = a64r * ci + a64i * cr + ei[q];
            cr = nr; ci = ni;
          }
        }
        for (; c2 < ck; ++c2) {
          float er = e0[(size_t)c2 * 4096], ei = e0[(size_t)c2 * 4096 + 64];
          float nr = a64r * cr - a64i * ci + er, ni = a64r * ci + a64i * cr + ei;
          cr = nr; ci = ni;
        }
      }
      float xr = cr, xi = ci;
#pragma unroll
      for (int i = 0; i < 16; ++i) { float nr = ar * xr - ai * xi + bur0[i], ni = ar * xi + ai * xr + bui0[i]; xr = nr; xi = ni; }
#pragma unroll
      for (int i = 0; i < 16; ++i) { float nr = ar * xr - ai * xi + bur1[i], ni = ar * xi + ai * xr + bui1[i]; xr = nr; xi = ni; }
      float er0 = xshfl(xr, r), ei0 = xshfl(xi, r);
      xr = h ? er0 : cr; xi = h ? ei0 : ci;
#pragma unroll
      for (int i = 0; i < 16; ++i) {
        float nr = ar * xr - ai * xi + bur0[i], ni = ar * xi + ai * xr + bui0[i]; xr = nr; xi = ni;
        if (PASS2) { int tk = 32 * h + i; img[tk * XLD + st] = f2bf(xr); img[tk * XLD + 64 + st] = f2bf(xi); }
      }
#pragma unroll
      for (int i = 0; i < 16; ++i) {
        float nr = ar * xr - ai * xi + bur1[i], ni = ar * xi + ai * xr + bui1[i]; xr = nr; xi = ni;
        if (PASS2) { int tk = 32 * h + 16 + i; img[tk * XLD + st] = f2bf(xr); img[tk * XLD + 64 + st] = f2bf(xi); }
      }
      if (!PASS2) {
        if (h) { float* e = ENDS + (((size_t)(b * 32 + ck) * 32 + g) * 128); e[st] = xr; e[64 + st] = xi; }
      }
    }
    if (PASS2) {
      __syncthreads();
      f32x16 y0, y1;
#pragma unroll
      for (int i = 0; i < 16; ++i) { y0[i] = 0.f; y1[i] = 0.f; }
#pragma unroll
      for (int s = 0; s < 8; ++s) {
        bf16x8 cf;
        if (r < 16) cf = *(const bf16x8*)(CT + ((size_t)g * 16 + r) * 128 + 16 * s + 8 * h);
        else {
#pragma unroll
          for (int j = 0; j < 8; ++j) cf[j] = 0;
        }
        bf16x8 a0 = *(const bf16x8*)(img + (r)*XLD + 16 * s + 8 * h);
        bf16x8 a1 = *(const bf16x8*)(img + (32 + r) * XLD + 16 * s + 8 * h);
        y0 = MFMA32(a0, cf, y0); y1 = MFMA32(a1, cf, y1);
      }
      if (r < 16) {
        const int ch = g * 16 + r;
        const float dd = p.s5_d[l * 512 + ch];
#pragma unroll
        for (int i = 0; i < 16; ++i) {
          int tk = crow(i, h);
          float u0 = bf2f(Z[(size_t)(t0 + tk) * ZW + Z_US5 + ch]);
          float u1 = bf2f(Z[(size_t)(t0 + 32 + tk) * ZW + Z_US5 + ch]);
          YS[(size_t)(t0 + tk) * 512 + ch] = f2bf(gelu_tanh(y0[i] + dd * u0));
          YS[(size_t)(t0 + 32 + tk) * 512 + ch] = f2bf(gelu_tanh(y1[i] + dd * u1));
        }
      }
    }
  }
}

DI void dsa_prep_qk(const Params& p, char* WS, int l, int bitem) {
  const int idx = bitem * NTHREADS + get_tid();
  if (idx >= T * 9) return;
  const int t = idx / 9, role = idx % 9;
  bf16_t* Z = (bf16_t*)(WS + OFF_HZ);
  const float* rope = (const float*)(WS + OFF_ROPE) + (size_t)t * 56;
  bf16_t* src = Z + (size_t)t * ZW + (role < 8 ? Z_QDSA + role * 64 : Z_KDSA);
  bf16_t* dst = (role < 8) ? src : (bf16_t*)(WS + OFF_KD) + (size_t)t * 64;
  const float* gain = p.dsa_qk_gain + (l * 2 + (role < 8 ? 0 : 1)) * 64;
  float v[64];
#pragma unroll
  for (int q = 0; q < 8; ++q) unpack8(*(const u32x4*)(src + q * 8), v + q * 8);
  float ss = 0.f;
#pragma unroll
  for (int j = 0; j < 64; ++j) ss += v[j] * v[j];
  const float rs = rsqrtf(ss * (1.f / 64.f) + 1e-6f);
#pragma unroll
  for (int j = 0; j < 64; ++j) v[j] = v[j] * rs * gain[j];
#pragma unroll
  for (int i = 0; i < 8; ++i) {
    float c = rope[32 + i], s = rope[40 + i];
    float x1 = v[i], x2 = v[8 + i];
    v[i] = x1 * c - x2 * s; v[8 + i] = x2 * c + x1 * s;
  }
#pragma unroll
  for (int q = 0; q < 8; ++q) *(u32x4*)(dst + q * 8) = pack8(v + q * 8);
}
DI void dsa_prep_idx(const Params& p, char* WS, int bitem) {
  const int idx = bitem * NTHREADS + get_tid();
  if (idx >= T * 9) return;
  const int t = idx / 9, role = idx % 9;
  bf16_t* Z = (bf16_t*)(WS + OFF_HZ);
  const float* rope = (const float*)(WS + OFF_ROPE) + (size_t)t * 56;
  bf16_t* src = Z + (size_t)t * ZW + (role < 8 ? Z_QIDX + role * 32 : Z_KIDX);
  bf16_t* dst = (role < 8) ? src : (bf16_t*)(WS + OFF_KI) + (size_t)t * 32;
  float v[32];
#pragma unroll
  for (int q = 0; q < 4; ++q) unpack8(*(const u32x4*)(src + q * 8), v + q * 8);
#pragma unroll
  for (int i = 0; i < 4; ++i) {
    float c = rope[48 + i], s = rope[52 + i];
    float x1 = v[i], x2 = v[4 + i];
    v[i] = x1 * c - x2 * s; v[4 + i] = x2 * c + x1 * s;
  }
#pragma unroll
  for (int q = 0; q < 4; ++q) *(u32x4*)(dst + q * 8) = pack8(v + q * 8);
}
DI void dsa_prep_vt(const Params& p, char* WS, int item, char* smem) {
  const int tid = get_tid();
  const int b = item >> 5, ck = item & 31;
  const bf16_t* Z = (const bf16_t*)(WS + OFF_HZ);
  bf16_t* VTD = (bf16_t*)(WS + OFF_VTD);
  bf16_t* tile = (bf16_t*)smem;
  __syncthreads();
  {
    const int tt = tid >> 2, dq = (tid & 3) * 16;
    const bf16_t* s = Z + (size_t)(b * SEQ + ck * 64 + tt) * ZW + Z_VDSA + dq;
    u32x4 a = *(const u32x4*)s, c = *(const u32x4*)(s + 8);
    uint32_t w[8] = {a.x, a.y, a.z, a.w, c.x, c.y, c.z, c.w};
#pragma unroll
    for (int e = 0; e < 8; ++e) *(uint32_t*)(tile + tt * 66 + dq + 2 * e) = w[e];
  }
  __syncthreads();
  {
    const int d = tid >> 2, tq = (tid & 3) * 16;
    uint32_t w[8];
#pragma unroll
    for (int e = 0; e < 8; ++e) w[e] = (uint32_t)tile[(tq + 2 * e) * 66 + d] | ((uint32_t)tile[(tq + 2 * e + 1) * 66 + d] << 16);
    bf16_t* o = VTD + ((size_t)b * 64 + d) * SEQ + ck * 64 + tq;
    *(u32x4*)o = u32x4{w[0], w[1], w[2], w[3]};
    *(u32x4*)(o + 8) = u32x4{w[4], w[5], w[6], w[7]};
  }
}

DI void rg_conv(const Params& p, char* WS, int l, int bitem) {
  const int idx = bitem * NTHREADS + get_tid();
  const int t = idx >> 6, c0 = (idx & 63) * 8;
  const int tl = t & (SEQ - 1);
  const bf16_t* Z = (const bf16_t*)(WS + OFF_HZ);
  float acc[8];
#pragma unroll
  for (int e = 0; e < 8; ++e) acc[e] = p.conv_b[l * 512 + c0 + e];
#pragma unroll
  for (int w = 0; w < 4; ++w) {
    int dt = w - 3;
    if (tl + dt >= 0) {
      float f[8]; unpack8(*(const u32x4*)(Z + (size_t)(t + dt) * ZW + Z_XRNN + c0), f);
#pragma unroll
      for (int e = 0; e < 8; ++e) acc[e] += f[e] * p.conv_w[(l * 4 + w) * 512 + c0 + e];
    }
  }
  *(u32x4*)((bf16_t*)(WS + OFF_XC) + (size_t)t * 512 + c0) = pack8(acc);
}

DI void mla_up_tile(const Params& p, char* WS, int t, bool kv, char* smem) {
  const int tid = get_tid(), lane = tid & 63, wave = tid >> 6, wm = wave >> 1, wn = wave & 1, r = lane & 31, h = lane >> 5;
  const bf16_t* Z = (const bf16_t*)(WS + OFF_HZ);
  float* rowstat = (float*)(smem + 4 * TILE_ELEMS * 2);
  f32x16 acc[2][2]; zero_acc(acc);
  if (!kv) {
    const int tm = t / 6, tn = t % 6;
    gemm_main<true>(Z + (size_t)tm * 128 * ZW + Z_QLAT, ZW, 64, (const bf16_t*)(WS + OFF_WUQ) + ((size_t)tn * 4 << 13), 64, 8192, 256,
                    (bf16_t*)smem, acc, rowstat);
    bf16_t* Q = (bf16_t*)(WS + OFF_Q);
#pragma unroll
    for (int mi = 0; mi < 2; ++mi)
#pragma unroll
      for (int ni = 0; ni < 2; ++ni)
#pragma unroll
        for (int i = 0; i < 16; ++i) {
          int rl = wm * 64 + mi * 32 + crow(i, h);
          int col = tn * 128 + wn * 64 + ni * 32 + r;
          Q[(size_t)(tm * 128 + rl) * 768 + col] = f2bf(acc[mi][ni][i] * rowstat[rl]);
        }
  } else {
    const int tm = t >> 3, hd = t & 7;
    gemm_main<true>(Z + (size_t)tm * 128 * ZW + Z_KVLAT, ZW, 64, (const bf16_t*)(WS + OFF_WUKV) + ((size_t)hd * 2 << 13), 64, 8192, 128,
                    (bf16_t*)smem, acc, rowstat);
    if (wn == 0) {
      bf16_t* KN = (bf16_t*)(WS + OFF_KNOPE);
#pragma unroll
      for (int mi = 0; mi < 2; ++mi)
#pragma unroll
        for (int ni = 0; ni < 2; ++ni)
#pragma unroll
          for (int i = 0; i < 16; ++i) {
            int rl = wm * 64 + mi * 32 + crow(i, h);
            KN[(size_t)(tm * 128 + rl) * 512 + hd * 64 + ni * 32 + r] = f2bf(acc[mi][ni][i] * rowstat[rl]);
          }
    } else {
      bf16_t* VT = (bf16_t*)(WS + OFF_VT);
      const int b = (tm * 128) >> 11, tl0 = (tm * 128) & (SEQ - 1);
#pragma unroll
      for (int mi = 0; mi < 2; ++mi)
#pragma unroll
        for (int ni = 0; ni < 2; ++ni)
#pragma unroll
          for (int g4 = 0; g4 < 4; ++g4) {
            int rl = wm * 64 + mi * 32 + 8 * g4 + 4 * h;
            u32x2 o;
            o.x = pack2(acc[mi][ni][4 * g4] * rowstat[rl], acc[mi][ni][4 * g4 + 1] * rowstat[rl + 1]);
            o.y = pack2(acc[mi][ni][4 * g4 + 2] * rowstat[rl + 2], acc[mi][ni][4 * g4 + 3] * rowstat[rl + 3]);
            *(u32x2*)(VT + ((size_t)(b * 8 + hd) * 64 + ni * 32 + r) * SEQ + tl0 + rl) = o;
          }
    }
  }
}

DI void mla_elem(const Params& p, char* WS, int l, int bitem) {
  const int idx = bitem * NTHREADS + get_tid();
  const int t = idx >> 4, role = idx & 15;
  const int hd = role & 7; const bool isk = role >= 8;
  bf16_t* Q = (bf16_t*)(WS + OFF_Q);
  const bf16_t* Z = (const bf16_t*)(WS + OFF_HZ);
  const bf16_t* KN = (const bf16_t*)(WS + OFF_KNOPE);
  bf16_t* K = (bf16_t*)(WS + OFF_K);
  const float* rope = (const float*)(WS + OFF_ROPE) + (size_t)t * 56;
  const bf16_t* s0 = isk ? Z + (size_t)t * ZW + Z_KPE : Q + (size_t)t * 768 + hd * 96;
  const bf16_t* s1 = isk ? KN + (size_t)t * 512 + hd * 64 : Q + (size_t)t * 768 + hd * 96 + 32;
  bf16_t* dst = isk ? K + (size_t)t * 768 + hd * 96 : Q + (size_t)t * 768 + hd * 96;
  const float* gain = p.mla_qk_gain + (l * 2 + (isk ? 1 : 0)) * 96;
  float v[96];
#pragma unroll
  for (int q = 0; q < 4; ++q) unpack8(*(const u32x4*)(s0 + q * 8), v + q * 8);
#pragma unroll
  for (int q = 0; q < 8; ++q) unpack8(*(const u32x4*)(s1 + q * 8), v + 32 + q * 8);
  float ss = 0.f;
#pragma unroll
  for (int j = 0; j < 96; ++j) ss += v[j] * v[j];
  const float rs = rsqrtf(ss * (1.f / 96.f) + 1e-6f);
#pragma unroll
  for (int j = 0; j < 96; ++j) v[j] = v[j] * rs * gain[j];
#pragma unroll
  for (int i = 0; i < 16; ++i) {
    float c = rope[i], s = rope[16 + i];
    float x1 = v[i], x2 = v[16 + i];
    v[i] = x1 * c - x2 * s; v[16 + i] = x2 * c + x1 * s;
  }
#pragma unroll
  for (int q = 0; q < 12; ++q) *(u32x4*)(dst + q * 8) = pack8(v + q * 8);
}

DI void rg_gate_tile(const Params& p, char* WS, int l, int t, char* smem) {
  const int tid = get_tid(), lane = tid & 63, wave = tid >> 6, wm = wave >> 1, wn = wave & 1, r = lane & 31, h = lane >> 5;
  const int tm = t >> 3, hd = t & 7;
  const bf16_t* XC = (const bf16_t*)(WS + OFF_XC);
  f32x16 acc[2][2]; zero_acc(acc);
  gemm_main<false>(XC + (size_t)tm * 128 * 512 + hd * 64, 512, 64, (const bf16_t*)(WS + OFF_WRG) + (size_t)hd * 128 * 64, 64, 64, 64,
                   (bf16_t*)smem, acc, nullptr);
  const int ch = hd * 64 + wn * 32 + r;
  const float ba = p.rg_ba[l * 512 + ch], bx = p.rg_bx[l * 512 + ch];
  const float lam = p.rg_lambda[l * 512 + ch];
  const float sp = log1pf(__expf(-lam));
  bf16_t* LOGA = (bf16_t*)(WS + OFF_LOGA);
  bf16_t* INP = (bf16_t*)(WS + OFF_INP);
#pragma unroll
  for (int mi = 0; mi < 2; ++mi)
#pragma unroll
    for (int i = 0; i < 16; ++i) {
      int row = tm * 128 + wm * 64 + mi * 32 + crow(i, h);
      float rg = sigmoidf_(acc[mi][0][i] + ba), ig = sigmoidf_(acc[mi][1][i] + bx);
      float loga = -8.f * rg * sp;
      float mult = sqrtf(fmaxf(1.f - __expf(2.f * loga), 0.f));
      float xc = bf2f(XC[(size_t)row * 512 + ch]);
      LOGA[(size_t)row * 512 + ch] = f2bf(loga);
      INP[(size_t)row * 512 + ch] = f2bf(mult * ig * xc);
    }
}

DI void rg_scan_item(const Params& p, char* WS, int item, char* smem) {
  const int tid = get_tid(), c8 = tid & 7, seg = tid >> 3;
  const int b = item >> 3, hd = item & 7;
  const int ch = hd * 64 + c8 * 8;
  const bf16_t* LOGA = (const bf16_t*)(WS + OFF_LOGA) + (size_t)b * SEQ * 512 + ch;
  const bf16_t* INP = (const bf16_t*)(WS + OFF_INP) + (size_t)b * SEQ * 512 + ch;
  const bf16_t* G = (const bf16_t*)(WS + OFF_HZ) + (size_t)b * SEQ * ZW + Z_GATE + ch;
  bf16_t* YA = (bf16_t*)(WS + OFF_YA) + (size_t)b * SEQ * 512 + ch;
  float* ex = (float*)smem;
  const int ts = seg * 64;
  float P[8], hh[8];
#pragma unroll
  for (int e = 0; e < 8; ++e) { P[e] = 1.f; hh[e] = 0.f; }
#pragma unroll 4
  for (int i = 0; i < 64; ++i) {
    float la[8], in[8];
    unpack8(*(const u32x4*)(LOGA + (size_t)(ts + i) * 512), la);
    unpack8(*(const u32x4*)(INP + (size_t)(ts + i) * 512), in);
#pragma unroll
    for (int e = 0; e < 8; ++e) { float a = __expf(la[e]); hh[e] = a * hh[e] + in[e]; P[e] *= a; }
  }
  __syncthreads();
#pragma unroll
  for (int e = 0; e < 8; ++e) { ex[((seg * 64) + c8 * 8 + e) * 2] = P[e]; ex[((seg * 64) + c8 * 8 + e) * 2 + 1] = hh[e]; }
  __syncthreads();
#pragma unroll
  for (int e = 0; e < 8; ++e) hh[e] = 0.f;
  for (int s2 = 0; s2 < seg; ++s2) {
#pragma unroll
    for (int e = 0; e < 8; ++e) hh[e] = ex[((s2 * 64) + c8 * 8 + e) * 2] * hh[e] + ex[((s2 * 64) + c8 * 8 + e) * 2 + 1];
  }
#pragma unroll 4
  for (int i = 0; i < 64; ++i) {
    float la[8], in[8], gt[8], o[8];
    unpack8(*(const u32x4*)(LOGA + (size_t)(ts + i) * 512), la);
    unpack8(*(const u32x4*)(INP + (size_t)(ts + i) * 512), in);
    unpack8(*(const u32x4*)(G + (size_t)(ts + i) * ZW), gt);
#pragma unroll
    for (int e = 0; e < 8; ++e) { float a = __expf(la[e]); hh[e] = a * hh[e] + in[e]; o[e] = hh[e] * gelu_tanh(gt[e]); }
    *(u32x4*)(YA + (size_t)(ts + i) * 512) = pack8(o);
  }
}

DI void glu_tile(const Params& p, char* WS, int l, int t, char* smem) {
  const int tid = get_tid(), lane = tid & 63, wave = tid >> 6, wm = wave >> 1, wn = wave & 1, r = lane & 31, h = lane >> 5;
  const int tm = t >> 2, tn = t & 3;
  const bf16_t* YS = (const bf16_t*)(WS + OFF_YS5);
  bf16_t* YD = (bf16_t*)(WS + OFF_YD);
  f32x16 acc[2][2]; zero_acc(acc);
  gemm_main<false>(YS + (size_t)tm * 128 * 512, 512, 64, (const bf16_t*)(WS + OFF_WGLU) + ((size_t)tn * 8 << 13), 64, 8192, 512,
                   (bf16_t*)smem, acc, nullptr);
#pragma unroll
  for (int ni = 0; ni < 2; ++ni) {
    const int col = tn * 128 + wn * 64 + ni * 32 + r;
    const float bg = p.s5_bglu[l * 512 + col];
#pragma unroll
    for (int mi = 0; mi < 2; ++mi)
#pragma unroll
      for (int i = 0; i < 16; ++i) {
        int row = tm * 128 + wm * 64 + mi * 32 + crow(i, h);
        float y = bf2f(YS[(size_t)row * 512 + col]);
        YD[(size_t)row * 512 + col] = f2bf(y * sigmoidf_(acc[mi][ni][i] + bg));
      }
  }
}

DI void mla_attn_item(const Params& p, char* WS, int l, int item, char* smem) {
  const int tid = get_tid(), lane = tid & 63, wave = tid >> 6, r = lane & 31, h = lane >> 5;
  const int qt = 15 - (item >> 7); const int bh = item & 127; const int b = bh >> 3, hd = bh & 7;
  const int q0 = qt * 128 + wave * 32;
  constexpr int KLD = 104, VLD = 72;
  bf16_t* Kt = (bf16_t*)smem;
  bf16_t* Vt = Kt + 2 * 64 * KLD;
  const bf16_t* Qp = (const bf16_t*)(WS + OFF_Q) + (size_t)(b * SEQ + q0 + r) * 768 + hd * 96 + h * 8;
  bf16x8 bq[6];
#pragma unroll
  for (int s6 = 0; s6 < 6; ++s6) bq[s6] = *(const bf16x8*)(Qp + s6 * 16);
  const bf16_t* Kb = (const bf16_t*)(WS + OFF_K) + (size_t)b * SEQ * 768 + hd * 96;
  const bf16_t* Vb = (const bf16_t*)(WS + OFF_VT) + (size_t)(b * 8 + hd) * 64 * SEQ;
  const float* g0 = p.mla_qk_gain + (l * 2) * 96; const float* g1 = g0 + 96;
  float m0 = fmaxf(fabsf(g0[lane]), lane < 32 ? fabsf(g0[64 + lane]) : 0.f);
  float m1 = fmaxf(fabsf(g1[lane]), lane < 32 ? fabsf(g1[64 + lane]) : 0.f);
  m0 = wave_max(m0); m1 = wave_max(m1);
  const float LOG2E = 1.4426950408889634f;
  const float sc2 = 0.10206207261596577f * LOG2E;
  const float cc2 = 9.797958971132712f * m0 * m1 * LOG2E;
  int krow[3], kcol[3];
#pragma unroll
  for (int i = 0; i < 3; ++i) { int c = tid + 256 * i; krow[i] = c / 12; kcol[i] = (c % 12) * 8; }
  int vrow[2], vcol[2];
#pragma unroll
  for (int i = 0; i < 2; ++i) { int c = tid + 256 * i; vrow[i] = c >> 3; vcol[i] = (c & 7) * 8; }
  u32x4 rk0[3], rv0[2], rk1[3], rv1[2];
  f32x16 o0, o1;
#pragma unroll
  for (int i = 0; i < 16; ++i) { o0[i] = 0.f; o1[i] = 0.f; }
  float lsum = 0.f;
  const int nkt = qt * 2 + 2;
#define A_LOAD(RK, RV, KT)                                                                                  \
  {                                                                                                         \
    const int kk_ = ((KT) < nkt ? (KT) : nkt - 1) * 64;                                                     \
    _Pragma("unroll") for (int i = 0; i < 3; ++i) RK[i] = *(const u32x4*)(Kb + (size_t)(kk_ + krow[i]) * 768 + kcol[i]); \
    _Pragma("unroll") for (int i = 0; i < 2; ++i) RV[i] = *(const u32x4*)(Vb + (size_t)vrow[i] * SEQ + kk_ + vcol[i]);   \
  }
#define A_STORE(RK, RV, BUF)                                                                                \
  {                                                                                                         \
    _Pragma("unroll") for (int i = 0; i < 3; ++i) *(u32x4*)(Kt + (BUF) * 64 * KLD + krow[i] * KLD + kcol[i]) = RK[i]; \
    _Pragma("unroll") for (int i = 0; i < 2; ++i) *(u32x4*)(Vt + (BUF) * 64 * VLD + vrow[i] * VLD + vcol[i]) = RV[i]; \
  }
#define A_COMPUTE(BUF, KT)                                                                                  \
  {                                                                                                         \
    const int k0 = (KT) * 64;                                                                               \
    const bf16_t* kc = Kt + (BUF) * 64 * KLD;                                                               \
    const bf16_t* vc = Vt + (BUF) * 64 * VLD;                                                               \
    _Pragma("unroll") for (int sub = 0; sub < 2; ++sub) {                                                   \
      const int ks0 = k0 + sub * 32;                                                                        \
      if (ks0 <= q0 + 31) {                                                                                 \
        f32x16 sacc;                                                                                        \
        _Pragma("unroll") for (int i = 0; i < 16; ++i) sacc[i] = 0.f;                                       \
        _Pragma("unroll") for (int s6 = 0; s6 < 6; ++s6) {                                                  \
          bf16x8 ka = *(const bf16x8*)(kc + (sub * 32 + r) * KLD + s6 * 16 + h * 8);                        \
          sacc = MFMA32(ka, bq[s6], sacc);                                                                  \
        }                                                                                                   \
        const bool diag = (ks0 + 31 > q0);                                                                  \
        float pv[16];                                                                                       \
        _Pragma("unroll") for (int i = 0; i < 16; ++i) {                                                    \
          float e = __builtin_amdgcn_exp2f(sacc[i] * sc2 - cc2);                                            \
          if (diag && (ks0 + crow(i, h) > q0 + r)) e = 0.f;                                                 \
          pv[i] = e; lsum += e;                                                                             \
        }                                                                                                   \
        _Pragma("unroll") for (int s2 = 0; s2 < 2; ++s2) {                                                  \
          u32x4 pfu;                                                                                        \
          pfu.x = pack2_mfma(pv[8 * s2 + 0], pv[8 * s2 + 1]); pfu.y = pack2_mfma(pv[8 * s2 + 2], pv[8 * s2 + 3]); \
          pfu.z = pack2_mfma(pv[8 * s2 + 4], pv[8 * s2 + 5]); pfu.w = pack2_mfma(pv[8 * s2 + 6], pv[8 * s2 + 7]); \
          bf16x8 pf = __builtin_bit_cast(bf16x8, pfu);                                                      \
          const bf16_t* vp = vc + r * VLD + sub * 32 + 16 * s2 + 4 * h;                                     \
          bf16x4 l0 = *(const bf16x4*)vp, h0 = *(const bf16x4*)(vp + 8);                                    \
          bf16x4 l1 = *(const bf16x4*)(vp + 32 * VLD), h1 = *(const bf16x4*)(vp + 32 * VLD + 8);            \
          bf16x8 va0 = __builtin_shufflevector(l0, h0, 0, 1, 2, 3, 4, 5, 6, 7);                             \
          bf16x8 va1 = __builtin_shufflevector(l1, h1, 0, 1, 2, 3, 4, 5, 6, 7);                             \
          o0 = MFMA32(va0, pf, o0); o1 = MFMA32(va1, pf, o1);                                               \
        }                                                                                                   \
      }                                                                                                     \
    }                                                                                                       \
  }
  A_LOAD(rk0, rv0, 0);
  A_LOAD(rk1, rv1, 1);
  __syncthreads();
  A_STORE(rk0, rv0, 0);
  __syncthreads();
  for (int kt = 0; kt < nkt; kt += 2) {
    A_LOAD(rk0, rv0, kt + 2);
    __builtin_amdgcn_sched_barrier(0);
    A_COMPUTE(0, kt);
    __builtin_amdgcn_sched_barrier(0);
    A_STORE(rk1, rv1, 1);
    __syncthreads();
    A_LOAD(rk1, rv1, kt + 3);
    __builtin_amdgcn_sched_barrier(0);
    A_COMPUTE(1, kt + 1);
    __builtin_amdgcn_sched_barrier(0);
    A_STORE(rk0, rv0, 0);
    __syncthreads();
  }
#undef A_LOAD
#undef A_STORE
#undef A_COMPUTE
  const float lt = lsum + xshfl_xor(lsum, 32);
  const float inv = 1.f / lt;
  bf16_t* yb = (bf16_t*)(WS + OFF_YB) + (size_t)(b * SEQ + q0 + r) * 512 + hd * 64;
#pragma unroll
  for (int g4 = 0; g4 < 4; ++g4) {
    u32x2 a, c;
    a.x = pack2(o0[4 * g4] * inv, o0[4 * g4 + 1] * inv); a.y = pack2(o0[4 * g4 + 2] * inv, o0[4 * g4 + 3] * inv);
    c.x = pack2(o1[4 * g4] * inv, o1[4 * g4 + 1] * inv); c.y = pack2(o1[4 * g4 + 2] * inv, o1[4 * g4 + 3] * inv);
    *(u32x2*)(yb + 8 * g4 + 4 * h) = a;
    *(u32x2*)(yb + 32 + 8 * g4 + 4 * h) = c;
  }
}

DI uint32_t sortable(float f) { uint32_t u = __float_as_uint(f); return (u & 0x80000000u) ? ~u : (u | 0x80000000u); }
DI float idx_score(const f32x16& a, const uint32_t (&wvp)[8], int jq) {
  float s = 0.f;
#pragma unroll
  for (int hd = 0; hd < 8; ++hd) {
    const uint32_t pw = wvp[4 * jq + (hd >> 1)];
    const float w = __uint_as_float((hd & 1) ? (pw & 0xffff0000u) : (pw << 16));
    s = fmaf(w, fmaxf(a[8 * jq + hd], 0.f), s);
  }
  return s;
}
DI int half_sum(int v) {
#pragma unroll
  for (int o = 16; o > 0; o >>= 1) v += xshfl_xor_i(v, o);
  return v;
}
DI void dsa_scores(const bf16_t* KI, const bf16x8 (&aqi)[2], const uint32_t (&wv)[8], int r, int h, int myq0, int ktmax,
                   uint32_t (&sk)[64], uint32_t* stash) {
  const bf16_t* kp = KI + (size_t)r * 32 + 8 * h;
#pragma unroll
  for (int g4 = 0; g4 < 16; ++g4) {
    if (g4 * 4 <= ktmax) {
      asm volatile("" : "+v"(kp));
#pragma unroll
      for (int e = 0; e < 4; ++e) {
        const int kt = g4 * 4 + e;
        f32x16 a;
#pragma unroll
        for (int i = 0; i < 16; ++i) a[i] = 0.f;
#pragma unroll
        for (int s2 = 0; s2 < 2; ++s2) {
          bf16x8 kb = *(const bf16x8*)(kp + e * 1024 + 16 * s2);
          a = MFMA32(aqi[s2], kb, a);
        }
        const int key = kt * 32 + r;
        const float s0 = idx_score(a, wv, 0), s1 = idx_score(a, wv, 1);
        sk[kt] = (key <= myq0) ? sortable(s0) : 0u;
        stash[kt * 64] = (key <= myq0 + 1) ? sortable(s1) : 0u;
      }
      kp += 4 * 1024;
    } else {
#pragma unroll
      for (int e = 0; e < 4; ++e) { sk[4 * g4 + e] = 0u; stash[(4 * g4 + e) * 64] = 0u; }
    }
  }
}
DI void dsa_unstash(uint32_t (&sk)[64], const uint32_t* stash, int ktmax) {
#pragma unroll
  for (int g8 = 0; g8 < 8; ++g8) {
    if (g8 * 8 <= ktmax) {
#pragma unroll
      for (int e = 0; e < 8; ++e) sk[8 * g8 + e] = stash[(8 * g8 + e) * 64];
    } else {
#pragma unroll
      for (int e = 0; e < 8; ++e) sk[8 * g8 + e] = 0u;
    }
  }
}
DI void dsa_threshold(const uint32_t (&sk)[64], int r, int ktmax, uint32_t& thr_out, int& cut_out) {
  uint32_t prefix = 0u;
#pragma unroll 1
  for (int bit = 31; bit >= 0; --bit) {
    const uint32_t cand = prefix | (1u << bit);
    int cnt = 0;
#pragma unroll
    for (int g8 = 0; g8 < 8; ++g8) {
      if (g8 * 8 <= ktmax) {
#pragma unroll
        for (int e = 0; e < 8; ++e) cnt += (sk[g8 * 8 + e] >= cand) ? 1 : 0;
      }
    }
    cnt = half_sum(cnt);
    if (cnt >= 256) prefix = cand;
  }
  int cgt = 0, ceq = 0;
#pragma unroll
  for (int kt = 0; kt < 64; ++kt) { cgt += (sk[kt] > prefix) ? 1 : 0; ceq += (sk[kt] == prefix) ? 1 : 0; }
  cgt = half_sum(cgt); ceq = half_sum(ceq);
  const int need = 256 - cgt;
  int c = 0x7fffffff;
  const bool excess = (prefix != 0u) && (ceq > need);
  if (__any(excess)) {
    int cc = 0;
#pragma unroll 1
    for (int bit = 10; bit >= 0; --bit) {
      const int test = cc | (1 << bit);
      int cnt = 0;
#pragma unroll
      for (int kt = 0; kt < 64; ++kt) cnt += (sk[kt] == prefix && (kt * 32 + r) < test) ? 1 : 0;
      cnt = half_sum(cnt);
      if (cnt < need) cc = test;
    }
    if (excess) c = cc;
  }
  thr_out = prefix; cut_out = c;
}

DI void dsa_item(const Params& p, char* WS, int l, int item, char* smem) {
  const int tid = get_tid(), lane = tid & 63, wave = tid >> 6, r = lane & 31, h = lane >> 5;
  const int qt = 127 - (item >> 4); const int b = item & 15;
  const int tq0 = qt * 16 + wave * 4;
  const bf16_t* Z = (const bf16_t*)(WS + OFF_HZ);
  const bf16_t* KI = (const bf16_t*)(WS + OFF_KI) + (size_t)b * SEQ * 32;
  const bf16_t* KD = (const bf16_t*)(WS + OFF_KD) + (size_t)b * SEQ * 64;
  const bf16_t* VTD = (const bf16_t*)(WS + OFF_VTD) + (size_t)b * 64 * SEQ;
  const int ai = (r & 3) + 4 * (r >> 3);
  const int aq = 2 * ((r >> 2) & 1) + (ai >> 3), ah = ai & 7;
  bf16x8 aqi[2];
#pragma unroll
  for (int s2 = 0; s2 < 2; ++s2)
    aqi[s2] = *(const bf16x8*)(Z + (size_t)(b * SEQ + tq0 + aq) * ZW + Z_QIDX + ah * 32 + 16 * s2 + 8 * h);
  uint32_t wv[8];
#pragma unroll
  for (int jq = 0; jq < 2; ++jq) {
    u32x4 w8 = *(const u32x4*)(Z + (size_t)(b * SEQ + tq0 + 2 * h + jq) * ZW + Z_WIDX);
    wv[4 * jq] = w8.x; wv[4 * jq + 1] = w8.y; wv[4 * jq + 2] = w8.z; wv[4 * jq + 3] = w8.w;
  }
  const int myq0 = tq0 + 2 * h;
  const int ktmax = (tq0 + 3) >> 5;
  uint32_t thr[2]; int cut[2];
  {
    uint32_t* stash = (uint32_t*)smem + (size_t)wave * 64 * 64 + lane;
    uint32_t sk[64];
    dsa_scores(KI, aqi, wv, r, h, myq0, ktmax, sk, stash);
    asm volatile("" ::: "memory");
    dsa_threshold(sk, r, ktmax, thr[0], cut[0]);
    dsa_unstash(sk, stash, ktmax);
    asm volatile("" ::: "memory");
    dsa_threshold(sk, r, ktmax, thr[1], cut[1]);
  }
  asm volatile("" ::: "memory");
  constexpr int KLD = 72, VLD = 72, ILD = 40;
  bf16_t* Kt = (bf16_t*)smem;
  bf16_t* Vt = Kt + 2 * 64 * KLD;
  bf16_t* It = Vt + 2 * 64 * VLD;
  const int cq = r >> 3, chd = r & 7;
  bf16x8 bq[4];
#pragma unroll
  for (int s4 = 0; s4 < 4; ++s4)
    bq[s4] = *(const bf16x8*)(Z + (size_t)(b * SEQ + tq0 + cq) * ZW + Z_QDSA + chd * 64 + 16 * s4 + 8 * h);
  const float* g0 = p.dsa_qk_gain + (l * 2) * 64; const float* g1 = g0 + 64;
  const float m0 = wave_max(fabsf(g0[lane])), m1 = wave_max(fabsf(g1[lane]));
  const float LOG2E = 1.4426950408889634f;
  const float sc2 = 0.125f * LOG2E;
  const float cc2 = 8.f * m0 * m1 * LOG2E;
  f32x16 o0, o1;
#pragma unroll
  for (int i = 0; i < 16; ++i) { o0[i] = 0.f; o1[i] = 0.f; }
  float lsum = 0.f;
  const int nkt = ((qt * 16 + 15) >> 6) + 1;
  const int srow0 = tid >> 3, scol0 = (tid & 7) * 8;
  const int irow = tid >> 2, icol = (tid & 3) * 8;
  u32x4 rk0[2], rv0[2], ri0, rk1[2], rv1[2], ri1;
#define D_LOAD(RK, RV, RI, KT)                                                                              \
  {                                                                                                         \
    const int kk_ = ((KT) < nkt ? (KT) : nkt - 1) * 64;                                                     \
    _Pragma("unroll") for (int i = 0; i < 2; ++i) {                                                         \
      RK[i] = *(const u32x4*)(KD + (size_t)(kk_ + srow0 + 32 * i) * 64 + scol0);                            \
      RV[i] = *(const u32x4*)(VTD + (size_t)(srow0 + 32 * i) * SEQ + kk_ + scol0);                          \
    }                                                                                                       \
    RI = *(const u32x4*)(KI + (size_t)(kk_ + irow) * 32 + icol);                                            \
  }
#define D_STORE(RK, RV, RI, BUF)                                                                            \
  {                                                                                                         \
    _Pragma("unroll") for (int i = 0; i < 2; ++i) {                                                         \
      *(u32x4*)(Kt + (BUF) * 64 * KLD + (srow0 + 32 * i) * KLD + scol0) = RK[i];                            \
      *(u32x4*)(Vt + (BUF) * 64 * VLD + (srow0 + 32 * i) * VLD + scol0) = RV[i];                            \
    }                                                                                                       \
    *(u32x4*)(It + (BUF) * 64 * ILD + irow * ILD + icol) = RI;                                              \
  }
#define D_COMPUTE(BUF, KT)                                                                                  \
  {                                                                                                         \
    const int k0 = (KT) * 64;                                                                               \
    const bf16_t* kc = Kt + (BUF) * 64 * KLD;                                                               \
    const bf16_t* vc = Vt + (BUF) * 64 * VLD;                                                               \
    const bf16_t* ic = It + (BUF) * 64 * ILD;                                                               \
    _Pragma("unroll") for (int sub = 0; sub < 2; ++sub) {                                                   \
      if ((KT) * 2 + sub <= ktmax) {                                                                        \
        const int ks0 = k0 + sub * 32;                                                                      \
        f32x16 a;                                                                                           \
        _Pragma("unroll") for (int i = 0; i < 16; ++i) a[i] = 0.f;                                          \
        _Pragma("unroll") for (int s2 = 0; s2 < 2; ++s2) {                                                  \
          bf16x8 kb = *(const bf16x8*)(ic + (sub * 32 + r) * ILD + 16 * s2 + 8 * h);                        \
          a = MFMA32(aqi[s2], kb, a);                                                                       \
        }                                                                                                   \
        const int key = ks0 + r;                                                                            \
        const uint32_t u0 = sortable(idx_score(a, wv, 0)), u1 = sortable(idx_score(a, wv, 1));              \
        const bool sel0 = (key <= myq0) && (u0 > thr[0] || (u0 == thr[0] && key <= cut[0]));                \
        const bool sel1 = (key <= myq0 + 1) && (u1 > thr[1] || (u1 == thr[1] && key <= cut[1]));            \
        const unsigned long long bl0 = __ballot(sel0), bl1 = __ballot(sel1);                                \
        const unsigned long long blq = (cq & 1) ? bl1 : bl0;                                                \
        const uint32_t mymask = (uint32_t)(blq >> (32 * (cq >> 1)));                                        \
        f32x16 sacc;                                                                                        \
        _Pragma("unroll") for (int i = 0; i < 16; ++i) sacc[i] = 0.f;                                       \
        _Pragma("unroll") for (int s4 = 0; s4 < 4; ++s4) {                                                  \
          bf16x8 ka = *(const bf16x8*)(kc + (sub * 32 + r) * KLD + 16 * s4 + 8 * h);                        \
          sacc = MFMA32(ka, bq[s4], sacc);                                                                  \
        }                                                                                                   \
        float pv[16];                                                                                       \
        _Pragma("unroll") for (int i = 0; i < 16; ++i) {                                                    \
          float e = __builtin_amdgcn_exp2f(sacc[i] * sc2 - cc2);                                            \
          e = ((mymask >> crow(i, h)) & 1u) ? e : 0.f;                                                      \
          pv[i] = e; lsum += e;                                                                             \
        }                                                                                                   \
        _Pragma("unroll") for (int s2 = 0; s2 < 2; ++s2) {                                                  \
          u32x4 pfu;                                                                                        \
          pfu.x = pack2_mfma(pv[8 * s2 + 0], pv[8 * s2 + 1]); pfu.y = pack2_mfma(pv[8 * s2 + 2], pv[8 * s2 + 3]); \
          pfu.z = pack2_mfma(pv[8 * s2 + 4], pv[8 * s2 + 5]); pfu.w = pack2_mfma(pv[8 * s2 + 6], pv[8 * s2 + 7]); \
          bf16x8 pf = __builtin_bit_cast(bf16x8, pfu);                                                      \
          const bf16_t* vp = vc + r * VLD + sub * 32 + 16 * s2 + 4 * h;                                     \
          bf16x4 l0 = *(const bf16x4*)vp, h0 = *(const bf16x4*)(vp + 8);                                    \
          bf16x4 l1 = *(const bf16x4*)(vp + 32 * VLD), h1 = *(const bf16x4*)(vp + 32 * VLD + 8);            \
          bf16x8 va0 = __builtin_shufflevector(l0, h0, 0, 1, 2, 3, 4, 5, 6, 7);                             \
          bf16x8 va1 = __builtin_shufflevector(l1, h1, 0, 1, 2, 3, 4, 5, 6, 7);                             \
          o0 = MFMA32(va0, pf, o0); o1 = MFMA32(va1, pf, o1);                                               \
        }                                                                                                   \
      }                                                                                                     \
    }                                                                                                       \
  }
  D_LOAD(rk0, rv0, ri0, 0);
  D_LOAD(rk1, rv1, ri1, 1);
  __syncthreads();
  D_STORE(rk0, rv0, ri0, 0);
  __syncthreads();
  for (int kt = 0; kt < nkt; kt += 2) {
    D_LOAD(rk0, rv0, ri0, kt + 2);
    __builtin_amdgcn_sched_barrier(0);
    D_COMPUTE(0, kt);
    __builtin_amdgcn_sched_barrier(0);
    D_STORE(rk1, rv1, ri1, 1);
    __syncthreads();
    D_LOAD(rk1, rv1, ri1, kt + 3);
    __builtin_amdgcn_sched_barrier(0);
    if (kt + 1 < nkt) D_COMPUTE(1, kt + 1);
    __builtin_amdgcn_sched_barrier(0);
    D_STORE(rk0, rv0, ri0, 0);
    __syncthreads();
  }
#undef D_LOAD
#undef D_STORE
#undef D_COMPUTE
  const float lt = lsum + xshfl_xor(lsum, 32);
  const float inv = 1.f / lt;
  bf16_t* yc = (bf16_t*)(WS + OFF_YC) + (size_t)(b * SEQ + tq0 + cq) * 512 + chd * 64;
#pragma unroll
  for (int g4 = 0; g4 < 4; ++g4) {
    u32x2 a2, c2;
    a2.x = pack2(o0[4 * g4] * inv, o0[4 * g4 + 1] * inv); a2.y = pack2(o0[4 * g4 + 2] * inv, o0[4 * g4 + 3] * inv);
    c2.x = pack2(o1[4 * g4] * inv, o1[4 * g4 + 1] * inv); c2.y = pack2(o1[4 * g4 + 2] * inv, o1[4 * g4 + 3] * inv);
    *(u32x2*)(yc + 8 * g4 + 4 * h) = a2;
    *(u32x2*)(yc + 32 + 8 * g4 + 4 * h) = c2;
  }
}

DI int snake512(int j) {
  const int round = j >> 9, u = j & 511;
  return (round & 1) ? (round << 9) + (511 - u) : j;
}

DI void phase_mix1(const Params& p, char* WS, int l, char* smem, int rep) {
  constexpr int N_S5 = 512, N_Q = 1536, N_KV = 2048, N_VT = 512, N_QK = (T * 9 + 255) / 256, N_IDX = N_QK, N_CONV = T * 64 / 256;
  constexpr int E0 = N_S5, E1 = E0 + N_Q, E2 = E1 + N_KV, E3 = E2 + N_VT, E4 = E3 + N_QK, E5 = E4 + N_IDX, E6 = E5 + N_CONV;
  for (int it = get_bid(); it < E6; it += get_nb()) {
    if (it < E0) s5_item<false>(p, WS, l, it, smem);
    else if (it < E1) mla_up_tile(p, WS, it - E0, false, smem);
    else if (it < E2) mla_up_tile(p, WS, it - E1, true, smem);
    else if (it < E3) dsa_prep_vt(p, WS, it - E2, smem);
    else if (it < E4) { if (rep == 0) dsa_prep_qk(p, WS, l, it - E3); }
    else if (it < E5) { if (rep == 0) dsa_prep_idx(p, WS, it - E4); }
    else rg_conv(p, WS, l, it - E5);
  }
}
DI void phase_mix2(const Params& p, char* WS, int l, char* smem, int rep) {
  constexpr int N_DSA = 2048, N_S5 = 512, N_RG = 2048, N_EL = T * 16 / 256;
  constexpr int E0 = N_DSA, E1 = E0 + N_S5, E2 = E1 + N_RG, E3 = E2 + N_EL;
  for (int it = get_bid(); it < E3; it += get_nb()) {
    if (it < E0) dsa_item(p, WS, l, snake512(it), smem);
    else if (it < E1) s5_item<true>(p, WS, l, it - E0, smem);
    else if (it < E2) rg_gate_tile(p, WS, l, it - E1, smem);
    else if (rep == 0) mla_elem(p, WS, l, it - E2);
  }
}
DI void phase_mix3(const Params& p, char* WS, int l, char* smem) {
  constexpr int N_RG = 128, N_ATT = 2048, N_GLU = 1024;
  constexpr int E0 = N_RG, E1 = E0 + N_ATT, E2 = E1 + N_GLU;
  for (int it = get_bid(); it < E2; it += get_nb()) {
    if (it < E0) rg_scan_item(p, WS, it, smem);
    else if (it < E1) mla_attn_item(p, WS, l, snake512(it - E0), smem);
    else glu_tile(p, WS, l, it - E1, smem);
  }
}

DI void grid_barrier() {
  asm volatile("s_waitcnt vmcnt(0) lgkmcnt(0)" ::: "memory");
  cg::this_grid().sync();
}

constexpr int NPHASE = 1 + NL * 13;

DI void run_phase(const Params& p, char* WS, int ph, char* smem_blk, int rep) {
  const int l = (ph - 1) / 13, s = (ph - 1) % 13;
  char* smem = smem_blk + get_team() * SMEM_BYTES;
#define MODP ((const float*)(WS + OFF_MOD) + (size_t)l * 16 * 9216)
  switch (s) {
    case 0: phase_convert(p, WS, l, smem); phase_norm(p, WS, l, 0); break;
    case 1: phase_ffn_up(p, WS, 0, smem_blk); break;
    case 2: phase_gemm_resid(p, WS, (const bf16_t*)(WS + OFF_HZ), (const bf16_t*)(WS + OFF_WDN), DFF, MODP + 2 * 1024, 0.5f, smem_blk); break;
    case 3: phase_norm(p, WS, l, 1); break;
    case 4: phase_inproj(p, WS, smem_blk); break;
    case 5: phase_mix1(p, WS, l, smem, rep); break;
    case 6: phase_mix2(p, WS, l, smem, rep); break;
    case 7: phase_mix3(p, WS, l, smem); break;
    case 8: phase_merge(p, WS, smem); break;
    case 9: phase_gemm_resid(p, WS, (const bf16_t*)(WS + OFF_MERGED), (const bf16_t*)(WS + OFF_WOUT), 1024, MODP + 5 * 1024, 1.0f, smem_blk); break;
    case 10: phase_norm(p, WS, l, 2); break;
    case 11: phase_ffn_up(p, WS, 1, smem_blk); break;
    case 12: phase_gemm_resid(p, WS, (const bf16_t*)(WS + OFF_HZ), (const bf16_t*)(WS + OFF_WDN) + (size_t)1024 * DFF, DFF, MODP + 8 * 1024, 0.5f, smem_blk); break;
  }
}

__global__ void __launch_bounds__(NTHREADS_BLK) mega_kernel(Params p, int ph_lo, int ph_hi, int probe) {
  __shared__ __attribute__((aligned(16))) char smem[SMEM_BLK];
  if (ph_lo == 0) {
    phase_init(p, p.ws, smem + get_team() * SMEM_BYTES);
    if (blockIdx.x == 0 && threadIdx.x == 0) {
      Params* tb = (Params*)(p.ws + OFF_TBL);
      tb->x = p.x;
      tb->c = p.c;
      tb->pos = p.pos;
      tb->ada_w = p.ada_w;
      tb->ada_b = p.ada_b;
      tb->norm_g = p.norm_g;
      tb->ffn_w1 = p.ffn_w1;
      tb->ffn_w3 = p.ffn_w3;
      tb->ffn_w2 = p.ffn_w2;
      tb->w_in = p.w_in;
      tb->conv_w = p.conv_w;
      tb->conv_b = p.conv_b;
      tb->rg_wa = p.rg_wa;
      tb->rg_ba = p.rg_ba;
      tb->rg_wx = p.rg_wx;
      tb->rg_bx = p.rg_bx;
      tb->rg_lambda = p.rg_lambda;
      tb->mla_q_norm = p.mla_q_norm;
      tb->mla_w_uq = p.mla_w_uq;
      tb->mla_kv_norm = p.mla_kv_norm;
      tb->mla_w_ukv = p.mla_w_ukv;
      tb->mla_qk_gain = p.mla_qk_gain;
      tb->dsa_qk_gain = p.dsa_qk_gain;
      tb->s5_lre = p.s5_lre;
      tb->s5_lim = p.s5_lim;
      tb->s5_logdt = p.s5_logdt;
      tb->s5_bre = p.s5_bre;
      tb->s5_bim = p.s5_bim;
      tb->s5_cre = p.s5_cre;
      tb->s5_cim = p.s5_cim;
      tb->s5_d = p.s5_d;
      tb->s5_wglu = p.s5_wglu;
      tb->s5_bglu = p.s5_bglu;
      tb->w_branch = p.w_branch;
      tb->w_out = p.w_out;
      tb->xo = p.xo;
      tb->ws = p.ws;
    }
    ph_lo = 1;
    if (ph_lo < ph_hi) grid_barrier();
  }
  for (int ph = ph_lo; ph < ph_hi; ++ph) {
    char* ws = p.ws;
    asm volatile("" : "+s"(ws));
    const Params& q = *(const Params*)(ws + OFF_TBL);
    const int nrep = (((ph - 1) % 13) == (probe & 255)) ? (probe >> 8) : 1;
    for (int rep = 0; rep < nrep; ++rep) {
      run_phase(q, ws, ph, smem, rep);
      if (rep + 1 < nrep) grid_barrier();
    }
    if (ph + 1 < ph_hi) grid_barrier();
  }
}

extern "C" void kernel_launch(void* const* d_in, const int* in_sizes, int n_in, void* d_out, int out_size, void* d_ws,
                              size_t ws_size, hipStream_t stream) {
  Params p{};
  p.x = (const float*)d_in[0]; p.c = (const float*)d_in[1]; p.pos = (const int*)d_in[2];
  p.ada_w = (const float*)d_in[3]; p.ada_b = (const float*)d_in[4]; p.norm_g = (const float*)d_in[5];
  p.ffn_w1 = (const float*)d_in[6]; p.ffn_w3 = (const float*)d_in[7]; p.ffn_w2 = (const float*)d_in[8];
  p.w_in = (const float*)d_in[9]; p.conv_w = (const float*)d_in[10]; p.conv_b = (const float*)d_in[11];
  p.rg_wa = (const float*)d_in[12]; p.rg_ba = (const float*)d_in[13]; p.rg_wx = (const float*)d_in[14];
  p.rg_bx = (const float*)d_in[15]; p.rg_lambda = (const float*)d_in[16]; p.mla_q_norm = (const float*)d_in[17];
  p.mla_w_uq = (const float*)d_in[18]; p.mla_kv_norm = (const float*)d_in[19]; p.mla_w_ukv = (const float*)d_in[20];
  p.mla_qk_gain = (const float*)d_in[21]; p.dsa_qk_gain = (const float*)d_in[22]; p.s5_lre = (const float*)d_in[23];
  p.s5_lim = (const float*)d_in[24]; p.s5_logdt = (const float*)d_in[25]; p.s5_bre = (const float*)d_in[26];
  p.s5_bim = (const float*)d_in[27]; p.s5_cre = (const float*)d_in[28]; p.s5_cim = (const float*)d_in[29];
  p.s5_d = (const float*)d_in[30]; p.s5_wglu = (const float*)d_in[31]; p.s5_bglu = (const float*)d_in[32];
  p.w_branch = (const float*)d_in[33]; p.w_out = (const float*)d_in[34];
  p.xo = (float*)d_out; p.ws = (char*)d_ws;
  if (ws_size < WS_NEED) fprintf(stderr, "workspace too small: %zu < %zu\n", ws_size, (size_t)WS_NEED);
  static int grid_blocks = 0;
  if (!grid_blocks) {
    int dev = 0, cus = 0, per_cu = 0;
    hipGetDevice(&dev);
    hipDeviceGetAttribute(&cus, hipDeviceAttributeMultiprocessorCount, dev);
    hipOccupancyMaxActiveBlocksPerMultiprocessor(&per_cu, mega_kernel, NTHREADS_BLK, 0);
    if (per_cu > 1) per_cu = 1;
    if (per_cu < 1) per_cu = 1;
    grid_blocks = cus * per_cu;
  }
#if MEGA
  int lo = 0, hi = NPHASE, probe = PROBE_CFG;
  void* args[] = {&p, &lo, &hi, &probe};
  hipError_t e = hipLaunchCooperativeKernel((void*)mega_kernel, dim3(grid_blocks), dim3(NTHREADS_BLK), args, 0, stream);
  if (e != hipSuccess) fprintf(stderr, "cooperative launch failed: %s (grid %d)\n", hipGetErrorString(e), grid_blocks);
#else
  for (int ph = 0; ph < NPHASE; ++ph) mega_kernel<<<grid_blocks, NTHREADS_BLK, 0, stream>>>(p, ph, ph + 1, PROBE_CFG);
#endif
}
```
